# Optimizing an MI355X kernel written in HIP

```python
import jax, jax.numpy as jnp
from jax import lax
import numpy as np

D_MODEL = 1024
BATCH = 4
SEQ = 4096
DEPTH = 2
DEC_BATCH = 32
DEC_SEQ = 16
PAST_LEN = 1024

CHUNK = 64
D_FF = 2816
N_HEADS = 16
N_KV_HEADS = 4
HEAD_DIM = 64
GROUP = N_HEADS // N_KV_HEADS
WINDOW = 128
WIN_CHUNKS = WINDOW // CHUNK
BAND = (WIN_CHUNKS + 1) * CHUNK
ATTN_Q = N_HEADS * HEAD_DIM
ATTN_KV = N_KV_HEADS * HEAD_DIM
SCALE = HEAD_DIM ** -0.5
HG_HEADS = 8
HG_DK = 128
HG_DV = D_MODEL // HG_HEADS
HG_FDIM = HG_HEADS * HG_DK
HG_IDIM = HG_HEADS * HG_DV
HG_BLOCK = 16
LOG_F_FLOOR = -60.0
LRU_WIDTH = D_MODEL
LRU_BLOCKS = 16
LRU_BW = LRU_WIDTH // LRU_BLOCKS
CONV_WIDTH = 4
LRU_C = 8.0
SPLIT_SIZES = (ATTN_Q, ATTN_KV, ATTN_KV, HG_FDIM, HG_FDIM, HG_IDIM, HG_IDIM, LRU_WIDTH, LRU_WIDTH, D_MODEL, D_MODEL, D_MODEL)
IN_COLS = ATTN_Q + 2 * ATTN_KV + 2 * HG_FDIM + 2 * HG_IDIM + 2 * LRU_WIDTH + 3 * D_MODEL
EPS = 1e-6
NEG = -1e30

kernel_name = "hybrid_streaming_swa_hgrn2_rglru_step"


def rms_norm(x, g):
    xf = x.astype(jnp.float32)
    y = xf * lax.rsqrt(jnp.mean(xf * xf, axis=-1, keepdims=True) + EPS)
    return y.astype(x.dtype) * g


def swiglu(h, w_up, w_down):
    gate, val = jnp.split(h @ w_up, 2, axis=-1)
    return (jax.nn.silu(gate) * val) @ w_down


def sink_softmax(s, sinks):
    m = jnp.maximum(jnp.max(s, axis=-1, keepdims=True), sinks)
    p = jnp.exp(s - m)
    return p / (jnp.sum(p, axis=-1, keepdims=True) + jnp.exp(sinks - m))


def swa_prompt(q, k, v, sinks):
    b, t = q.shape[:2]
    nc = t // CHUNK
    qc = q.reshape(b, nc, CHUNK, N_KV_HEADS, GROUP, HEAD_DIM)

    def band(a):
        ac = a.reshape(b, nc, CHUNK, N_KV_HEADS, HEAD_DIM)
        ap = jnp.pad(ac, ((0, 0), (WIN_CHUNKS, 0), (0, 0), (0, 0), (0, 0)))
        return jnp.concatenate([ap[:, j:j + nc] for j in range(WIN_CHUNKS + 1)], axis=2)

    kb, vb = band(k), band(v)
    valid = (np.arange(nc)[:, None] - WIN_CHUNKS + (np.arange(BAND) // CHUNK)[None, :]) >= 0
    s = jnp.einsum('bnqhgd,bnkhd->bnhgqk', qc, kb).astype(jnp.float32) * SCALE
    s = jnp.where(valid[None, :, None, None, None, :], s, NEG)
    sk = sinks.astype(jnp.float32).reshape(N_KV_HEADS, GROUP)[None, None, :, :, None, None]
    p = sink_softmax(s, sk)
    o = jnp.einsum('bnhgqk,bnkhd->bnqhgd', p.astype(v.dtype), vb)
    return o.reshape(b, t, ATTN_Q)


def swa_sample(q, k, v, ck, cv, sinks):
    b, t = q.shape[:2]
    keys = jnp.concatenate([ck.astype(k.dtype), k], axis=1)
    vals = jnp.concatenate([cv.astype(v.dtype), v], axis=1)
    qg = q.reshape(b, t, N_KV_HEADS, GROUP, HEAD_DIM)
    s = jnp.einsum('bqhgd,bkhd->bhgqk', qg, keys).astype(jnp.float32) * SCALE
    sk = sinks.astype(jnp.float32).reshape(N_KV_HEADS, GROUP)[None, :, :, None, None]
    p = sink_softmax(s, sk)
    o = jnp.einsum('bhgqk,bkhd->bqhgd', p.astype(v.dtype), vals)
    return o.reshape(b, t, ATTN_Q)


def hgrn2_blocks(q, logf, k, v, s0):
    bsz, t, h, dk = q.shape
    dv = v.shape[-1]
    pad = (-t) % HG_BLOCK
    if pad:
        pw = ((0, 0), (0, pad), (0, 0), (0, 0))
        q, logf, k, v = (jnp.pad(a, pw) for a in (q, logf, k, v))
    n = (t + pad) // HG_BLOCK

    def blocks(a):
        return jnp.moveaxis(a.reshape(bsz, n, HG_BLOCK, h, a.shape[-1]), 1, 0)

    causal = jnp.tril(jnp.ones((HG_BLOCK, HG_BLOCK), dtype=bool))[None, :, :, None, None]

    def step(s, blk):
        qb, gb, kb, vb = blk
        bc = jnp.cumsum(gb, axis=1)
        diff = jnp.where(causal, bc[:, :, None] - bc[:, None, :], NEG)
        att = jnp.einsum('blhk,blmhk,bmhk->bhlm', qb, jnp.exp(diff), kb)
        o = jnp.einsum('blhk,bhkv->blhv', qb * jnp.exp(bc), s) + jnp.einsum('bhlm,bmhv->blhv', att, vb)
        b_last = bc[:, -1]
        s_new = jnp.exp(b_last)[..., None] * s + jnp.einsum('blhk,blhv->bhkv', kb * jnp.exp(b_last[:, None] - bc), vb)
        return s_new, o

    s_fin, o = lax.scan(step, s0, (blocks(q), blocks(logf), blocks(k), blocks(v)))
    o = jnp.moveaxis(o, 0, 1).reshape(bsz, n * HG_BLOCK, h, dv)[:, :t]
    return o, s_fin


def rglru_scan(log_a, bx, h0):
    a = jnp.exp(log_a)
    b = jnp.sqrt(-jnp.expm1(2.0 * log_a)) * bx

    def combine(c1, c2):
        return c1[0] * c2[0], c2[0] * c1[1] + c2[1]

    a_cum, b_cum = lax.associative_scan(combine, (a, b), axis=1)
    return a_cum * h0[:, None] + b_cum


def mixer(h, p, lb, cache, win_rows):
    bsz, t, _ = h.shape
    dt = h.dtype
    idx = np.cumsum(SPLIT_SIZES)[:-1].tolist()
    (aq, ak, av, hq, hf, hi, hg, lx, lg, ga, gb, gc) = jnp.split(h @ p['w_in'], idx, axis=-1)

    q = rms_norm(aq.reshape(bsz, t, N_HEADS, HEAD_DIM), p['q_norm'])
    k = rms_norm(ak.reshape(bsz, t, N_KV_HEADS, HEAD_DIM), p['k_norm'])
    v = av.reshape(bsz, t, N_KV_HEADS, HEAD_DIM)
    if cache is None:
        ya = swa_prompt(q, k, v, p['attn_sinks'])
        k_rows, v_rows = k[:, t - win_rows:], v[:, t - win_rows:]
        s0 = jnp.zeros((bsz, HG_HEADS, HG_DK, HG_DV), jnp.float32)
        conv_buf = jnp.zeros((bsz, CONV_WIDTH - 1, LRU_WIDTH), dt)
        h0 = jnp.zeros((bsz, LRU_WIDTH), jnp.float32)
    else:
        ck, cv, s0, conv_buf, h0 = cache
        ya = swa_sample(q, k, v, ck, cv, p['attn_sinks'])
        k_rows, v_rows = k, v
        s0 = s0.astype(jnp.float32)
        conv_buf = conv_buf.astype(dt)
        h0 = h0.astype(jnp.float32)

    lbh = lb.reshape(HG_HEADS, HG_DK)
    hf32 = hf.astype(jnp.float32).reshape(bsz, t, HG_HEADS, HG_DK)
    f = lbh + (1.0 - lbh) * jax.nn.sigmoid(hf32)
    logf = jnp.maximum(jnp.log(jnp.maximum(f, 1e-26)), LOG_F_FLOOR)
    kk = (1.0 - lbh) * jax.nn.sigmoid(-hf32)
    qq = jax.nn.silu(hq).astype(jnp.float32).reshape(bsz, t, HG_HEADS, HG_DK)
    vv = hi.astype(jnp.float32).reshape(bsz, t, HG_HEADS, HG_DV)
    o, s_new = hgrn2_blocks(qq, logf, kk, vv, s0)
    o = rms_norm(o.astype(dt), p['hgrn_o_norm']) * jax.nn.silu(hg.reshape(bsz, t, HG_HEADS, HG_DV))
    yb = o.reshape(bsz, t, HG_IDIM)

    xpad = jnp.concatenate([conv_buf, lx], axis=1)
    xc = sum(xpad[:, j:j + t] * p['conv_w'][j] for j in range(CONV_WIDTH)) + p['conv_b']
    new_buf = xpad[:, t:]
    xr = xc.reshape(bsz, t, LRU_BLOCKS, LRU_BW)
    r = jax.nn.sigmoid(jnp.einsum('btnc,ncd->btnd', xr, p['lru_w_a']).reshape(bsz, t, LRU_WIDTH) + p['lru_b_a'])
    ig = jax.nn.sigmoid(jnp.einsum('btnc,ncd->btnd', xr, p['lru_w_x']).reshape(bsz, t, LRU_WIDTH) + p['lru_b_x'])
    log_a = -LRU_C * r.astype(jnp.float32) * jax.nn.softplus(-p['lru_lambda'].astype(jnp.float32))
    hs = rglru_scan(log_a, (ig * xc).astype(jnp.float32), h0)
    yc = hs.astype(dt) * jax.nn.gelu(lg)

    merged = (jax.nn.sigmoid(ga) * (ya @ p['w_attn_o'])
              + jax.nn.sigmoid(gb) * (yb @ p['w_hgrn_o'])
              + jax.nn.sigmoid(gc) * (yc @ p['w_lru_o']))
    out = merged @ p['w_out']
    return out, (k_rows, v_rows, s_new, new_buf, hs[:, -1])


def layer_forward(x, p, lb, cache, win_rows):
    x = x + 0.5 * swiglu(rms_norm(x, p['norm_ffn1']), p['w_ffn1_up'], p['w_ffn1_down'])
    m, st = mixer(rms_norm(x, p['norm_mix']), p, lb, cache, win_rows)
    x = x + m
    x = x + 0.5 * swiglu(rms_norm(x, p['norm_ffn2']), p['w_ffn2_up'], p['w_ffn2_down'])
    return x, st


def setup_inputs(seed: int = 0) -> dict:
    key = jax.random.key(seed)
    ks = iter(jax.random.split(key, 48))

    def nrm(shape, scale):
        return scale * jax.random.normal(next(ks), shape, jnp.float32)

    def gain(shape):
        return 1.0 + 0.01 * jax.random.normal(next(ks), shape, jnp.float32)

    win_rows = min(WINDOW, PAST_LEN)
    u = jax.random.uniform(next(ks), (DEPTH, LRU_WIDTH), jnp.float32, 0.9, 0.999)
    a_base = u ** (1.0 / LRU_C)
    lru_lambda = jnp.log(a_base) - jnp.log1p(-a_base)
    return {
        'x_prompt': nrm((BATCH, SEQ, D_MODEL), 1.0),
        'x_sample': nrm((DEC_BATCH, DEC_SEQ, D_MODEL), 1.0),
        'cache_attn_k': nrm((DEPTH, DEC_BATCH, win_rows, N_KV_HEADS, HEAD_DIM), 1.0),
        'cache_attn_v': nrm((DEPTH, DEC_BATCH, win_rows, N_KV_HEADS, HEAD_DIM), 1.0),
        'state_hgrn': nrm((DEPTH, DEC_BATCH, HG_HEADS, HG_DK, HG_DV), 0.3),
        'state_conv': nrm((DEPTH, DEC_BATCH, CONV_WIDTH - 1, LRU_WIDTH), 1.0),
        'state_lru': nrm((DEPTH, DEC_BATCH, LRU_WIDTH), 0.5),
        'norm_ffn1': gain((DEPTH, D_MODEL)),
        'w_ffn1_up': nrm((DEPTH, D_MODEL, 2 * D_FF), D_MODEL ** -0.5),
        'w_ffn1_down': nrm((DEPTH, D_FF, D_MODEL), D_FF ** -0.5),
        'norm_mix': gain((DEPTH, D_MODEL)),
        'w_in': nrm((DEPTH, D_MODEL, IN_COLS), D_MODEL ** -0.5),
        'q_norm': gain((DEPTH, HEAD_DIM)),
        'k_norm': gain((DEPTH, HEAD_DIM)),
        'attn_sinks': nrm((DEPTH, N_HEADS), 0.5),
        'w_attn_o': nrm((DEPTH, ATTN_Q, D_MODEL), ATTN_Q ** -0.5),
        'hgrn_lb_logits': nrm((DEPTH, HG_FDIM), 0.5),
        'hgrn_o_norm': gain((DEPTH, HG_DV)),
        'w_hgrn_o': nrm((DEPTH, HG_IDIM, D_MODEL), HG_IDIM ** -0.5),
        'conv_w': nrm((DEPTH, CONV_WIDTH, LRU_WIDTH), CONV_WIDTH ** -0.5),
        'conv_b': nrm((DEPTH, LRU_WIDTH), 0.01),
        'lru_w_a': nrm((DEPTH, LRU_BLOCKS, LRU_BW, LRU_BW), LRU_BW ** -0.5),
        'lru_b_a': nrm((DEPTH, LRU_WIDTH), 0.01),
        'lru_w_x': nrm((DEPTH, LRU_BLOCKS, LRU_BW, LRU_BW), LRU_BW ** -0.5),
        'lru_b_x': nrm((DEPTH, LRU_WIDTH), 0.01),
        'lru_lambda': lru_lambda,
        'w_lru_o': nrm((DEPTH, LRU_WIDTH, D_MODEL), LRU_WIDTH ** -0.5),
        'w_out': nrm((DEPTH, D_MODEL, D_MODEL), D_MODEL ** -0.5),
        'norm_ffn2': gain((DEPTH, D_MODEL)),
        'w_ffn2_up': nrm((DEPTH, D_MODEL, 2 * D_FF), D_MODEL ** -0.5),
        'w_ffn2_down': nrm((DEPTH, D_FF, D_MODEL), D_FF ** -0.5),
    }


def reference(x_prompt, x_sample, cache_attn_k, cache_attn_v, state_hgrn, state_conv, state_lru,
              norm_ffn1, w_ffn1_up, w_ffn1_down, norm_mix, w_in, q_norm, k_norm, attn_sinks, w_attn_o,
              hgrn_lb_logits, hgrn_o_norm, w_hgrn_o, conv_w, conv_b, lru_w_a, lru_b_a, lru_w_x, lru_b_x,
              lru_lambda, w_lru_o, w_out, norm_ffn2, w_ffn2_up, w_ffn2_down):
    win_rows = cache_attn_k.shape[2]
    lb_prob = jax.nn.softmax(hgrn_lb_logits.astype(jnp.float32), axis=0)
    lb_all = jnp.cumsum(lb_prob, axis=0) - lb_prob[0:1]

    xp, xs = x_prompt, x_sample
    st_p_all, st_s_all = [], []
    for l in range(DEPTH):
        p = {
            'norm_ffn1': norm_ffn1[l], 'w_ffn1_up': w_ffn1_up[l], 'w_ffn1_down': w_ffn1_down[l],
            'norm_mix': norm_mix[l], 'w_in': w_in[l], 'q_norm': q_norm[l], 'k_norm': k_norm[l],
            'attn_sinks': attn_sinks[l], 'w_attn_o': w_attn_o[l], 'hgrn_o_norm': hgrn_o_norm[l],
            'w_hgrn_o': w_hgrn_o[l], 'conv_w': conv_w[l], 'conv_b': conv_b[l], 'lru_w_a': lru_w_a[l],
            'lru_b_a': lru_b_a[l], 'lru_w_x': lru_w_x[l], 'lru_b_x': lru_b_x[l], 'lru_lambda': lru_lambda[l],
            'w_lru_o': w_lru_o[l], 'w_out': w_out[l], 'norm_ffn2': norm_ffn2[l],
            'w_ffn2_up': w_ffn2_up[l], 'w_ffn2_down': w_ffn2_down[l],
        }
        xp, st_p = layer_forward(xp, p, lb_all[l], None, win_rows)
        xs, st_s = layer_forward(xs, p, lb_all[l],
                                 (cache_attn_k[l], cache_attn_v[l], state_hgrn[l], state_conv[l], state_lru[l]),
                                 win_rows)
        st_p_all.append(st_p)
        st_s_all.append(st_s)

    def stack(sts, i):
        return jnp.stack([s[i] for s in sts], axis=0)

    return (xp, xs,
            stack(st_p_all, 0), stack(st_p_all, 1), stack(st_p_all, 2), stack(st_p_all, 3), stack(st_p_all, 4),
            stack(st_s_all, 0), stack(st_s_all, 1), stack(st_s_all, 2), stack(st_s_all, 3), stack(st_s_all, 4))
```

```cpp
#include <hip/hip_runtime.h>
#include <hip/hip_cooperative_groups.h>
#include <cstdio>
#include <cstdint>
namespace cg = cooperative_groups;

#ifndef ONE_LAUNCH
#define ONE_LAUNCH 0
#endif

#define LAS __attribute__((address_space(3)))
typedef unsigned short bf16_t;
typedef short bf16x8 __attribute__((ext_vector_type(8)));
typedef short bf16x4 __attribute__((ext_vector_type(4)));
typedef float f32x4 __attribute__((ext_vector_type(4)));
typedef unsigned u32x4 __attribute__((ext_vector_type(4)));
typedef unsigned u32x2 __attribute__((ext_vector_type(2)));

constexpr int DM = 1024, NB = 4, SEQ = 4096, DEPTH = 2, DB = 32, DSQ = 16, DFF = 2816;
constexpr int MP = NB * SEQ, MS = DB * DSQ, MT = MP + MS;
constexpr int INC = 10752;
constexpr int LDA_ = 2560, LDC_ = 3072, LDB_ = 5120;
constexpr float EPS = 1e-6f;
constexpr int NSEG = 16, SEGT = 256;

constexpr size_t W_UP1 = 0, W_DN1 = W_UP1 + (size_t)5632 * 1024, W_IN = W_DN1 + (size_t)1024 * 2816, W_AO = W_IN + (size_t)INC * 1024,
                 W_HO = W_AO + 1048576, W_LO = W_HO + 1048576, W_OUT = W_LO + 1048576, W_UP2 = W_OUT + 1048576, W_DN2 = W_UP2 + (size_t)5632 * 1024,
                 W_END = W_DN2 + (size_t)1024 * 2816;
constexpr size_t OFF_W = 0, OFF_H = OFF_W + W_END * 2, OFF_MG = OFF_H + (size_t)MT * 1024 * 2, OFF_P = OFF_MG + (size_t)MT * 1024 * 2,
                 OFF_S = OFF_P + (size_t)MT * 5120 * 2, OFF_D = OFF_S + (size_t)NB * 8 * NSEG * 16384 * 4, WS_END = OFF_D + (size_t)NB * 8 * NSEG * 128 * 4;
constexpr size_t O_NKP = 17301504, O_NVP = 17563648, O_NHP = 17825792, O_NCP = 18874368, O_NLP = 18898944, O_NKS = 18907136, O_NVS = 19169280,
                 O_NHS = 19431424, O_NCS = 27820032, O_NLS = 28016640;

constexpr int LDS_BYTES = 131072;

struct Params { const float* in[31]; float* out; unsigned char* ws; };
enum { I_XP = 0, I_XS, I_CK, I_CV, I_SH, I_SC, I_SL, I_NF1, I_UP1, I_DN1, I_NMIX, I_WIN, I_QN, I_KN, I_SINK, I_WAO, I_LBL, I_HON, I_WHO, I_CW, I_CB,
       I_LWA, I_LBA, I_LWX, I_LBX, I_LAM, I_WLO, I_WOUT, I_NF2, I_UP2, I_DN2 };

__device__ __forceinline__ float bf2f(unsigned v) { return __uint_as_float(v << 16); }
__device__ __forceinline__ unsigned f2bf(float f) { unsigned u = __float_as_uint(f); u += 0x7FFFu + ((u >> 16) & 1u); return u >> 16; }
__device__ __forceinline__ unsigned pk2(float lo, float hi) { return f2bf(lo) | (f2bf(hi) << 16); }
__device__ __forceinline__ float sigm(float x) { return 1.f / (1.f + __expf(-x)); }
__device__ __forceinline__ float siluf(float x) { return x / (1.f + __expf(-x)); }
__device__ __forceinline__ float gelu_tanh(float x) { const float u = 0.7978845608028654f * (x + 0.044715f * x * x * x); const float e = __expf(2.f * u); const float th = 1.f - 2.f / (e + 1.f); return 0.5f * x * (1.f + th); }
__device__ __forceinline__ void unpack8(u32x4 r, float (&o)[8]) {
    o[0] = bf2f(r.x & 0xffffu); o[1] = bf2f(r.x >> 16); o[2] = bf2f(r.y & 0xffffu); o[3] = bf2f(r.y >> 16);
    o[4] = bf2f(r.z & 0xffffu); o[5] = bf2f(r.z >> 16); o[6] = bf2f(r.w & 0xffffu); o[7] = bf2f(r.w >> 16);
}
__device__ __forceinline__ u32x4 pack8(const float (&v)[8]) { u32x4 r; r.x = pk2(v[0], v[1]); r.y = pk2(v[2], v[3]); r.z = pk2(v[4], v[5]); r.w = pk2(v[6], v[7]); return r; }
#define LDS_WAIT() asm volatile("s_waitcnt lgkmcnt(0)" ::: "memory")

namespace pg8 {
constexpr int BM = 256, BK = 64, HALF = 128, HTB = HALF * BK * 2, STAGE_BYTES = 8 * HTB, NXCD = 8, WGM = 8;
__device__ __forceinline__ int lds_byte(int r, int c) { const int st = (r >> 4) * 2 + (c >> 5), rr = r & 15, cc = c & 31, ob = rr * 64 + cc * 2; return st * 1024 + (ob ^ (((ob >> 9) & 1) << 5)); }
__device__ __forceinline__ void stage_rc(int b, int& R, int& C) { const int st = b / 1024, sb = b % 1024, swz = sb ^ (((sb >> 9) & 1) << 5); R = (st >> 1) * 16 + swz / 64; C = (st & 1) * 32 + (swz % 64) / 2; }
struct Unit { int pm, pn; };
struct Gemm { const bf16_t* A; const bf16_t* Bt; int M, N, K, lda; };
struct StaticOrder {
    int nM, nN, nwg, G, c;
    __device__ void init(int M, int N, int G_, int c_) { nM = M / BM; nN = N / BM; nwg = nM * nN; G = G_; c = c_; }
    __device__ bool next(int i, Unit& u) const {
        const long L = (long)i * G + c; if (L >= nwg) return false;
        int wgid = (int)L; { const int q = nwg / NXCD, r = nwg % NXCD, xcd = wgid % NXCD, off = wgid / NXCD; wgid = (xcd < r ? xcd * (q + 1) : r * (q + 1) + (xcd - r) * q) + off; }
        const int nig = WGM * nN, gid = wgid / nig, fm = gid * WGM, gsz = (nM - fm) < WGM ? (nM - fm) : WGM;
        u.pm = fm + ((wgid % nig) % gsz); u.pn = (wgid % nig) / gsz; return true;
    }
};
template <class Epi>
__device__ __forceinline__ void gemm_phase(LAS unsigned char* lds, const Gemm g, const StaticOrder& S, const Epi& E) {
    const int tid = threadIdx.x, wid = __builtin_amdgcn_readfirstlane(tid >> 6), lane = tid & 63, wr = wid >> 2, wc = wid & 3, fr = lane & 15, fq = lane >> 4;
    const int K = g.K, nt = K / BK, lda = g.lda;
    unsigned voffA[2], voffB[2];
#pragma unroll
    for (int i = 0; i < 2; ++i) { int R, C; stage_rc(tid * 16 + i * 8192, R, C); voffA[i] = (unsigned)(R * lda + C) * 2u; voffB[i] = (unsigned)(R * K + C) * 2u; }
    const size_t kstep = (size_t)(BK * 2);
    const size_t hstepA = (size_t)HALF * lda * 2, tstepA = 2 * hstepA;
    const size_t hstepB = (size_t)HALF * K * 2, tstepB = 2 * hstepB;
    const unsigned ldsw = (unsigned)wid * 1024u;
    const int aoff = lds_byte(wr * 64 + fr, fq * 8), boff = lds_byte(wc * 32 + fr, fq * 8);
#define PG8_SA(b, h) (((b) * 2 + (h)) * HTB)
#define PG8_SB(b, h) ((4 + (b) * 2 + (h)) * HTB)
#define PG8_STAGE(bufoff, gbase, voff) do { _Pragma("unroll") for (int _i = 0; _i < 2; ++_i) \
        __builtin_amdgcn_global_load_lds((const unsigned*)((const char*)(gbase) + (voff)[_i]), (LAS unsigned*)(lds + (bufoff) + ldsw + _i * 8192), 16, 0, 0); } while (0)
#define PG8_LDA(dst, b, h) do { _Pragma("unroll") for (int m = 0; m < 4; ++m) _Pragma("unroll") for (int k = 0; k < 2; ++k) dst[m][k] = *(const LAS bf16x8*)(lds + PG8_SA(b, h) + aoff + m * 2048 + k * 1024); } while (0)
#define PG8_LDB(dst, b, h) do { _Pragma("unroll") for (int n = 0; n < 2; ++n) _Pragma("unroll") for (int k = 0; k < 2; ++k) dst[n][k] = *(const LAS bf16x8*)(lds + PG8_SB(b, h) + boff + n * 2048 + k * 1024); } while (0)
#define PG8_MMA(ai, bj, At, Bt) do { __builtin_amdgcn_s_setprio(1); _Pragma("unroll") for (int m = 0; m < 4; ++m) _Pragma("unroll") for (int n = 0; n < 2; ++n) _Pragma("unroll") for (int k = 0; k < 2; ++k) \
        acc[ai][bj][m][n] = __builtin_amdgcn_mfma_f32_16x16x32_bf16(Bt[n][k], At[m][k], acc[ai][bj][m][n], 0, 0, 0); __builtin_amdgcn_s_setprio(0); } while (0)
#define PG8_WAIT_V(n) asm volatile("s_waitcnt vmcnt(" #n ")" ::: "memory")
#define PG8_WAIT_L(n) asm volatile("s_waitcnt lgkmcnt(" #n ")" ::: "memory")
#define PG8_BAR __builtin_amdgcn_s_barrier()
#define PG8_SCHED __builtin_amdgcn_sched_barrier(0)
    Unit cur, nxt; int ui = 0;
    if (!S.next(0, cur)) return;
    f32x4 acc[2][2][4][2];
#pragma unroll
    for (int a = 0; a < 2; ++a)
#pragma unroll
        for (int b = 0; b < 2; ++b)
#pragma unroll
            for (int m = 0; m < 4; ++m)
#pragma unroll
                for (int n = 0; n < 2; ++n) acc[a][b][m][n] = (f32x4){0.f, 0.f, 0.f, 0.f};
    bf16x8 At[4][2], B0[2][2], B1[2][2];
    const char* cA = (const char*)g.A + (size_t)cur.pm * tstepA; const char* cB = (const char*)g.Bt + (size_t)cur.pn * tstepB;
    PG8_STAGE(PG8_SB(0, 0), cB, voffB); PG8_STAGE(PG8_SA(0, 0), cA, voffA); PG8_STAGE(PG8_SB(0, 1), cB + hstepB, voffB); PG8_STAGE(PG8_SA(0, 1), cA + hstepA, voffA);
    if (wr == 1) PG8_BAR;
    PG8_WAIT_V(4); PG8_BAR;
    PG8_STAGE(PG8_SB(1, 0), cB + kstep, voffB); PG8_STAGE(PG8_SA(1, 0), cA + kstep, voffA); PG8_STAGE(PG8_SB(1, 1), cB + hstepB + kstep, voffB);
    PG8_WAIT_V(6); PG8_BAR;
    for (;;) {
        const bool has_next = S.next(ui + 1, nxt);
        const char* nA = has_next ? (const char*)g.A + (size_t)nxt.pm * tstepA : cA; const char* nB = has_next ? (const char*)g.Bt + (size_t)nxt.pn * tstepB : cB;
        for (int t = 0; t < nt; t += 2) {
            const bool last = (t == nt - 2);
            const char* a1 = cA + (size_t)(t + 1) * kstep;
            const char* a2 = last ? nA : cA + (size_t)(t + 2) * kstep; const char* b2 = last ? nB : cB + (size_t)(t + 2) * kstep;
            const char* a3 = a2 + kstep; const char* b3 = b2 + kstep;
            PG8_LDB(B0, 0, 0); PG8_SCHED; PG8_LDA(At, 0, 0); PG8_STAGE(PG8_SA(1, 1), a1 + hstepA, voffA);
            PG8_WAIT_L(8); PG8_BAR; PG8_WAIT_L(0); PG8_MMA(0, 0, At, B0); PG8_BAR; PG8_SCHED;
            PG8_LDB(B1, 0, 1); PG8_STAGE(PG8_SB(0, 0), b2, voffB);
            PG8_BAR; PG8_WAIT_L(0); PG8_MMA(0, 1, At, B1); PG8_BAR;
            PG8_LDA(At, 0, 1); PG8_STAGE(PG8_SA(0, 0), a2, voffA);
            PG8_BAR; PG8_WAIT_L(0); PG8_MMA(1, 0, At, B0); PG8_BAR; PG8_SCHED;
            PG8_STAGE(PG8_SB(0, 1), b2 + hstepB, voffB);
            PG8_WAIT_V(6); PG8_BAR; PG8_MMA(1, 1, At, B1); PG8_BAR;
            PG8_LDB(B0, 1, 0); PG8_SCHED; PG8_LDA(At, 1, 0); PG8_STAGE(PG8_SA(0, 1), a2 + hstepA, voffA);
            PG8_WAIT_L(8); PG8_BAR; PG8_WAIT_L(0); PG8_MMA(0, 0, At, B0); PG8_BAR; PG8_SCHED;
            PG8_LDB(B1, 1, 1); PG8_STAGE(PG8_SB(1, 0), b3, voffB);
            PG8_BAR; PG8_WAIT_L(0); PG8_MMA(0, 1, At, B1); PG8_BAR;
            PG8_LDA(At, 1, 1); PG8_STAGE(PG8_SA(1, 0), a3, voffA);
            PG8_BAR; PG8_WAIT_L(0); PG8_MMA(1, 0, At, B0); PG8_BAR; PG8_SCHED;
            PG8_STAGE(PG8_SB(1, 1), b3 + hstepB, voffB);
            PG8_WAIT_V(6); PG8_BAR; PG8_MMA(1, 1, At, B1); PG8_BAR;
        }
        E(acc, cur, wr, wc, fr, fq);
        if (!has_next) break;
#pragma unroll
        for (int a = 0; a < 2; ++a)
#pragma unroll
            for (int b = 0; b < 2; ++b)
#pragma unroll
                for (int m = 0; m < 4; ++m)
#pragma unroll
                    for (int n = 0; n < 2; ++n) acc[a][b][m][n] = (f32x4){0.f, 0.f, 0.f, 0.f};
        cur = nxt; cA = nA; cB = nB; ++ui;
    }
    PG8_WAIT_V(0);
    if (wr == 0) PG8_BAR;
    PG8_BAR;
#undef PG8_SA
#undef PG8_SB
#undef PG8_STAGE
#undef PG8_LDA
#undef PG8_LDB
#undef PG8_MMA
#undef PG8_WAIT_V
#undef PG8_WAIT_L
#undef PG8_BAR
#undef PG8_SCHED
}
}
using pg8::Unit;

struct EpiStore {
    bf16_t* O; int ldc;
    __device__ __forceinline__ void operator()(const f32x4 (&acc)[2][2][4][2], const Unit& u, int wr, int wc, int fr, int fq) const {
        const int row0 = u.pm * 256 + wr * 64 + fr, col0 = u.pn * 256 + wc * 32 + 4 * fq;
#pragma unroll
        for (int ai = 0; ai < 2; ++ai)
#pragma unroll
            for (int m = 0; m < 4; ++m) { bf16_t* rowp = O + (size_t)(row0 + ai * 128 + m * 16) * ldc + col0;
#pragma unroll
                for (int bj = 0; bj < 2; ++bj)
#pragma unroll
                    for (int n = 0; n < 2; ++n) { const f32x4 v = acc[ai][bj][m][n]; u32x2 w; w.x = pk2(v[0], v[1]); w.y = pk2(v[2], v[3]); *(u32x2*)(rowp + bj * 128 + n * 16) = w; } }
    }
};
struct EpiSwiGLU {
    bf16_t* G;
    __device__ __forceinline__ void operator()(const f32x4 (&acc)[2][2][4][2], const Unit& u, int wr, int wc, int fr, int fq) const {
        const int row0 = u.pm * 256 + wr * 64 + fr, col0 = (u.pn * 256 + wc * 32) / 2 + 4 * fq;
#pragma unroll
        for (int ai = 0; ai < 2; ++ai)
#pragma unroll
            for (int m = 0; m < 4; ++m) { bf16_t* rowp = G + (size_t)(row0 + ai * 128 + m * 16) * DFF + col0;
#pragma unroll
                for (int bj = 0; bj < 2; ++bj) { const f32x4 gt = acc[ai][bj][m][0], vl = acc[ai][bj][m][1]; u32x2 w;
                    w.x = pk2(siluf(gt[0]) * vl[0], siluf(gt[1]) * vl[1]); w.y = pk2(siluf(gt[2]) * vl[2], siluf(gt[3]) * vl[3]); *(u32x2*)(rowp + bj * 64) = w; } }
    }
};
struct EpiResid {
    float* X; float scale;
    __device__ __forceinline__ void operator()(const f32x4 (&acc)[2][2][4][2], const Unit& u, int wr, int wc, int fr, int fq) const {
        const int row0 = u.pm * 256 + wr * 64 + fr, col0 = u.pn * 256 + wc * 32 + 4 * fq;
#pragma unroll
        for (int ai = 0; ai < 2; ++ai)
#pragma unroll
            for (int m = 0; m < 4; ++m) { float* rowp = X + (size_t)(row0 + ai * 128 + m * 16) * DM + col0;
#pragma unroll
                for (int bj = 0; bj < 2; ++bj)
#pragma unroll
                    for (int n = 0; n < 2; ++n) { f32x4* q = (f32x4*)(rowp + bj * 128 + n * 16); const f32x4 o = *q; *q = o + acc[ai][bj][m][n] * scale; } }
    }
};
struct EpiGate {
    bf16_t* MG; const bf16_t* gate; int ldg; int accum;
    __device__ __forceinline__ void operator()(const f32x4 (&acc)[2][2][4][2], const Unit& u, int wr, int wc, int fr, int fq) const {
        const int row0 = u.pm * 256 + wr * 64 + fr, col0 = u.pn * 256 + wc * 32 + 4 * fq;
#pragma unroll
        for (int ai = 0; ai < 2; ++ai)
#pragma unroll
            for (int m = 0; m < 4; ++m) { const size_t r = (size_t)(row0 + ai * 128 + m * 16); bf16_t* rowp = MG + r * DM + col0; const bf16_t* gp = gate + r * ldg + col0;
#pragma unroll
                for (int bj = 0; bj < 2; ++bj)
#pragma unroll
                    for (int n = 0; n < 2; ++n) { const f32x4 v = acc[ai][bj][m][n]; const u32x2 gw = *(const u32x2*)(gp + bj * 128 + n * 16);
                        float o0 = sigm(bf2f(gw.x & 0xffffu)) * v[0], o1 = sigm(bf2f(gw.x >> 16)) * v[1], o2 = sigm(bf2f(gw.y & 0xffffu)) * v[2], o3 = sigm(bf2f(gw.y >> 16)) * v[3];
                        u32x2* q = (u32x2*)(rowp + bj * 128 + n * 16);
                        if (accum) { const u32x2 old = *q; o0 += bf2f(old.x & 0xffffu); o1 += bf2f(old.x >> 16); o2 += bf2f(old.y & 0xffffu); o3 += bf2f(old.y >> 16); }
                        u32x2 w; w.x = pk2(o0, o1); w.y = pk2(o2, o3); *q = w; } }
    }
};
template <class Epi> __device__ __forceinline__ void run_gemm(LAS unsigned char* lds, const bf16_t* A, int lda, const bf16_t* Bt, int N, int K, const Epi& E) {
    pg8::Gemm g; g.A = A; g.Bt = Bt; g.M = MT; g.N = N; g.K = K; g.lda = lda;
    pg8::StaticOrder S; S.init(MT, N, (int)gridDim.x, (int)blockIdx.x);
    pg8::gemm_phase<Epi>(lds, g, S, E);
}

__device__ __forceinline__ int srccol(int kind, int j) {
    if (kind == 0) return j;
    if (kind == 1) { const int grp = j >> 5, w = j & 31; return w < 16 ? grp * 16 + w : DFF + grp * 16 + (w - 16); }
    if (j < 1536) return j;
    if (j < 2560) return 7680 + (j - 1536);
    if (j < 4608) return 5632 + (j - 2560);
    if (j < 5632) return 9728 + (j - 4608);
    if (j < 9728) return 1536 + (j - 5632);
    return 8704 + (j - 9728);
}
__device__ __forceinline__ void conv_item(const float* W, int K, int N, bf16_t* WT, int kind, LAS float* scr, int item, int lane) {
    const int nblk = N / 32, kb = item / nblk, nb = item % nblk, k0 = 64 * kb, n0 = 32 * nb;
    const int sc = srccol(kind, n0 + (lane & 31));
#pragma unroll 8
    for (int i = 0; i < 32; ++i) { const int kk = 2 * i + (lane >> 5); scr[kk * 33 + (lane & 31)] = W[(size_t)(k0 + kk) * N + sc]; }
    LDS_WAIT();
    const int c = lane & 7;
#pragma unroll
    for (int j = 0; j < 4; ++j) { const int n = (lane >> 3) + 8 * j; const LAS float* s = scr + (8 * c) * 33 + n;
        u32x4 o; o.x = pk2(s[0 * 33], s[1 * 33]); o.y = pk2(s[2 * 33], s[3 * 33]); o.z = pk2(s[4 * 33], s[5 * 33]); o.w = pk2(s[6 * 33], s[7 * 33]);
        *(u32x4*)(WT + (size_t)(n0 + n) * K + k0 + 8 * c) = o; }
    LDS_WAIT();
}
__device__ __forceinline__ void ph_convert(const Params& p, int l, LAS unsigned char* lds) {
    const int wave = threadIdx.x >> 6, lane = threadIdx.x & 63;
    LAS float* scr = (LAS float*)(lds + wave * 8704);
    bf16_t* Wb = (bf16_t*)(p.ws + OFF_W);
    const int gw = blockIdx.x * 8 + wave, NGW = gridDim.x * 8;
    constexpr int I_UP = (1024 / 64) * (5632 / 32), I_DN = (2816 / 64) * (1024 / 32), I_IN = (1024 / 64) * (INC / 32), I_SQ = (1024 / 64) * (1024 / 32);
    constexpr int NIT = 2 * I_UP + 2 * I_DN + I_IN + 4 * I_SQ;
    for (int it = gw; it < NIT; it += NGW) {
        int r = it;
        if (r < I_UP) { conv_item(p.in[I_UP1] + (size_t)l * 1024 * 5632, 1024, 5632, Wb + W_UP1, 1, scr, r, lane); continue; } r -= I_UP;
        if (r < I_DN) { conv_item(p.in[I_DN1] + (size_t)l * 2816 * 1024, 2816, 1024, Wb + W_DN1, 0, scr, r, lane); continue; } r -= I_DN;
        if (r < I_IN) { conv_item(p.in[I_WIN] + (size_t)l * 1024 * INC, 1024, INC, Wb + W_IN, 2, scr, r, lane); continue; } r -= I_IN;
        if (r < I_SQ) { conv_item(p.in[I_WAO] + (size_t)l * 1048576, 1024, 1024, Wb + W_AO, 0, scr, r, lane); continue; } r -= I_SQ;
        if (r < I_SQ) { conv_item(p.in[I_WHO] + (size_t)l * 1048576, 1024, 1024, Wb + W_HO, 0, scr, r, lane); continue; } r -= I_SQ;
        if (r < I_SQ) { conv_item(p.in[I_WLO] + (size_t)l * 1048576, 1024, 1024, Wb + W_LO, 0, scr, r, lane); continue; } r -= I_SQ;
        if (r < I_SQ) { conv_item(p.in[I_WOUT] + (size_t)l * 1048576, 1024, 1024, Wb + W_OUT, 0, scr, r, lane); continue; } r -= I_SQ;
        if (r < I_UP) { conv_item(p.in[I_UP2] + (size_t)l * 1024 * 5632, 1024, 5632, Wb + W_UP2, 1, scr, r, lane); continue; } r -= I_UP;
        conv_item(p.in[I_DN2] + (size_t)l * 2816 * 1024, 2816, 1024, Wb + W_DN2, 0, scr, r, lane);
    }
}

__device__ __forceinline__ float wave_sum(float v) {
#pragma unroll
    for (int o = 1; o < 64; o <<= 1) v += __shfl_xor(v, o);
    return v;
}
__device__ __forceinline__ void ph_norm(const Params& p, const float* g, bool init) {
    const int wave = threadIdx.x >> 6, lane = threadIdx.x & 63;
    const int gw = blockIdx.x * 8 + wave, NGW = gridDim.x * 8;
    float* X = p.out; bf16_t* H = (bf16_t*)(p.ws + OFF_H);
    f32x4 gv[4];
#pragma unroll
    for (int j = 0; j < 4; ++j) gv[j] = ((const f32x4*)g)[lane + 64 * j];
    for (int row = gw; row < MT; row += NGW) {
        const float* src = init ? (row < MP ? p.in[I_XP] + (size_t)row * DM : p.in[I_XS] + (size_t)(row - MP) * DM) : X + (size_t)row * DM;
        f32x4 v[4]; float s = 0.f;
#pragma unroll
        for (int j = 0; j < 4; ++j) { v[j] = ((const f32x4*)src)[lane + 64 * j]; s += (v[j][0] * v[j][0] + v[j][1] * v[j][1]) + (v[j][2] * v[j][2] + v[j][3] * v[j][3]); }
        s = wave_sum(s);
        const float rstd = rsqrtf(s * (1.f / DM) + EPS);
#pragma unroll
        for (int j = 0; j < 4; ++j) { u32x2 w; w.x = pk2(v[j][0] * rstd * gv[j][0], v[j][1] * rstd * gv[j][1]); w.y = pk2(v[j][2] * rstd * gv[j][2], v[j][3] * rstd * gv[j][3]);
            *(u32x2*)(H + (size_t)row * DM + (lane + 64 * j) * 4) = w;
            if (init) ((f32x4*)(X + (size_t)row * DM))[lane + 64 * j] = v[j]; }
    }
}

constexpr int KS_LD = 72, VT_LD = 200;
constexpr int KS_OFF = 0, VT_OFF = 192 * KS_LD * 2;
template <bool SAMPLE>
__device__ __forceinline__ void attn_item(const Params& p, int l, LAS unsigned char* lds, int b, int c, int kvh) {
    const int tid = threadIdx.x, wave = tid >> 6, lane = tid & 63, l15 = lane & 15, quad = lane >> 4;
    bf16_t* PA = (bf16_t*)(p.ws + OFF_P);
    LAS bf16_t* Ks = (LAS bf16_t*)(lds + KS_OFF); LAS bf16_t* Vt = (LAS bf16_t*)(lds + VT_OFF);
    const float* kg = p.in[I_KN] + l * 64; const float* qg = p.in[I_QN] + l * 64;
    {
        const int d8 = (tid & 7) * 8;
        float kgv[8];
#pragma unroll
        for (int i = 0; i < 8; ++i) kgv[i] = kg[d8 + i];
#pragma unroll
        for (int pass = 0; pass < 3; ++pass) {
            const int j = pass * 64 + (tid >> 3);
            float kf[8], vf[8]; bool valid, need_norm; long row = 0;
            if (!SAMPLE) { const int tk = (c - 2) * 64 + j; valid = tk >= 0; need_norm = true; row = (long)b * SEQ + tk; }
            else { valid = j < 144; need_norm = j >= 128; row = (long)MP + b * DSQ + (j - 128); }
            if (valid && need_norm) {
                const u32x4 kr = *(const u32x4*)(PA + row * LDA_ + 1024 + kvh * 64 + d8); const u32x4 vr = *(const u32x4*)(PA + row * LDA_ + 1280 + kvh * 64 + d8);
                unpack8(kr, kf); unpack8(vr, vf);
            } else if (valid) {
                const float* ck = p.in[I_CK] + ((((size_t)l * DB + b) * 128 + j) * 4 + kvh) * 64 + d8; const float* cv = p.in[I_CV] + ((((size_t)l * DB + b) * 128 + j) * 4 + kvh) * 64 + d8;
                const f32x4 a0 = *(const f32x4*)ck, a1 = *(const f32x4*)(ck + 4), b0 = *(const f32x4*)cv, b1 = *(const f32x4*)(cv + 4);
#pragma unroll
                for (int i = 0; i < 4; ++i) { kf[i] = a0[i]; kf[4 + i] = a1[i]; vf[i] = b0[i]; vf[4 + i] = b1[i]; }
            } else {
#pragma unroll
                for (int i = 0; i < 8; ++i) { kf[i] = 0.f; vf[i] = 0.f; }
            }
            float ss = 0.f;
#pragma unroll
            for (int i = 0; i < 8; ++i) ss += kf[i] * kf[i];
            ss += __shfl_xor(ss, 1); ss += __shfl_xor(ss, 2); ss += __shfl_xor(ss, 4);
            if (need_norm) { const float rstd = rsqrtf(ss * (1.f / 64.f) + EPS);
#pragma unroll
                for (int i = 0; i < 8; ++i) kf[i] = kf[i] * rstd * kgv[i]; }
            *(LAS u32x4*)(Ks + j * KS_LD + d8) = pack8(kf);
#pragma unroll
            for (int i = 0; i < 8; ++i) Vt[(d8 + i) * VT_LD + j] = (bf16_t)f2bf(vf[i]);
            if (!SAMPLE) { const int tk = (c - 2) * 64 + j;
                if (j >= 128 && tk >= SEQ - 128) { const size_t o = ((((size_t)l * NB + b) * 128 + (tk - (SEQ - 128))) * 4 + kvh) * 64 + d8;
#pragma unroll
                    for (int i = 0; i < 8; ++i) { p.out[O_NKP + o + i] = kf[i]; p.out[O_NVP + o + i] = vf[i]; } } }
            else if (j >= 128 && j < 144) { const size_t o = ((((size_t)l * DB + b) * DSQ + (j - 128)) * 4 + kvh) * 64 + d8;
#pragma unroll
                for (int i = 0; i < 8; ++i) { p.out[O_NKS + o + i] = kf[i]; p.out[O_NVS + o + i] = vf[i]; } }
        }
    }
    __syncthreads();
    constexpr int NQT = SAMPLE ? 1 : 2, NKT = SAMPLE ? 10 : 12;
    const bool active = SAMPLE ? (wave < 4) : true;
    if (active) {
        const int g = SAMPLE ? wave : (wave >> 1), tokbase = SAMPLE ? 0 : (wave & 1) * 32;
        const int hq = kvh * 4 + g;
        const float sink = p.in[I_SINK][l * 16 + hq];
        const int kmin = SAMPLE ? 0 : (c >= 2 ? 0 : (2 - c) * 64), kmax = SAMPLE ? 144 : 192;
        bf16x8 qf[NQT][2]; long qrow[NQT];
#pragma unroll
        for (int qt = 0; qt < NQT; ++qt) {
            const int tok = tokbase + qt * 16 + l15;
            qrow[qt] = SAMPLE ? ((long)MP + b * DSQ + tok) : ((long)b * SEQ + c * 64 + tok);
            const bf16_t* qp = PA + qrow[qt] * LDA_ + hq * 64;
            float q0[8], q1[8]; unpack8(*(const u32x4*)(qp + quad * 8), q0); unpack8(*(const u32x4*)(qp + 32 + quad * 8), q1);
            float ss = 0.f;
#pragma unroll
            for (int i = 0; i < 8; ++i) ss += q0[i] * q0[i] + q1[i] * q1[i];
            ss += __shfl_xor(ss, 16); ss += __shfl_xor(ss, 32);
            const float sc = rsqrtf(ss * (1.f / 64.f) + EPS) * 0.125f;
#pragma unroll
            for (int i = 0; i < 8; ++i) { q0[i] = q0[i] * sc * qg[quad * 8 + i]; q1[i] = q1[i] * sc * qg[32 + quad * 8 + i]; }
            const u32x4 w0 = pack8(q0), w1 = pack8(q1);
            qf[qt][0] = __builtin_bit_cast(bf16x8, w0); qf[qt][1] = __builtin_bit_cast(bf16x8, w1);
        }
        f32x4 st[NKT][NQT];
#pragma unroll
        for (int kt = 0; kt < NKT; ++kt) {
#pragma unroll
            for (int qt = 0; qt < NQT; ++qt) st[kt][qt] = (f32x4){0.f, 0.f, 0.f, 0.f};
#pragma unroll
            for (int ds = 0; ds < 2; ++ds) {
                const bf16x8 kfr = *(const LAS bf16x8*)(Ks + (kt * 16 + l15) * KS_LD + ds * 32 + quad * 8);
#pragma unroll
                for (int qt = 0; qt < NQT; ++qt) st[kt][qt] = __builtin_amdgcn_mfma_f32_16x16x32_bf16(kfr, qf[qt][ds], st[kt][qt], 0, 0, 0);
            }
        }
        float inv[NQT];
#pragma unroll
        for (int qt = 0; qt < NQT; ++qt) {
            float m = -1e30f;
#pragma unroll
            for (int kt = 0; kt < NKT; ++kt)
#pragma unroll
                for (int j = 0; j < 4; ++j) { const int key = kt * 16 + quad * 4 + j; const bool ok = key >= kmin && key < kmax; if (ok) m = fmaxf(m, st[kt][qt][j]); }
            m = fmaxf(m, __shfl_xor(m, 16)); m = fmaxf(m, __shfl_xor(m, 32));
            m = fmaxf(m, sink);
            float sum = 0.f;
#pragma unroll
            for (int kt = 0; kt < NKT; ++kt)
#pragma unroll
                for (int j = 0; j < 4; ++j) { const int key = kt * 16 + quad * 4 + j; const bool ok = key >= kmin && key < kmax; const float e = ok ? __expf(st[kt][qt][j] - m) : 0.f; st[kt][qt][j] = e; sum += e; }
            sum += __shfl_xor(sum, 16); sum += __shfl_xor(sum, 32);
            inv[qt] = 1.f / (sum + __expf(sink - m));
        }
        f32x4 ot[4][NQT];
#pragma unroll
        for (int dt = 0; dt < 4; ++dt)
#pragma unroll
            for (int qt = 0; qt < NQT; ++qt) ot[dt][qt] = (f32x4){0.f, 0.f, 0.f, 0.f};
#pragma unroll
        for (int s = 0; s < NKT / 2; ++s) {
            bf16x8 pf[NQT];
#pragma unroll
            for (int qt = 0; qt < NQT; ++qt) { u32x4 w; w.x = pk2(st[2 * s][qt][0], st[2 * s][qt][1]); w.y = pk2(st[2 * s][qt][2], st[2 * s][qt][3]);
                w.z = pk2(st[2 * s + 1][qt][0], st[2 * s + 1][qt][1]); w.w = pk2(st[2 * s + 1][qt][2], st[2 * s + 1][qt][3]); pf[qt] = __builtin_bit_cast(bf16x8, w); }
#pragma unroll
            for (int dt = 0; dt < 4; ++dt) {
                const LAS bf16_t* vp = Vt + (dt * 16 + l15) * VT_LD + 32 * s + quad * 4;
                const u32x2 lo = *(const LAS u32x2*)vp, hi = *(const LAS u32x2*)(vp + 16);
                u32x4 w; w.x = lo.x; w.y = lo.y; w.z = hi.x; w.w = hi.y;
                const bf16x8 vfr = __builtin_bit_cast(bf16x8, w);
#pragma unroll
                for (int qt = 0; qt < NQT; ++qt) ot[dt][qt] = __builtin_amdgcn_mfma_f32_16x16x32_bf16(vfr, pf[qt], ot[dt][qt], 0, 0, 0);
            }
        }
#pragma unroll
        for (int qt = 0; qt < NQT; ++qt) {
            bf16_t* op = PA + qrow[qt] * LDA_ + hq * 64 + quad * 4;
#pragma unroll
            for (int dt = 0; dt < 4; ++dt) { u32x2 w; w.x = pk2(ot[dt][qt][0] * inv[qt], ot[dt][qt][1] * inv[qt]); w.y = pk2(ot[dt][qt][2] * inv[qt], ot[dt][qt][3] * inv[qt]); *(u32x2*)(op + dt * 16) = w; }
        }
    }
    __syncthreads();
}
__device__ __forceinline__ void ph_attn(const Params& p, int l, LAS unsigned char* lds) {
    constexpr int NPI = NB * 64 * 4, NSI = DB * 4;
    for (int it = blockIdx.x; it < NPI + NSI; it += gridDim.x) {
        if (it < NPI) { const int kvh = it & 3, c = (it >> 2) & 63, b = it >> 8; attn_item<false>(p, l, lds, b, c, kvh); }
        else { const int r = it - NPI; attn_item<true>(p, l, lds, r >> 2, 0, r & 3); }
    }
}

__device__ __forceinline__ float hgrn_lb(const Params& p, int l, int idx) {
    if (l == 0) return 0.f;
    const float a = p.in[I_LBL][idx], b = p.in[I_LBL][1024 + idx]; const float m = fmaxf(a, b); const float ea = __expf(a - m), eb = __expf(b - m);
    const float p0 = ea / (ea + eb), p1 = eb / (ea + eb); return (p0 + p1) - p0;
}
template <int MODE>
__device__ __forceinline__ void hgrn_item(const Params& p, int l, LAS unsigned char* lds, long rowbase, int ntok, int h, const float* Sin, float* Sout, float* Dout) {
    const int tid = threadIdx.x, wave = tid >> 6, lane = tid & 63, kgi = lane >> 2, vs = lane & 3, vcol = wave * 16 + vs * 4;
    bf16_t* PB = (bf16_t*)(p.ws + OFF_P);
    LAS float* Fs = (LAS float*)lds; LAS float* Kk = Fs + 4096; LAS float* Qs = Kk + 4096; LAS float* Vs = Qs + 4096; LAS float* Os = Vs + 4096;
    float S[8][4];
#pragma unroll
    for (int i = 0; i < 8; ++i) { f32x4 v = (f32x4){0.f, 0.f, 0.f, 0.f}; if (Sin) v = *(const f32x4*)(Sin + (size_t)(kgi * 8 + i) * 128 + vcol);
#pragma unroll
        for (int j = 0; j < 4; ++j) S[i][j] = v[j]; }
    float Dp[8];
#pragma unroll
    for (int i = 0; i < 8; ++i) Dp[i] = 1.f;
    const int st = tid >> 4, k8 = (tid & 15) * 8;
    float lbv[8], gnv[8];
#pragma unroll
    for (int i = 0; i < 8; ++i) { lbv[i] = hgrn_lb(p, l, h * 128 + k8 + i); gnv[i] = p.in[I_HON][l * 128 + k8 + i]; }
    for (int t0 = 0; t0 < ntok; t0 += 32) {
        const int nb = (ntok - t0) < 32 ? (ntok - t0) : 32;
        if (st < nb) {
            const bf16_t* rp = PB + (rowbase + t0 + st) * LDB_ + h * 128 + k8;
            float hf[8], hi[8]; unpack8(*(const u32x4*)(rp + 1024), hf); unpack8(*(const u32x4*)(rp + 2048), hi);
            float fv[8], kv[8];
#pragma unroll
            for (int i = 0; i < 8; ++i) { const float sg = sigm(hf[i]); const float f = lbv[i] + (1.f - lbv[i]) * sg; fv[i] = fmaxf(f, 1e-26f); kv[i] = (1.f - lbv[i]) * sigm(-hf[i]); }
            *(LAS f32x4*)(Fs + st * 128 + k8) = (f32x4){fv[0], fv[1], fv[2], fv[3]}; *(LAS f32x4*)(Fs + st * 128 + k8 + 4) = (f32x4){fv[4], fv[5], fv[6], fv[7]};
            *(LAS f32x4*)(Kk + st * 128 + k8) = (f32x4){kv[0], kv[1], kv[2], kv[3]}; *(LAS f32x4*)(Kk + st * 128 + k8 + 4) = (f32x4){kv[4], kv[5], kv[6], kv[7]};
            *(LAS f32x4*)(Vs + st * 128 + k8) = (f32x4){hi[0], hi[1], hi[2], hi[3]}; *(LAS f32x4*)(Vs + st * 128 + k8 + 4) = (f32x4){hi[4], hi[5], hi[6], hi[7]};
            if (MODE == 1) { float hq[8]; unpack8(*(const u32x4*)rp, hq);
                *(LAS f32x4*)(Qs + st * 128 + k8) = (f32x4){siluf(hq[0]), siluf(hq[1]), siluf(hq[2]), siluf(hq[3])}; *(LAS f32x4*)(Qs + st * 128 + k8 + 4) = (f32x4){siluf(hq[4]), siluf(hq[5]), siluf(hq[6]), siluf(hq[7])}; }
        }
        __syncthreads();
#pragma unroll 2
        for (int t = 0; t < nb; ++t) {
            const f32x4 f0 = *(const LAS f32x4*)(Fs + t * 128 + kgi * 8), f1 = *(const LAS f32x4*)(Fs + t * 128 + kgi * 8 + 4);
            const f32x4 c0 = *(const LAS f32x4*)(Kk + t * 128 + kgi * 8), c1 = *(const LAS f32x4*)(Kk + t * 128 + kgi * 8 + 4);
            const f32x4 v4 = *(const LAS f32x4*)(Vs + t * 128 + vcol);
            f32x4 q0 = (f32x4){0.f, 0.f, 0.f, 0.f}, q1 = q0;
            if (MODE == 1) { q0 = *(const LAS f32x4*)(Qs + t * 128 + kgi * 8); q1 = *(const LAS f32x4*)(Qs + t * 128 + kgi * 8 + 4); }
            float o[4] = {0.f, 0.f, 0.f, 0.f};
#pragma unroll
            for (int i = 0; i < 8; ++i) { const float fi = i < 4 ? f0[i & 3] : f1[i & 3], ci = i < 4 ? c0[i & 3] : c1[i & 3], qi = i < 4 ? q0[i & 3] : q1[i & 3];
                if (MODE == 0) Dp[i] *= fi;
#pragma unroll
                for (int j = 0; j < 4; ++j) { S[i][j] = fi * S[i][j] + ci * v4[j]; if (MODE == 1) o[j] += S[i][j] * qi; } }
            if (MODE == 1) {
#pragma unroll
                for (int j = 0; j < 4; ++j) { o[j] += __shfl_xor(o[j], 4); o[j] += __shfl_xor(o[j], 8); o[j] += __shfl_xor(o[j], 16); o[j] += __shfl_xor(o[j], 32); }
                if (kgi == 0) *(LAS f32x4*)(Os + t * 128 + vcol) = (f32x4){o[0], o[1], o[2], o[3]};
            }
        }
        __syncthreads();
        if (MODE == 1 && st < nb) {
            const f32x4 o0 = *(const LAS f32x4*)(Os + st * 128 + k8), o1 = *(const LAS f32x4*)(Os + st * 128 + k8 + 4);
            float ov[8] = {o0[0], o0[1], o0[2], o0[3], o1[0], o1[1], o1[2], o1[3]};
            float ss = 0.f;
#pragma unroll
            for (int i = 0; i < 8; ++i) ss += ov[i] * ov[i];
            ss += __shfl_xor(ss, 1); ss += __shfl_xor(ss, 2); ss += __shfl_xor(ss, 4); ss += __shfl_xor(ss, 8);
            const float rstd = rsqrtf(ss * (1.f / 128.f) + EPS);
            bf16_t* gp = PB + (rowbase + t0 + st) * LDB_ + 3072 + h * 128 + k8;
            float hg[8]; unpack8(*(const u32x4*)gp, hg);
#pragma unroll
            for (int i = 0; i < 8; ++i) ov[i] = ov[i] * rstd * gnv[i] * siluf(hg[i]);
            *(u32x4*)gp = pack8(ov);
        }
    }
    if (Sout) {
#pragma unroll
        for (int i = 0; i < 8; ++i) *(f32x4*)(Sout + (size_t)(kgi * 8 + i) * 128 + vcol) = (f32x4){S[i][0], S[i][1], S[i][2], S[i][3]};
    }
    if (MODE == 0 && wave == 0 && vs == 0) {
#pragma unroll
        for (int i = 0; i < 8; ++i) Dout[kgi * 8 + i] = Dp[i];
    }
    __syncthreads();
}
__device__ __forceinline__ void ph_hgrn1(const Params& p, int l, LAS unsigned char* lds) {
    float* Sb = (float*)(p.ws + OFF_S); float* Db = (float*)(p.ws + OFF_D);
    constexpr int NI = NB * 8 * (NSEG - 1);
    for (int it = blockIdx.x; it < NI; it += gridDim.x) {
        const int seg = it % (NSEG - 1), bh = it / (NSEG - 1), b = bh >> 3, h = bh & 7;
        hgrn_item<0>(p, l, lds, (long)b * SEQ + seg * SEGT, SEGT, h, nullptr, Sb + ((size_t)bh * NSEG + seg + 1) * 16384, Db + ((size_t)bh * NSEG + seg) * 128);
    }
}
__device__ __forceinline__ void ph_hgrn2(const Params& p) {
    float* Sb = (float*)(p.ws + OFF_S); const float* Db = (const float*)(p.ws + OFF_D);
    const int nth = gridDim.x * 512;
    for (int e = blockIdx.x * 512 + threadIdx.x; e < NB * 8 * 16384; e += nth) {
        const int bh = e >> 14, kv = e & 16383, k = kv >> 7;
        float* base = Sb + (size_t)bh * NSEG * 16384 + kv; float carry = 0.f; base[0] = 0.f;
        for (int s = 1; s < NSEG; ++s) { const float d = Db[((size_t)bh * NSEG + (s - 1)) * 128 + k]; carry = d * carry + base[(size_t)s * 16384]; base[(size_t)s * 16384] = carry; }
    }
}
__device__ __forceinline__ void ph_hgrn3(const Params& p, int l, LAS unsigned char* lds) {
    float* Sb = (float*)(p.ws + OFF_S);
    constexpr int NPI = NB * 8 * NSEG, NSI = DB * 8;
    for (int it = blockIdx.x; it < NPI + NSI; it += gridDim.x) {
        if (it < NPI) { const int seg = it & (NSEG - 1), bh = it >> 4, b = bh >> 3, h = bh & 7;
            float* so = seg == NSEG - 1 ? p.out + O_NHP + (((size_t)l * NB + b) * 8 + h) * 16384 : nullptr;
            hgrn_item<1>(p, l, lds, (long)b * SEQ + seg * SEGT, SEGT, h, Sb + ((size_t)bh * NSEG + seg) * 16384, so, nullptr); }
        else { const int r = it - NPI, b = r >> 3, h = r & 7;
            hgrn_item<1>(p, l, lds, (long)MP + b * DSQ, DSQ, h, p.in[I_SH] + (((size_t)l * DB + b) * 8 + h) * 16384, p.out + O_NHS + (((size_t)l * DB + b) * 8 + h) * 16384, nullptr); }
    }
}

constexpr int XC_LD = 68;
template <bool SAMPLE>
__device__ __forceinline__ void lru_item(const Params& p, int l, LAS unsigned char* lds, int b, int n, int dq) {
    const int tid = threadIdx.x, d = tid & 15, typ = (tid >> 4) & 1, j = tid >> 5, ch = n * 64 + dq * 16 + d;
    bf16_t* PC = (bf16_t*)(p.ws + OFF_P);
    LAS float* xcs = (LAS float*)lds; LAS float* As = xcs + 128 * XC_LD; LAS float* Bs = As + 256; LAS float* hs = Bs + 256;
    float w[64];
    { const float* pw = p.in[typ ? I_LWX : I_LWA] + (((size_t)l * 16 + n) * 64) * 64 + dq * 16 + d;
#pragma unroll
      for (int c = 0; c < 64; ++c) w[c] = pw[c * 64]; }
    const float bias = p.in[typ ? I_LBX : I_LBA][l * 1024 + ch];
    const float lam = p.in[I_LAM][l * 1024 + ch]; const float sp = log1pf(expf(-lam));
    const float* cw = p.in[I_CW] + (size_t)l * 4 * 1024; const float* cb = p.in[I_CB] + (size_t)l * 1024;
    if (tid < 16) hs[tid] = 0.f;
    constexpr int NSG = SAMPLE ? 1 : SEQ / 128;
    for (int seg = 0; seg < NSG; ++seg) {
#pragma unroll 2
        for (int i = 0; i < 16; ++i) {
            const int idx = tid + 512 * i, t = idx >> 6, c = idx & 63, chan = n * 64 + c;
            float xc = cb[chan];
            if (!SAMPLE) { const int tg = seg * 128 + t;
#pragma unroll
                for (int jj = 0; jj < 4; ++jj) { const int ti = tg - 3 + jj; if (ti >= 0) xc += bf2f(PC[((size_t)b * SEQ + ti) * LDC_ + chan]) * cw[jj * 1024 + chan]; } }
            else { const int bb = b * 8 + (t >> 4), tok = t & 15;
#pragma unroll
                for (int jj = 0; jj < 4; ++jj) { const int ti = tok - 3 + jj;
                    const float v = ti >= 0 ? bf2f(PC[((size_t)MP + bb * DSQ + ti) * LDC_ + chan]) : p.in[I_SC][(((size_t)l * DB + bb) * 3 + (3 + ti)) * 1024 + chan];
                    xc += v * cw[jj * 1024 + chan]; } }
            xcs[t * XC_LD + c] = xc;
        }
        __syncthreads();
        float av[8], bv[8];
#pragma unroll
        for (int tt = 0; tt < 8; ++tt) {
            const int t = j * 8 + tt; const LAS float* xr = xcs + t * XC_LD;
            float s = bias;
#pragma unroll
            for (int c4 = 0; c4 < 16; ++c4) { const f32x4 x = *(const LAS f32x4*)(xr + c4 * 4);
#pragma unroll
                for (int e = 0; e < 4; ++e) s += x[e] * w[c4 * 4 + e]; }
            const float mine = sigm(s), other = __shfl_xor(mine, 16);
            const float r = typ ? other : mine, ig = typ ? mine : other;
            const float la = -8.f * r * sp;
            av[tt] = expf(la);
            bv[tt] = sqrtf(-expm1f(2.f * la)) * (ig * xr[dq * 16 + d]);
        }
        float A = 1.f, B = 0.f;
#pragma unroll
        for (int tt = 0; tt < 8; ++tt) { A *= av[tt]; B = av[tt] * B + bv[tt]; }
        if (typ == 0) { As[j * 16 + d] = A; Bs[j * 16 + d] = B; }
        __syncthreads();
        float hcur; int j0;
        if (!SAMPLE) { hcur = hs[d]; j0 = 0; } else { const int bb = b * 8 + (j >> 1); hcur = p.in[I_SL][((size_t)l * DB + bb) * 1024 + ch]; j0 = j & ~1; }
        for (int jp = j0; jp < j; ++jp) hcur = As[jp * 16 + d] * hcur + Bs[jp * 16 + d];
#pragma unroll
        for (int tt = 0; tt < 8; ++tt) {
            const int t = j * 8 + tt;
            hcur = av[tt] * hcur + bv[tt];
            if (typ == 0) {
                const size_t row = SAMPLE ? ((size_t)MP + (b * 8 + (t >> 4)) * DSQ + (t & 15)) : ((size_t)b * SEQ + seg * 128 + t);
                bf16_t* gp = PC + row * LDC_ + 1024 + ch;
                *gp = (bf16_t)f2bf(hcur * gelu_tanh(bf2f(*gp)));
            }
        }
        __syncthreads();
        if (typ == 0) {
            if (!SAMPLE) { if (j == 15) { hs[d] = hcur; if (seg == NSG - 1) p.out[O_NLP + ((size_t)l * NB + b) * 1024 + ch] = hcur; } }
            else if ((j & 1) == 1) p.out[O_NLS + ((size_t)l * DB + b * 8 + (j >> 1)) * 1024 + ch] = hcur;
        }
    }
    if (dq == 0) {
        if (!SAMPLE) { if (tid < 192) { const int r = tid >> 6, c = tid & 63; p.out[O_NCP + (((size_t)l * NB + b) * 3 + r) * 1024 + n * 64 + c] = bf2f(PC[((size_t)b * SEQ + SEQ - 3 + r) * LDC_ + n * 64 + c]); } }
        else { for (int i = tid; i < 8 * 192; i += 512) { const int bb = b * 8 + i / 192, r = (i % 192) >> 6, c = i & 63;
                p.out[O_NCS + (((size_t)l * DB + bb) * 3 + r) * 1024 + n * 64 + c] = bf2f(PC[((size_t)MP + bb * DSQ + 13 + r) * LDC_ + n * 64 + c]); } }
    }
    __syncthreads();
}
__device__ __forceinline__ void ph_lru(const Params& p, int l, LAS unsigned char* lds) {
    constexpr int NPI = NB * 64, NSI = 4 * 64;
    for (int it = blockIdx.x; it < NPI + NSI; it += gridDim.x) {
        if (it < NPI) { const int dq = it & 3, n = (it >> 2) & 15, b = it >> 6; lru_item<false>(p, l, lds, b, n, dq); }
        else { const int r = it - NPI, dq = r & 3, n = (r >> 2) & 15, bg = r >> 6; lru_item<true>(p, l, lds, bg, n, dq); }
    }
}

constexpr int NPL = 19, NPH = DEPTH * NPL;
template <int K>
__device__ __forceinline__ void run_phase(const Params& p, int l, LAS unsigned char* lds) {
    bf16_t* Wb = (bf16_t*)(p.ws + OFF_W); bf16_t* H = (bf16_t*)(p.ws + OFF_H); bf16_t* MG = (bf16_t*)(p.ws + OFF_MG); bf16_t* P = (bf16_t*)(p.ws + OFF_P);
    float* X = p.out;
    if constexpr (K == 0) { ph_convert(p, l, lds); ph_norm(p, p.in[I_NF1] + l * DM, l == 0); }
    else if constexpr (K == 1) { EpiSwiGLU e; e.G = P; run_gemm(lds, H, DM, Wb + W_UP1, 2 * DFF, DM, e); }
    else if constexpr (K == 2) { EpiResid e; e.X = X; e.scale = 0.5f; run_gemm(lds, P, DFF, Wb + W_DN1, DM, DFF, e); }
    else if constexpr (K == 3) ph_norm(p, p.in[I_NMIX] + l * DM, false);
    else if constexpr (K == 4) { EpiStore e; e.O = P; e.ldc = LDA_; run_gemm(lds, H, DM, Wb + W_IN, 2560, DM, e); }
    else if constexpr (K == 5) ph_attn(p, l, lds);
    else if constexpr (K == 6) { EpiGate e; e.MG = MG; e.gate = P + 1536; e.ldg = LDA_; e.accum = 0; run_gemm(lds, P, LDA_, Wb + W_AO, DM, DM, e); }
    else if constexpr (K == 7) { EpiStore e; e.O = P; e.ldc = LDC_; run_gemm(lds, H, DM, Wb + W_IN + (size_t)2560 * 1024, 3072, DM, e); }
    else if constexpr (K == 8) ph_lru(p, l, lds);
    else if constexpr (K == 9) { EpiGate e; e.MG = MG; e.gate = P + 2048; e.ldg = LDC_; e.accum = 1; run_gemm(lds, P + 1024, LDC_, Wb + W_LO, DM, DM, e); }
    else if constexpr (K == 10) { EpiStore e; e.O = P; e.ldc = LDB_; run_gemm(lds, H, DM, Wb + W_IN + (size_t)5632 * 1024, 5120, DM, e); }
    else if constexpr (K == 11) ph_hgrn1(p, l, lds);
    else if constexpr (K == 12) ph_hgrn2(p);
    else if constexpr (K == 13) ph_hgrn3(p, l, lds);
    else if constexpr (K == 14) { EpiGate e; e.MG = MG; e.gate = P + 4096; e.ldg = LDB_; e.accum = 1; run_gemm(lds, P + 3072, LDB_, Wb + W_HO, DM, DM, e); }
    else if constexpr (K == 15) { EpiResid e; e.X = X; e.scale = 1.f; run_gemm(lds, MG, DM, Wb + W_OUT, DM, DM, e); }
    else if constexpr (K == 16) ph_norm(p, p.in[I_NF2] + l * DM, false);
    else if constexpr (K == 17) { EpiSwiGLU e; e.G = P; run_gemm(lds, H, DM, Wb + W_UP2, 2 * DFF, DM, e); }
    else { EpiResid e; e.X = X; e.scale = 0.5f; run_gemm(lds, P, DFF, Wb + W_DN2, DM, DFF, e); }
}

__global__ void __launch_bounds__(512, 2) mega(Params p, int ph_lo, int ph_hi) {
    extern __shared__ __attribute__((aligned(16))) unsigned char shm[];
    LAS unsigned char* lds = (LAS unsigned char*)shm;
    cg::grid_group grid = cg::this_grid();
#define PHASE(L, K) { constexpr int ph = (L) * NPL + (K); if (ph >= ph_lo && ph < ph_hi) { run_phase<K>(p, L, lds); if (ph + 1 < ph_hi) grid.sync(); } }
#define LAYER(L) PHASE(L, 0) PHASE(L, 1) PHASE(L, 2) PHASE(L, 3) PHASE(L, 4) PHASE(L, 5) PHASE(L, 6) PHASE(L, 7) PHASE(L, 8) PHASE(L, 9) \
    PHASE(L, 10) PHASE(L, 11) PHASE(L, 12) PHASE(L, 13) PHASE(L, 14) PHASE(L, 15) PHASE(L, 16) PHASE(L, 17) PHASE(L, 18)
    LAYER(0)
    LAYER(1)
#undef LAYER
#undef PHASE
}

extern "C" void kernel_launch(void* const* d_in, const int* in_sizes, int n_in, void* d_out, int out_size, void* d_ws, size_t ws_size, hipStream_t stream) {
    static int grid = 0;
    if (grid == 0) {
        if (n_in != 31 || ws_size < WS_END) { fprintf(stderr, "kernel_launch: unexpected n_in %d or ws %zu < %zu\n", n_in, ws_size, (size_t)WS_END); grid = -1; return; }
        int dev = 0, cus = 0, per_cu = 0;
        hipGetDevice(&dev); hipDeviceGetAttribute(&cus, hipDeviceAttributeMultiprocessorCount, dev);
        if (hipFuncSetAttribute((const void*)mega, hipFuncAttributeMaxDynamicSharedMemorySize, LDS_BYTES) != hipSuccess) { fprintf(stderr, "hipFuncSetAttribute failed\n"); grid = -1; return; }
        if (hipOccupancyMaxActiveBlocksPerMultiprocessor(&per_cu, (const void*)mega, 512, LDS_BYTES) != hipSuccess || per_cu < 1) { fprintf(stderr, "occupancy query: %d\n", per_cu); per_cu = 1; }
        (void)hipGetLastError();
        grid = cus * 1;
    }
    if (grid < 0) return;
    Params p{};
    for (int i = 0; i < 31; ++i) p.in[i] = (const float*)d_in[i];
    p.out = (float*)d_out; p.ws = (unsigned char*)d_ws;
#if ONE_LAUNCH
    int lo = 0, hi = NPH;
    void* args[] = {&p, &lo, &hi};
    hipError_t e = hipLaunchCooperativeKernel((const void*)mega, dim3(grid), dim3(512), args, LDS_BYTES, stream);
    if (e != hipSuccess) fprintf(stderr, "cooperative launch failed: %s (grid %d)\n", hipGetErrorString(e), grid);
#else
    for (int ph = 0; ph < NPH; ++ph) mega<<<dim3(grid), dim3(512), LDS_BYTES, stream>>>(p, ph, ph + 1);
#endif
}
```

```cpp
#include <hip/hip_runtime.h>
#include <hip/hip_cooperative_groups.h>
#include <cstdio>
#include <cstdint>
namespace cg = cooperative_groups;

#ifndef ONE_LAUNCH
#define ONE_LAUNCH 1
#endif

#ifndef DUP_MASK
#define DUP_MASK 0
#endif
#define LAS __attribute__((address_space(3)))
typedef unsigned short bf16_t;
typedef short bf16x8 __attribute__((ext_vector_type(8)));
typedef short bf16x4 __attribute__((ext_vector_type(4)));
typedef float f32x4 __attribute__((ext_vector_type(4)));
typedef unsigned u32x4 __attribute__((ext_vector_type(4)));
typedef unsigned u32x2 __attribute__((ext_vector_type(2)));

constexpr int DM = 1024, NB = 4, SEQ = 4096, DEPTH = 2, DB = 32, DSQ = 16, DFF = 2816;
constexpr int MP = NB * SEQ, MS = DB * DSQ, MT = MP + MS;
constexpr int INC = 10752;
constexpr int LDA_ = 2560, LDC_ = 5120, LDB_ = 5120;
constexpr float EPS = 1e-6f;
constexpr int NSEG = 16, SEGT = 256;

constexpr size_t W_UP1 = 0, W_DN1 = W_UP1 + (size_t)5632 * 1024, W_IN = W_DN1 + (size_t)1024 * 2816, W_AO = W_IN + (size_t)INC * 1024,
                 W_HO = W_AO + 1048576, W_LO = W_HO + 1048576, W_OUT = W_LO + 1048576, W_UP2 = W_OUT + 1048576, W_DN2 = W_UP2 + (size_t)5632 * 1024,
                 W_LRU = W_DN2 + (size_t)1024 * 2816, W_END = W_LRU + (size_t)2048 * 256;
constexpr size_t OFF_W = 0, OFF_H = OFF_W + W_END * 2, OFF_MG = OFF_H + (size_t)MT * 1024 * 2, OFF_P = OFF_MG + (size_t)MT * 1024 * 2,
                 OFF_S = OFF_P + (size_t)MT * 5120 * 2, OFF_D = OFF_S + (size_t)NB * 8 * NSEG * 16384 * 4, WS_END = OFF_D + (size_t)NB * 8 * NSEG * 128 * 4;
constexpr size_t O_NKP = 17301504, O_NVP = 17563648, O_NHP = 17825792, O_NCP = 18874368, O_NLP = 18898944, O_NKS = 18907136, O_NVS = 19169280,
                 O_NHS = 19431424, O_NCS = 27820032, O_NLS = 28016640;

constexpr int LDS_MAIN = 156416, LDS_BYTES = LDS_MAIN + 16;
constexpr size_t OFF_BAR = (WS_END + 255) / 256 * 256, WS_NEED = OFF_BAR + 3456 * 4;

struct Params { const float* in[31]; float* out; unsigned char* ws; unsigned* bar; long one; };
enum { I_XP = 0, I_XS, I_CK, I_CV, I_SH, I_SC, I_SL, I_NF1, I_UP1, I_DN1, I_NMIX, I_WIN, I_QN, I_KN, I_SINK, I_WAO, I_LBL, I_HON, I_WHO, I_CW, I_CB,
       I_LWA, I_LBA, I_LWX, I_LBX, I_LAM, I_WLO, I_WOUT, I_NF2, I_UP2, I_DN2 };

__device__ __forceinline__ float bf2f(unsigned v) { return __uint_as_float(v << 16); }
__device__ __forceinline__ unsigned f2bf(float f) { unsigned u = __float_as_uint(f); u += 0x7FFFu + ((u >> 16) & 1u); return u >> 16; }
__device__ __forceinline__ unsigned pk2(float lo, float hi) { return f2bf(lo) | (f2bf(hi) << 16); }
__device__ __forceinline__ float sigm(float x) { return 1.f / (1.f + __expf(-x)); }
__device__ __forceinline__ float siluf(float x) { return x / (1.f + __expf(-x)); }
__device__ __forceinline__ float gelu_tanh(float x) { const float u = 0.7978845608028654f * (x + 0.044715f * x * x * x); const float e = __expf(2.f * u); const float th = 1.f - 2.f / (e + 1.f); return 0.5f * x * (1.f + th); }
__device__ __forceinline__ void unpack8(u32x4 r, float (&o)[8]) {
    o[0] = bf2f(r.x & 0xffffu); o[1] = bf2f(r.x >> 16); o[2] = bf2f(r.y & 0xffffu); o[3] = bf2f(r.y >> 16);
    o[4] = bf2f(r.z & 0xffffu); o[5] = bf2f(r.z >> 16); o[6] = bf2f(r.w & 0xffffu); o[7] = bf2f(r.w >> 16);
}
__device__ __forceinline__ u32x4 pack8(const float (&v)[8]) { u32x4 r; r.x = pk2(v[0], v[1]); r.y = pk2(v[2], v[3]); r.z = pk2(v[4], v[5]); r.w = pk2(v[6], v[7]); return r; }
__device__ __forceinline__ int tid_opaque() { int t = (int)__builtin_amdgcn_workitem_id_x(); asm volatile("" : "+v"(t)); return t; }
typedef float f32x2 __attribute__((ext_vector_type(2)));
template <int N> __device__ __forceinline__ float row_ror(float x) { return __builtin_bit_cast(float, __builtin_amdgcn_update_dpp(0, __builtin_bit_cast(int, x), 0x120 + N, 0xf, 0xf, false)); }
#define LDS_WAIT() asm volatile("s_waitcnt lgkmcnt(0)" ::: "memory")

namespace pg8 {
constexpr int BM = 256, BK = 64, HALF = 128, HTB = HALF * BK * 2, STAGE_BYTES = 8 * HTB, NXCD = 8, WGM = 8;
__device__ __forceinline__ int lds_byte(int r, int c) { const int st = (r >> 4) * 2 + (c >> 5), rr = r & 15, cc = c & 31, ob = rr * 64 + cc * 2; return st * 1024 + (ob ^ (((ob >> 9) & 1) << 5)); }
__device__ __forceinline__ void stage_rc(int b, int& R, int& C) { const int st = b / 1024, sb = b % 1024, swz = sb ^ (((sb >> 9) & 1) << 5); R = (st >> 1) * 16 + swz / 64; C = (st & 1) * 32 + (swz % 64) / 2; }
struct Unit { int pm, pn, aoff, boff; };
struct Gemm { const bf16_t* A; const bf16_t* Bt; int M, N, K, lda, ldb; };
struct StaticOrder {
    int nM, nN, nwg, G, c;
    __device__ void init(int M, int N, int G_, int c_) { nM = M / BM; nN = N / BM; nwg = nM * nN; G = G_; c = c_; }
    __device__ bool next(int i, Unit& u) const {
        const long L = (long)i * G + c; if (L >= nwg) return false;
        int wgid = (int)L; { const int q = nwg / NXCD, r = nwg % NXCD, xcd = wgid % NXCD, off = wgid / NXCD; wgid = (xcd < r ? xcd * (q + 1) : r * (q + 1) + (xcd - r) * q) + off; }
        const int nig = WGM * nN, gid = wgid / nig, fm = gid * WGM, gsz = (nM - fm) < WGM ? (nM - fm) : WGM;
        u.pm = fm + ((wgid % nig) % gsz); u.pn = (wgid % nig) / gsz; u.aoff = 0; u.boff = 0; return true;
    }
};
struct LruOrder : StaticOrder {
    __device__ bool next(int i, Unit& u) const { if (!StaticOrder::next(i, u)) return false; u.aoff = (u.pn >> 1) * 512; return true; }
};
struct SplitOrder {
    int nchunk, total, c;
    __device__ void init(int nunits, int nchunk_, int c_) { nchunk = nchunk_; total = nunits * nchunk_; c = c_; }
    __device__ bool next(int i, Unit& u) const { if (i != 0 || c >= total) return false; const int unit = c / nchunk, ch = c % nchunk; u.pm = unit >> 2; u.pn = unit & 3; u.aoff = ch * 512; u.boff = ch * 512; return true; }
};
struct TailOrder {
    int c;
    __device__ bool next(int i, Unit& u) const { if (c < 0 || i > 0 || c >= 40) return false; u.pm = 64 + c / 20; u.pn = c % 20; u.aoff = 0; u.boff = 0; return true; }
};
template <class Epi, class Sched>
__device__ __forceinline__ void gemm_phase(LAS unsigned char* lds, const Gemm g, const Sched& S, const Epi& E) {
    const int tid = tid_opaque(), wid = __builtin_amdgcn_readfirstlane(tid >> 6), lane = tid & 63, wr = wid >> 2, wc = wid & 3, fr = lane & 15, fq = lane >> 4;
    const int K = g.K, nt = K / BK, lda = g.lda, ldb = g.ldb;
    unsigned voffA[2], voffB[2];
#pragma unroll
    for (int i = 0; i < 2; ++i) { int R, C; stage_rc(tid * 16 + i * 8192, R, C); voffA[i] = (unsigned)(R * lda + C) * 2u; voffB[i] = (unsigned)(R * ldb + C) * 2u; }
    const size_t kstep = (size_t)(BK * 2);
    const size_t hstepA = (size_t)HALF * lda * 2, tstepA = 2 * hstepA;
    const size_t hstepB = (size_t)HALF * ldb * 2, tstepB = 2 * hstepB;
    const unsigned ldsw = (unsigned)wid * 1024u;
    const int aoff = lds_byte(wr * 64 + fr, fq * 8), boff = lds_byte(wc * 32 + fr, fq * 8);
#define PG8_SA(b, h) (((b) * 2 + (h)) * HTB)
#define PG8_SB(b, h) ((4 + (b) * 2 + (h)) * HTB)
#define PG8_STAGE(bufoff, gbase, voff) do { _Pragma("unroll") for (int _i = 0; _i < 2; ++_i) \
        __builtin_amdgcn_global_load_lds((const unsigned*)((const char*)(gbase) + (voff)[_i]), (LAS unsigned*)(lds + (bufoff) + ldsw + _i * 8192), 16, 0, 0); } while (0)
#define PG8_LDA(dst, b, h) do { _Pragma("unroll") for (int m = 0; m < 4; ++m) _Pragma("unroll") for (int k = 0; k < 2; ++k) dst[m][k] = *(const LAS bf16x8*)(lds + PG8_SA(b, h) + aoff + m * 2048 + k * 1024); } while (0)
#define PG8_LDB(dst, b, h) do { _Pragma("unroll") for (int n = 0; n < 2; ++n) _Pragma("unroll") for (int k = 0; k < 2; ++k) dst[n][k] = *(const LAS bf16x8*)(lds + PG8_SB(b, h) + boff + n * 2048 + k * 1024); } while (0)
#define PG8_MMA(ai, bj, At, Bt) do { __builtin_amdgcn_s_setprio(1); _Pragma("unroll") for (int m = 0; m < 4; ++m) _Pragma("unroll") for (int n = 0; n < 2; ++n) _Pragma("unroll") for (int k = 0; k < 2; ++k) \
        acc[ai][bj][m][n] = __builtin_amdgcn_mfma_f32_16x16x32_bf16(Bt[n][k], At[m][k], acc[ai][bj][m][n], 0, 0, 0); __builtin_amdgcn_s_setprio(0); } while (0)
#define PG8_WAIT_V(n) asm volatile("s_waitcnt vmcnt(" #n ")" ::: "memory")
#define PG8_WAIT_L(n) asm volatile("s_waitcnt lgkmcnt(" #n ")" ::: "memory")
#define PG8_BAR __builtin_amdgcn_s_barrier()
#define PG8_SCHED __builtin_amdgcn_sched_barrier(0)
    Unit cur, nxt; int ui = 0;
    if (!S.next(0, cur)) return;
    f32x4 acc[2][2][4][2];
#pragma unroll
    for (int a = 0; a < 2; ++a)
#pragma unroll
        for (int b = 0; b < 2; ++b)
#pragma unroll
            for (int m = 0; m < 4; ++m)
#pragma unroll
                for (int n = 0; n < 2; ++n) acc[a][b][m][n] = (f32x4){0.f, 0.f, 0.f, 0.f};
    bf16x8 At[4][2], B0[2][2], B1[2][2];
    const char* cA = (const char*)g.A + (size_t)cur.pm * tstepA + cur.aoff; const char* cB = (const char*)g.Bt + (size_t)cur.pn * tstepB + cur.boff;
    PG8_STAGE(PG8_SB(0, 0), cB, voffB); PG8_STAGE(PG8_SA(0, 0), cA, voffA); PG8_STAGE(PG8_SB(0, 1), cB + hstepB, voffB); PG8_STAGE(PG8_SA(0, 1), cA + hstepA, voffA);
    if (wr == 1) PG8_BAR;
    PG8_WAIT_V(4); PG8_BAR;
    PG8_STAGE(PG8_SB(1, 0), cB + kstep, voffB); PG8_STAGE(PG8_SA(1, 0), cA + kstep, voffA); PG8_STAGE(PG8_SB(1, 1), cB + hstepB + kstep, voffB);
    PG8_WAIT_V(6); PG8_BAR;
    for (;;) {
        const bool has_next = S.next(ui + 1, nxt);
        const char* nA = has_next ? (const char*)g.A + (size_t)nxt.pm * tstepA + nxt.aoff : cA; const char* nB = has_next ? (const char*)g.Bt + (size_t)nxt.pn * tstepB + nxt.boff : cB;
        for (int t = 0; t < nt; t += 2) {
            const bool last = (t == nt - 2);
            const char* a1 = cA + (size_t)(t + 1) * kstep;
            const char* a2 = last ? nA : cA + (size_t)(t + 2) * kstep; const char* b2 = last ? nB : cB + (size_t)(t + 2) * kstep;
            const char* a3 = a2 + kstep; const char* b3 = b2 + kstep;
            PG8_LDB(B0, 0, 0); PG8_SCHED; PG8_LDA(At, 0, 0); PG8_STAGE(PG8_SA(1, 1), a1 + hstepA, voffA);
            PG8_WAIT_L(8); PG8_BAR; PG8_WAIT_L(0); PG8_MMA(0, 0, At, B0); PG8_BAR; PG8_SCHED;
            PG8_LDB(B1, 0, 1); PG8_STAGE(PG8_SB(0, 0), b2, voffB);
            PG8_BAR; PG8_WAIT_L(0); PG8_MMA(0, 1, At, B1); PG8_BAR;
            PG8_LDA(At, 0, 1); PG8_STAGE(PG8_SA(0, 0), a2, voffA);
            PG8_BAR; PG8_WAIT_L(0); PG8_MMA(1, 0, At, B0); PG8_BAR; PG8_SCHED;
            PG8_STAGE(PG8_SB(0, 1), b2 + hstepB, voffB);
            PG8_WAIT_V(6); PG8_BAR; PG8_MMA(1, 1, At, B1); PG8_BAR;
            PG8_LDB(B0, 1, 0); PG8_SCHED; PG8_LDA(At, 1, 0); PG8_STAGE(PG8_SA(0, 1), a2 + hstepA, voffA);
            PG8_WAIT_L(8); PG8_BAR; PG8_WAIT_L(0); PG8_MMA(0, 0, At, B0); PG8_BAR; PG8_SCHED;
            PG8_LDB(B1, 1, 1); PG8_STAGE(PG8_SB(1, 0), b3, voffB);
            PG8_BAR; PG8_WAIT_L(0); PG8_MMA(0, 1, At, B1); PG8_BAR;
            PG8_LDA(At, 1, 1); PG8_STAGE(PG8_SA(1, 0), a3, voffA);
            PG8_BAR; PG8_WAIT_L(0); PG8_MMA(1, 0, At, B0); PG8_BAR; PG8_SCHED;
            PG8_STAGE(PG8_SB(1, 1), b3 + hstepB, voffB);
            PG8_WAIT_V(6); PG8_BAR; PG8_MMA(1, 1, At, B1); PG8_BAR;
        }
        E(acc, cur, wr, wc, fr, fq);
        if (!has_next) break;
#pragma unroll
        for (int a = 0; a < 2; ++a)
#pragma unroll
            for (int b = 0; b < 2; ++b)
#pragma unroll
                for (int m = 0; m < 4; ++m)
#pragma unroll
                    for (int n = 0; n < 2; ++n) acc[a][b][m][n] = (f32x4){0.f, 0.f, 0.f, 0.f};
        cur = nxt; cA = nA; cB = nB; ++ui;
    }
    PG8_WAIT_V(0);
    if (wr == 0) PG8_BAR;
    PG8_BAR;
#undef PG8_SA
#undef PG8_SB
#undef PG8_STAGE
#undef PG8_LDA
#undef PG8_LDB
#undef PG8_MMA
#undef PG8_WAIT_V
#undef PG8_WAIT_L
#undef PG8_BAR
#undef PG8_SCHED
}
}
using pg8::Unit;

template <int LRU> struct EpiStoreT {
    bf16_t* O; int ldc;
    __device__ __forceinline__ void operator()(const f32x4 (&acc)[2][2][4][2], const Unit& u, int wr, int wc, int fr, int fq) const {
        const int row0 = u.pm * 256 + wr * 64 + fr, col0 = (LRU ? 3072 + (u.pn & 1) * 1024 + (u.pn >> 1) * 256 : u.pn * 256) + wc * 32 + 4 * fq;
#pragma unroll
        for (int ai = 0; ai < 2; ++ai)
#pragma unroll
            for (int m = 0; m < 4; ++m) { bf16_t* rowp = O + (size_t)(row0 + ai * 128 + m * 16) * ldc + col0;
#pragma unroll
                for (int bj = 0; bj < 2; ++bj)
#pragma unroll
                    for (int n = 0; n < 2; ++n) { const f32x4 v = acc[ai][bj][m][n]; u32x2 w; w.x = pk2(v[0], v[1]); w.y = pk2(v[2], v[3]); *(u32x2*)(rowp + bj * 128 + n * 16) = w; } }
    }
};
struct EpiSwiGLU {
    bf16_t* G;
    __device__ __forceinline__ void operator()(const f32x4 (&acc)[2][2][4][2], const Unit& u, int wr, int wc, int fr, int fq) const {
        const int row0 = u.pm * 256 + wr * 64 + fr, col0 = (u.pn * 256 + wc * 32) / 2 + 4 * fq;
#pragma unroll
        for (int ai = 0; ai < 2; ++ai)
#pragma unroll
            for (int m = 0; m < 4; ++m) { bf16_t* rowp = G + (size_t)(row0 + ai * 128 + m * 16) * DFF + col0;
#pragma unroll
                for (int bj = 0; bj < 2; ++bj) { const f32x4 gt = acc[ai][bj][m][0], vl = acc[ai][bj][m][1]; u32x2 w;
                    w.x = pk2(siluf(gt[0]) * vl[0], siluf(gt[1]) * vl[1]); w.y = pk2(siluf(gt[2]) * vl[2], siluf(gt[3]) * vl[3]); *(u32x2*)(rowp + bj * 64) = w; } }
    }
};
struct EpiResid {
    float* X; float scale;
    __device__ __forceinline__ void operator()(const f32x4 (&acc)[2][2][4][2], const Unit& u, int wr, int wc, int fr, int fq) const {
        const int row0 = u.pm * 256 + wr * 64 + fr, col0 = u.pn * 256 + wc * 32 + 4 * fq;
#pragma unroll
        for (int ai = 0; ai < 2; ++ai)
#pragma unroll
            for (int m = 0; m < 4; ++m) { float* rowp = X + (size_t)(row0 + ai * 128 + m * 16) * DM + col0;
#pragma unroll
                for (int bj = 0; bj < 2; ++bj)
#pragma unroll
                    for (int n = 0; n < 2; ++n) { f32x4* q = (f32x4*)(rowp + bj * 128 + n * 16); const f32x4 o = *q; *q = o + acc[ai][bj][m][n] * scale; } }
    }
};
struct EpiPart {
    float* PART; float scale;
    __device__ __forceinline__ void operator()(const f32x4 (&acc)[2][2][4][2], const Unit& u, int wr, int wc, int fr, int fq) const {
        const int row0 = u.pm * 256 + wr * 64 + fr, col0 = u.pn * 256 + wc * 32 + 4 * fq;
        float* base = PART + (size_t)(u.aoff >> 9) * MS * DM;
#pragma unroll
        for (int ai = 0; ai < 2; ++ai)
#pragma unroll
            for (int m = 0; m < 4; ++m) { float* rowp = base + (size_t)(row0 + ai * 128 + m * 16) * DM + col0;
#pragma unroll
                for (int bj = 0; bj < 2; ++bj)
#pragma unroll
                    for (int n = 0; n < 2; ++n) *(f32x4*)(rowp + bj * 128 + n * 16) = acc[ai][bj][m][n] * scale; }
    }
};
struct EpiGate {
    bf16_t* MG; const bf16_t* gate; int ldg; int accum;
    __device__ __forceinline__ void operator()(const f32x4 (&acc)[2][2][4][2], const Unit& u, int wr, int wc, int fr, int fq) const {
        const int row0 = u.pm * 256 + wr * 64 + fr, col0 = u.pn * 256 + wc * 32 + 4 * fq;
#pragma unroll
        for (int ai = 0; ai < 2; ++ai)
#pragma unroll
            for (int m = 0; m < 4; ++m) { const size_t r = (size_t)(row0 + ai * 128 + m * 16); bf16_t* rowp = MG + r * DM + col0; const bf16_t* gp = gate + r * ldg + col0;
#pragma unroll
                for (int bj = 0; bj < 2; ++bj)
#pragma unroll
                    for (int n = 0; n < 2; ++n) { const f32x4 v = acc[ai][bj][m][n]; const u32x2 gw = *(const u32x2*)(gp + bj * 128 + n * 16);
                        float o0 = sigm(bf2f(gw.x & 0xffffu)) * v[0], o1 = sigm(bf2f(gw.x >> 16)) * v[1], o2 = sigm(bf2f(gw.y & 0xffffu)) * v[2], o3 = sigm(bf2f(gw.y >> 16)) * v[3];
                        u32x2* q = (u32x2*)(rowp + bj * 128 + n * 16);
                        if (accum) { const u32x2 old = *q; o0 += bf2f(old.x & 0xffffu); o1 += bf2f(old.x >> 16); o2 += bf2f(old.y & 0xffffu); o3 += bf2f(old.y >> 16); }
                        u32x2 w; w.x = pk2(o0, o1); w.y = pk2(o2, o3); *q = w; } }
    }
};
template <class Epi> __device__ __forceinline__ void run_gemm(LAS unsigned char* lds, const bf16_t* A, int lda, const bf16_t* Bt, int N, int K, const Epi& E, int Mrows = MT) {
    pg8::Gemm g; g.A = A; g.Bt = Bt; g.M = Mrows; g.N = N; g.K = K; g.lda = lda; g.ldb = K;
    pg8::StaticOrder S; S.init(Mrows, N, (int)gridDim.x, (int)blockIdx.x);
    pg8::gemm_phase<Epi, pg8::StaticOrder>(lds, g, S, E);
}
__device__ __forceinline__ void run_gemm_resid(LAS unsigned char* lds, const bf16_t* A, int lda, const bf16_t* Bt, int K, float* X, float scale, float* PART) {
    EpiResid e; e.X = X; e.scale = scale;
    run_gemm(lds, A, lda, Bt, DM, K, e, MP);
    EpiPart ea; ea.PART = PART; ea.scale = scale;
    pg8::Gemm g; g.A = A + (size_t)MP * lda; g.Bt = Bt; g.M = MS; g.N = DM; g.K = 256; g.lda = lda; g.ldb = K;
    pg8::SplitOrder S; S.init(8, K / 256, (int)blockIdx.x);
    pg8::gemm_phase<EpiPart, pg8::SplitOrder>(lds, g, S, ea);
}
typedef EpiStoreT<0> EpiStore; typedef EpiStoreT<1> EpiStoreLru;
__device__ __forceinline__ void run_gemm_lru(LAS unsigned char* lds, const bf16_t* A, const bf16_t* Bt, const EpiStoreLru& E) {
    pg8::Gemm g; g.A = A; g.Bt = Bt; g.M = MT; g.N = 2048; g.K = 256; g.lda = DM; g.ldb = 256;
    pg8::LruOrder S; S.init(MT, 2048, (int)gridDim.x, (int)blockIdx.x);
    pg8::gemm_phase<EpiStoreLru, pg8::LruOrder>(lds, g, S, E);
}

__device__ __forceinline__ int srccol(int kind, int j) {
    if (kind == 0) return j;
    if (kind == 1) { const int grp = j >> 5, w = j & 31; return w < 16 ? grp * 16 + w : DFF + grp * 16 + (w - 16); }
    if (j < 1536) return j;
    if (j < 2560) return 7680 + (j - 1536);
    if (j < 4608) return 5632 + (j - 2560);
    if (j < 5632) return 9728 + (j - 4608);
    if (j < 9728) return 1536 + (j - 5632);
    return 8704 + (j - 9728);
}
__device__ __forceinline__ void conv_item(const float* W, int K, int N, bf16_t* WT, int kind, LAS float* scr, int item, int lane) {
    const int nblk = N / 32, kb = item / nblk, nb = item % nblk, k0 = 64 * kb, n0 = 32 * nb;
    const int sc = srccol(kind, n0 + (lane & 31));
    float wv[32];
#pragma unroll
    for (int i = 0; i < 32; ++i) { const int kk = 2 * i + (lane >> 5); wv[i] = W[(size_t)(k0 + kk) * N + sc]; }
#pragma unroll
    for (int i = 0; i < 32; ++i) { const int kk = 2 * i + (lane >> 5); scr[kk * 33 + (lane & 31)] = wv[i]; }
    LDS_WAIT();
    const int c = lane & 7;
#pragma unroll
    for (int j = 0; j < 4; ++j) { const int n = (lane >> 3) + 8 * j; const LAS float* s = scr + (8 * c) * 33 + n;
        u32x4 o; o.x = pk2(s[0 * 33], s[1 * 33]); o.y = pk2(s[2 * 33], s[3 * 33]); o.z = pk2(s[4 * 33], s[5 * 33]); o.w = pk2(s[6 * 33], s[7 * 33]);
        *(u32x4*)(WT + (size_t)(n0 + n) * K + k0 + 8 * c) = o; }
    LDS_WAIT();
}
__device__ __forceinline__ void ph_convert(const Params& p, int l, LAS unsigned char* lds) {
    const int wave = tid_opaque() >> 6, lane = tid_opaque() & 63;
    LAS float* scr = (LAS float*)(lds + wave * 8704);
    bf16_t* Wb = (bf16_t*)(p.ws + OFF_W);
    const int gw = blockIdx.x * 8 + wave, NGW = gridDim.x * 8;
    constexpr int I_UP = (1024 / 64) * (5632 / 32), I_DN = (2816 / 64) * (1024 / 32), I_IN = (1024 / 64) * (INC / 32), I_SQ = (1024 / 64) * (1024 / 32);
    constexpr int NIT = 2 * I_UP + 2 * I_DN + I_IN + 4 * I_SQ;
    for (int it = gw; it < NIT; it += NGW) {
        int r = it;
        if (r < I_UP) { conv_item(p.in[I_UP1] + (size_t)l * 1024 * 5632, 1024, 5632, Wb + W_UP1, 1, scr, r, lane); continue; } r -= I_UP;
        if (r < I_DN) { conv_item(p.in[I_DN1] + (size_t)l * 2816 * 1024, 2816, 1024, Wb + W_DN1, 0, scr, r, lane); continue; } r -= I_DN;
        if (r < I_IN) { conv_item(p.in[I_WIN] + (size_t)l * 1024 * INC, 1024, INC, Wb + W_IN, 2, scr, r, lane); continue; } r -= I_IN;
        if (r < I_SQ) { conv_item(p.in[I_WAO] + (size_t)l * 1048576, 1024, 1024, Wb + W_AO, 0, scr, r, lane); continue; } r -= I_SQ;
        if (r < I_SQ) { conv_item(p.in[I_WHO] + (size_t)l * 1048576, 1024, 1024, Wb + W_HO, 0, scr, r, lane); continue; } r -= I_SQ;
        if (r < I_SQ) { conv_item(p.in[I_WLO] + (size_t)l * 1048576, 1024, 1024, Wb + W_LO, 0, scr, r, lane); continue; } r -= I_SQ;
        if (r < I_SQ) { conv_item(p.in[I_WOUT] + (size_t)l * 1048576, 1024, 1024, Wb + W_OUT, 0, scr, r, lane); continue; } r -= I_SQ;
        if (r < I_UP) { conv_item(p.in[I_UP2] + (size_t)l * 1024 * 5632, 1024, 5632, Wb + W_UP2, 1, scr, r, lane); continue; } r -= I_UP;
        conv_item(p.in[I_DN2] + (size_t)l * 2816 * 1024, 2816, 1024, Wb + W_DN2, 0, scr, r, lane);
    }
    for (int idx = blockIdx.x * 512 + tid_opaque(); idx < 2048 * 256; idx += gridDim.x * 512) {
        const int j = idx >> 8, k = idx & 255, pn = j >> 8, i = j & 255, g = pn >> 1, typ = pn & 1;
        const int blk = g * 4 + (i >> 6), dd = i & 63, blk_in = g * 4 + (k >> 6), cc = k & 63;
        float v = 0.f;
        if (blk == blk_in) v = p.in[typ ? I_LWX : I_LWA][(((size_t)l * 16 + blk) * 64 + cc) * 64 + dd];
        Wb[W_LRU + idx] = (bf16_t)f2bf(v);
    }
}

__device__ __forceinline__ float wave_sum(float v) {
#pragma unroll
    for (int o = 1; o < 64; o <<= 1) v += __shfl_xor(v, o);
    return v;
}
__device__ __forceinline__ void ph_norm(const Params& p, const float* g, bool init, int nchunk) {
    const int wave = tid_opaque() >> 6, lane = tid_opaque() & 63;
    const int gw = blockIdx.x * 8 + wave, NGW = gridDim.x * 8;
    float* X = p.out; bf16_t* H = (bf16_t*)(p.ws + OFF_H);
    f32x4 gv[4];
#pragma unroll
    for (int j = 0; j < 4; ++j) gv[j] = ((const f32x4*)g)[lane + 64 * j];
    for (int row = gw; row < MT; row += NGW) {
        const float* src = init ? (row < MP ? p.in[I_XP] + (size_t)row * DM : p.in[I_XS] + (size_t)(row - MP) * DM) : X + (size_t)row * DM;
        f32x4 v[4]; float s = 0.f;
#pragma unroll
        for (int j = 0; j < 4; ++j) v[j] = ((const f32x4*)src)[lane + 64 * j];
        const bool fold = !init && row >= MP && nchunk > 0;
        if (fold) { const float* part = (const float*)(p.ws + OFF_S) + (size_t)(row - MP) * DM;
            for (int c = 0; c < nchunk; ++c)
#pragma unroll
                for (int j = 0; j < 4; ++j) v[j] += ((const f32x4*)(part + (size_t)c * MS * DM))[lane + 64 * j]; }
#pragma unroll
        for (int j = 0; j < 4; ++j) s += (v[j][0] * v[j][0] + v[j][1] * v[j][1]) + (v[j][2] * v[j][2] + v[j][3] * v[j][3]);
        s = wave_sum(s);
        const float rstd = rsqrtf(s * (1.f / DM) + EPS);
#pragma unroll
        for (int j = 0; j < 4; ++j) { u32x2 w; w.x = pk2(v[j][0] * rstd * gv[j][0], v[j][1] * rstd * gv[j][1]); w.y = pk2(v[j][2] * rstd * gv[j][2], v[j][3] * rstd * gv[j][3]);
            *(u32x2*)(H + (size_t)row * DM + (lane + 64 * j) * 4) = w;
            if (init || fold) ((f32x4*)(X + (size_t)row * DM))[lane + 64 * j] = v[j]; }
    }
}

constexpr int KS_LD = 72, VT_LD = 200;
constexpr int KS_OFF = 0, VT_OFF = 192 * KS_LD * 2;
template <bool SAMPLE>
__device__ __forceinline__ void attn_item(const Params& p, int l, LAS unsigned char* lds, int b, int c, int kvh, bool dry) {
    const int tid = tid_opaque(), wave = tid >> 6, lane = tid & 63, l15 = lane & 15, quad = lane >> 4;
    bf16_t* PA = (bf16_t*)(p.ws + OFF_P);
    LAS bf16_t* Ks = (LAS bf16_t*)(lds + KS_OFF); LAS bf16_t* Vt = (LAS bf16_t*)(lds + VT_OFF);
    const float* kg = p.in[I_KN] + l * 64; const float* qg = p.in[I_QN] + l * 64;
    constexpr int NQT = SAMPLE ? 1 : 2, NKT = SAMPLE ? 10 : 12;
    const bool active = SAMPLE ? (wave < 4) : true;
    const int g = SAMPLE ? (wave & 3) : (wave >> 1), tokbase = SAMPLE ? 0 : (wave & 1) * 32;
    const int hq = kvh * 4 + g;
    u32x4 qraw[NQT][2]; long qrow[NQT];
#pragma unroll
    for (int qt = 0; qt < NQT; ++qt) {
        const int tok = tokbase + qt * 16 + l15;
        qrow[qt] = SAMPLE ? ((long)MP + b * DSQ + tok) : ((long)b * SEQ + c * 64 + tok);
        const bf16_t* qp = PA + qrow[qt] * LDA_ + hq * 64;
        qraw[qt][0] = *(const u32x4*)(qp + quad * 8); qraw[qt][1] = *(const u32x4*)(qp + 32 + quad * 8);
    }
    {
        const int d8 = (tid & 7) * 8;
        float kgv[8];
#pragma unroll
        for (int i = 0; i < 8; ++i) kgv[i] = kg[d8 + i];
#pragma unroll
        for (int pass = 0; pass < 3; ++pass) {
            const int j = pass * 64 + (tid >> 3);
            float kf[8], vf[8]; bool valid, need_norm; long row = 0;
            if (!SAMPLE) { const int tk = (c - 2) * 64 + j; valid = tk >= 0; need_norm = true; row = (long)b * SEQ + tk; }
            else { valid = j < 144; need_norm = j >= 128; row = (long)MP + b * DSQ + (j - 128); }
            if (valid && need_norm) {
                const u32x4 kr = *(const u32x4*)(PA + row * LDA_ + 1024 + kvh * 64 + d8); const u32x4 vr = *(const u32x4*)(PA + row * LDA_ + 1280 + kvh * 64 + d8);
                unpack8(kr, kf); unpack8(vr, vf);
            } else if (valid) {
                const float* ck = p.in[I_CK] + ((((size_t)l * DB + b) * 128 + j) * 4 + kvh) * 64 + d8; const float* cv = p.in[I_CV] + ((((size_t)l * DB + b) * 128 + j) * 4 + kvh) * 64 + d8;
                const f32x4 a0 = *(const f32x4*)ck, a1 = *(const f32x4*)(ck + 4), b0 = *(const f32x4*)cv, b1 = *(const f32x4*)(cv + 4);
#pragma unroll
                for (int i = 0; i < 4; ++i) { kf[i] = a0[i]; kf[4 + i] = a1[i]; vf[i] = b0[i]; vf[4 + i] = b1[i]; }
            } else {
#pragma unroll
                for (int i = 0; i < 8; ++i) { kf[i] = 0.f; vf[i] = 0.f; }
            }
            float ss = 0.f;
#pragma unroll
            for (int i = 0; i < 8; ++i) ss += kf[i] * kf[i];
            ss += __shfl_xor(ss, 1); ss += __shfl_xor(ss, 2); ss += __shfl_xor(ss, 4);
            if (need_norm) { const float rstd = rsqrtf(ss * (1.f / 64.f) + EPS);
#pragma unroll
                for (int i = 0; i < 8; ++i) kf[i] = kf[i] * rstd * kgv[i]; }
            *(LAS u32x4*)(Ks + j * KS_LD + d8) = pack8(kf);
#pragma unroll
            for (int i = 0; i < 8; ++i) Vt[(d8 + i) * VT_LD + j] = (bf16_t)f2bf(vf[i]);
            if (!SAMPLE) { const int tk = (c - 2) * 64 + j;
                if (j >= 128 && tk >= SEQ - 128) { const size_t o = ((((size_t)l * NB + b) * 128 + (tk - (SEQ - 128))) * 4 + kvh) * 64 + d8;
#pragma unroll
                    for (int i = 0; i < 8; ++i) { p.out[O_NKP + o + i] = kf[i]; p.out[O_NVP + o + i] = vf[i]; } } }
            else if (j >= 128 && j < 144) { const size_t o = ((((size_t)l * DB + b) * DSQ + (j - 128)) * 4 + kvh) * 64 + d8;
#pragma unroll
                for (int i = 0; i < 8; ++i) { p.out[O_NKS + o + i] = kf[i]; p.out[O_NVS + o + i] = vf[i]; } }
        }
    }
    __syncthreads();
    if (active) {
        const float sink = p.in[I_SINK][l * 16 + hq];
        const int kmin = SAMPLE ? 0 : (c >= 2 ? 0 : (2 - c) * 64), kmax = SAMPLE ? 144 : 192;
        bf16x8 qf[NQT][2];
#pragma unroll
        for (int qt = 0; qt < NQT; ++qt) {
            float q0[8], q1[8]; unpack8(qraw[qt][0], q0); unpack8(qraw[qt][1], q1);
            float ss = 0.f;
#pragma unroll
            for (int i = 0; i < 8; ++i) ss += q0[i] * q0[i] + q1[i] * q1[i];
            ss += __shfl_xor(ss, 16); ss += __shfl_xor(ss, 32);
            const float sc = rsqrtf(ss * (1.f / 64.f) + EPS) * 0.125f;
#pragma unroll
            for (int i = 0; i < 8; ++i) { q0[i] = q0[i] * sc * qg[quad * 8 + i]; q1[i] = q1[i] * sc * qg[32 + quad * 8 + i]; }
            const u32x4 w0 = pack8(q0), w1 = pack8(q1);
            qf[qt][0] = __builtin_bit_cast(bf16x8, w0); qf[qt][1] = __builtin_bit_cast(bf16x8, w1);
        }
        f32x4 st[NKT][NQT];
#pragma unroll
        for (int kt = 0; kt < NKT; ++kt) {
#pragma unroll
            for (int qt = 0; qt < NQT; ++qt) st[kt][qt] = (f32x4){0.f, 0.f, 0.f, 0.f};
#pragma unroll
            for (int ds = 0; ds < 2; ++ds) {
                const bf16x8 kfr = *(const LAS bf16x8*)(Ks + (kt * 16 + l15) * KS_LD + ds * 32 + quad * 8);
#pragma unroll
                for (int qt = 0; qt < NQT; ++qt) st[kt][qt] = __builtin_amdgcn_mfma_f32_16x16x32_bf16(kfr, qf[qt][ds], st[kt][qt], 0, 0, 0);
            }
        }
        float inv[NQT];
#pragma unroll
        for (int qt = 0; qt < NQT; ++qt) {
            float m = -1e30f;
#pragma unroll
            for (int kt = 0; kt < NKT; ++kt)
#pragma unroll
                for (int j = 0; j < 4; ++j) { const int key = kt * 16 + quad * 4 + j; const bool ok = key >= kmin && key < kmax; if (ok) m = fmaxf(m, st[kt][qt][j]); }
            m = fmaxf(m, __shfl_xor(m, 16)); m = fmaxf(m, __shfl_xor(m, 32));
            m = fmaxf(m, sink);
            float sum = 0.f;
#pragma unroll
            for (int kt = 0; kt < NKT; ++kt)
#pragma unroll
                for (int j = 0; j < 4; ++j) { const int key = kt * 16 + quad * 4 + j; const bool ok = key >= kmin && key < kmax; const float e = ok ? __expf(st[kt][qt][j] - m) : 0.f; st[kt][qt][j] = e; sum += e; }
            sum += __shfl_xor(sum, 16); sum += __shfl_xor(sum, 32);
            inv[qt] = 1.f / (sum + __expf(sink - m));
        }
        f32x4 ot[4][NQT];
#pragma unroll
        for (int dt = 0; dt < 4; ++dt)
#pragma unroll
            for (int qt = 0; qt < NQT; ++qt) ot[dt][qt] = (f32x4){0.f, 0.f, 0.f, 0.f};
#pragma unroll
        for (int s = 0; s < NKT / 2; ++s) {
            bf16x8 pf[NQT];
#pragma unroll
            for (int qt = 0; qt < NQT; ++qt) { u32x4 w; w.x = pk2(st[2 * s][qt][0], st[2 * s][qt][1]); w.y = pk2(st[2 * s][qt][2], st[2 * s][qt][3]);
                w.z = pk2(st[2 * s + 1][qt][0], st[2 * s + 1][qt][1]); w.w = pk2(st[2 * s + 1][qt][2], st[2 * s + 1][qt][3]); pf[qt] = __builtin_bit_cast(bf16x8, w); }
#pragma unroll
            for (int dt = 0; dt < 4; ++dt) {
                const LAS bf16_t* vp = Vt + (dt * 16 + l15) * VT_LD + 32 * s + quad * 4;
                const u32x2 lo = *(const LAS u32x2*)vp, hi = *(const LAS u32x2*)(vp + 16);
                u32x4 w; w.x = lo.x; w.y = lo.y; w.z = hi.x; w.w = hi.y;
                const bf16x8 vfr = __builtin_bit_cast(bf16x8, w);
#pragma unroll
                for (int qt = 0; qt < NQT; ++qt) ot[dt][qt] = __builtin_amdgcn_mfma_f32_16x16x32_bf16(vfr, pf[qt], ot[dt][qt], 0, 0, 0);
            }
        }
#pragma unroll
        for (int qt = 0; qt < NQT; ++qt) {
            bf16_t* op = PA + qrow[qt] * LDA_ + hq * 64 + quad * 4;
#pragma unroll
            for (int dt = 0; dt < 4; ++dt) { u32x2 w; w.x = pk2(ot[dt][qt][0] * inv[qt], ot[dt][qt][1] * inv[qt]); w.y = pk2(ot[dt][qt][2] * inv[qt], ot[dt][qt][3] * inv[qt]); if (!dry) *(u32x2*)(op + dt * 16) = w; }
        }
    }
    __syncthreads();
}
__device__ __forceinline__ void ph_attn(const Params& p, int l, LAS unsigned char* lds, bool dry) {
    constexpr int NPI = NB * 64 * 4, NSI = DB * 4;
    for (int it = blockIdx.x; it < NPI + NSI; it += gridDim.x) {
        if (it < NPI) { const int kvh = it & 3, c = (it >> 2) & 63, b = it >> 8; attn_item<false>(p, l, lds, b, c, kvh, dry); }
        else { const int r = it - NPI; attn_item<true>(p, l, lds, r >> 2, 0, r & 3, dry); }
    }
}

__device__ __forceinline__ float hgrn_lb(const Params& p, int l, int idx) {
    if (l == 0) return 0.f;
    const float a = p.in[I_LBL][idx], b = p.in[I_LBL][1024 + idx]; const float m = fmaxf(a, b); const float ea = __expf(a - m), eb = __expf(b - m);
    const float p0 = ea / (ea + eb), p1 = eb / (ea + eb); return (p0 + p1) - p0;
}
template <int MODE>
__device__ __forceinline__ void hgrn_item(const Params& p, int l, LAS unsigned char* lds, long rowbase, int ntok, int h, const float* Sin, float* Sout, float* Dout, bool dry) {
    const int tid = tid_opaque(), wave = tid >> 6, lane = tid & 63, kgi = lane & 15, vs = lane >> 4, vcol = wave * 16 + vs * 4;
    bf16_t* PB = (bf16_t*)(p.ws + OFF_P);
    LAS float* Fs = (LAS float*)lds; LAS float* Kk = Fs + 4096; LAS float* Qs = Kk + 4096; LAS float* Vs = Qs + 4096; LAS float* Os = Vs + 4096;
    f32x2 Sa[8], Sb[8];
#pragma unroll
    for (int i = 0; i < 8; ++i) { f32x4 v = (f32x4){0.f, 0.f, 0.f, 0.f}; if (Sin) v = *(const f32x4*)(Sin + (size_t)(kgi * 8 + i) * 128 + vcol);
        Sa[i] = (f32x2){v[0], v[1]}; Sb[i] = (f32x2){v[2], v[3]}; }
    float Dp[8];
#pragma unroll
    for (int i = 0; i < 8; ++i) Dp[i] = 1.f;
    const int st = tid >> 4, k8 = (tid & 15) * 8;
    float lbv[8], gnv[8];
#pragma unroll
    for (int i = 0; i < 8; ++i) { lbv[i] = hgrn_lb(p, l, h * 128 + k8 + i); gnv[i] = p.in[I_HON][l * 128 + k8 + i]; }
    u32x4 r_hq = (u32x4){0u, 0u, 0u, 0u}, r_hf = r_hq, r_hi = r_hq, r_hg = r_hq;
    { const int nb0 = ntok < 32 ? ntok : 32;
      if (st < nb0) { const bf16_t* rp = PB + (rowbase + st) * LDB_ + h * 128 + k8; r_hf = *(const u32x4*)(rp + 1024); r_hi = *(const u32x4*)(rp + 2048); if (MODE == 1) r_hq = *(const u32x4*)rp; } }
    for (int t0 = 0; t0 < ntok; t0 += 32) {
        const int nb = (ntok - t0) < 32 ? (ntok - t0) : 32;
        if (st < nb) {
            float hf[8], hi[8]; unpack8(r_hf, hf); unpack8(r_hi, hi);
            float fv[8];
#pragma unroll
            for (int i = 0; i < 8; ++i) { const float sg = sigm(hf[i]); const float f = lbv[i] + (1.f - lbv[i]) * sg; fv[i] = fmaxf(f, 1e-26f); }
            *(LAS f32x4*)(Fs + st * 128 + k8) = (f32x4){fv[0], fv[1], fv[2], fv[3]}; *(LAS f32x4*)(Fs + st * 128 + k8 + 4) = (f32x4){fv[4], fv[5], fv[6], fv[7]};
            *(LAS f32x4*)(Vs + st * 128 + k8) = (f32x4){hi[0], hi[1], hi[2], hi[3]}; *(LAS f32x4*)(Vs + st * 128 + k8 + 4) = (f32x4){hi[4], hi[5], hi[6], hi[7]};
            if (MODE == 1) { float hq[8]; unpack8(r_hq, hq);
                *(LAS f32x4*)(Qs + st * 128 + k8) = (f32x4){siluf(hq[0]), siluf(hq[1]), siluf(hq[2]), siluf(hq[3])}; *(LAS f32x4*)(Qs + st * 128 + k8 + 4) = (f32x4){siluf(hq[4]), siluf(hq[5]), siluf(hq[6]), siluf(hq[7])}; }
        }
        __syncthreads();
        { const int t1 = t0 + 32; const int nb1 = (ntok - t1) < 32 ? (ntok - t1) : 32;
          if (t1 < ntok && st < nb1) { const bf16_t* rp = PB + (rowbase + t1 + st) * LDB_ + h * 128 + k8; r_hf = *(const u32x4*)(rp + 1024); r_hi = *(const u32x4*)(rp + 2048); if (MODE == 1) r_hq = *(const u32x4*)rp; }
          if (MODE == 1 && st < nb) r_hg = *(const u32x4*)(PB + (rowbase + t0 + st) * LDB_ + 3072 + h * 128 + k8); }
#pragma unroll 4
        for (int t = 0; t < nb; ++t) {
            const f32x4 f0 = *(const LAS f32x4*)(Fs + t * 128 + kgi * 8), f1 = *(const LAS f32x4*)(Fs + t * 128 + kgi * 8 + 4);
            const f32x4 v4 = *(const LAS f32x4*)(Vs + t * 128 + vcol);
            f32x4 q0 = (f32x4){0.f, 0.f, 0.f, 0.f}, q1 = q0;
            if (MODE == 1) { q0 = *(const LAS f32x4*)(Qs + t * 128 + kgi * 8); q1 = *(const LAS f32x4*)(Qs + t * 128 + kgi * 8 + 4); }
            f32x2 oa = (f32x2){0.f, 0.f}, ob = oa; const f32x2 va = (f32x2){v4[0], v4[1]}, vb = (f32x2){v4[2], v4[3]};
#pragma unroll
            for (int i = 0; i < 8; ++i) { const float fi = i < 4 ? f0[i & 3] : f1[i & 3], qi = i < 4 ? q0[i & 3] : q1[i & 3];
                if (MODE == 0) Dp[i] *= fi;
                const f32x2 f2 = (f32x2){fi, fi}, q2 = (f32x2){qi, qi};
                Sa[i] = va + f2 * (Sa[i] - va); Sb[i] = vb + f2 * (Sb[i] - vb);
                if (MODE == 1) { oa += Sa[i] * q2; ob += Sb[i] * q2; } }
            if (MODE == 1) {
                float o[4] = {oa[0], oa[1], ob[0], ob[1]};
#pragma unroll
                for (int j = 0; j < 4; ++j) { o[j] += row_ror<1>(o[j]); o[j] += row_ror<2>(o[j]); o[j] += row_ror<4>(o[j]); o[j] += row_ror<8>(o[j]); }
                if (kgi == 0) *(LAS f32x4*)(Os + t * 128 + vcol) = (f32x4){o[0], o[1], o[2], o[3]};
            }
        }
        __syncthreads();
        if (MODE == 1 && st < nb) {
            const f32x4 o0 = *(const LAS f32x4*)(Os + st * 128 + k8), o1 = *(const LAS f32x4*)(Os + st * 128 + k8 + 4);
            float ov[8] = {o0[0], o0[1], o0[2], o0[3], o1[0], o1[1], o1[2], o1[3]};
            float ss = 0.f;
#pragma unroll
            for (int i = 0; i < 8; ++i) ss += ov[i] * ov[i];
            ss += __shfl_xor(ss, 1); ss += __shfl_xor(ss, 2); ss += __shfl_xor(ss, 4); ss += __shfl_xor(ss, 8);
            const float rstd = rsqrtf(ss * (1.f / 128.f) + EPS);
            bf16_t* gp = PB + (rowbase + t0 + st) * LDB_ + 3072 + h * 128 + k8;
            float hg[8]; unpack8(r_hg, hg);
#pragma unroll
            for (int i = 0; i < 8; ++i) ov[i] = ov[i] * rstd * gnv[i] * siluf(hg[i]);
            if (!dry) *(u32x4*)gp = pack8(ov);
        }
    }
    if (Sout) {
#pragma unroll
        for (int i = 0; i < 8; ++i) *(f32x4*)(Sout + (size_t)(kgi * 8 + i) * 128 + vcol) = (f32x4){Sa[i][0], Sa[i][1], Sb[i][0], Sb[i][1]};
    }
    if (MODE == 0 && wave == 0 && vs == 0) {
#pragma unroll
        for (int i = 0; i < 8; ++i) Dout[kgi * 8 + i] = Dp[i];
    }
    __syncthreads();
}
__device__ __forceinline__ void hgrn1_item_mfma(const Params& p, int l, LAS unsigned char* lds, long rowbase, int h, float* Sout, float* Dout) {
    const int tid = tid_opaque(), wave = tid >> 6, lane = tid & 63, l15 = lane & 15, quad = lane >> 4;
    const bf16_t* PB = (const bf16_t*)(p.ws + OFF_P);
    LAS float* G = (LAS float*)lds; LAS float* KKs = G + 64 * 128;
    LAS bf16_t* KdT = (LAS bf16_t*)(lds + 65536); LAS bf16_t* Vt = (LAS bf16_t*)(lds + 65536 + 18432);
    LAS float* QS = (LAS float*)(lds + 65536 + 36864); LAS float* CAR = QS + 512; LAS bf16_t* Vs1 = (LAS bf16_t*)(lds + 106496);
    const int st = tid >> 3, kb = (tid & 7) * 16;
    const int sk = tid & 127, qr = tid >> 7;
    float lbv[16];
#pragma unroll
    for (int i = 0; i < 16; ++i) lbv[i] = hgrn_lb(p, l, h * 128 + kb + i);
    if (tid < 128) CAR[tid] = 0.f;
    f32x4 acc[8];
#pragma unroll
    for (int vt = 0; vt < 8; ++vt) acc[vt] = (f32x4){0.f, 0.f, 0.f, 0.f};
    __syncthreads();
    for (int c = SEGT / 64 - 1; c >= 0; --c) {
        {
            const bf16_t* rp = PB + (rowbase + c * 64 + st) * LDB_ + h * 128 + kb;
            float hf[16], hi[16];
            unpack8(*(const u32x4*)(rp + 1024), *(float(*)[8])&hf[0]); unpack8(*(const u32x4*)(rp + 1024 + 8), *(float(*)[8])&hf[8]);
            unpack8(*(const u32x4*)(rp + 2048), *(float(*)[8])&hi[0]); unpack8(*(const u32x4*)(rp + 2048 + 8), *(float(*)[8])&hi[8]);
#pragma unroll
            for (int i = 0; i < 16; ++i) { const float sg = sigm(hf[i]); const float f = fmaxf(lbv[i] + (1.f - lbv[i]) * sg, 1e-26f);
                G[st * 128 + kb + i] = __logf(f); KKs[st * 128 + kb + i] = 1.f - f; }
            *(LAS u32x4*)(Vs1 + st * 128 + kb) = pack8(*(float(*)[8])&hi[0]); *(LAS u32x4*)(Vs1 + st * 128 + kb + 8) = pack8(*(float(*)[8])&hi[8]);
        }
        __syncthreads();
        {
            float run = 0.f;
#pragma unroll
            for (int i = 15; i >= 0; --i) { const int t = qr * 16 + i; const float g = G[t * 128 + sk]; G[t * 128 + sk] = run; run += g; }
            QS[qr * 128 + sk] = run;
        }
        __syncthreads();
        {
            float add = CAR[sk];
#pragma unroll
            for (int q2 = 1; q2 < 4; ++q2) if (q2 > qr) add += QS[q2 * 128 + sk];
            float kd[16], vv[16];
#pragma unroll
            for (int i = 0; i < 16; ++i) { const int t = qr * 16 + i; const float e = G[t * 128 + sk] + add; kd[i] = KKs[t * 128 + sk] * __expf(e); vv[i] = bf2f(Vs1[t * 128 + sk]); }
            *(LAS u32x4*)(KdT + sk * 72 + qr * 16) = pack8(*(float(*)[8])&kd[0]); *(LAS u32x4*)(KdT + sk * 72 + qr * 16 + 8) = pack8(*(float(*)[8])&kd[8]);
            *(LAS u32x4*)(Vt + sk * 72 + qr * 16) = pack8(*(float(*)[8])&vv[0]); *(LAS u32x4*)(Vt + sk * 72 + qr * 16 + 8) = pack8(*(float(*)[8])&vv[8]);
        }
        __syncthreads();
        if (qr == 0) CAR[sk] += (QS[sk] + QS[128 + sk]) + (QS[256 + sk] + QS[384 + sk]);
#pragma unroll
        for (int s2 = 0; s2 < 2; ++s2) {
            const bf16x8 a = *(const LAS bf16x8*)(KdT + (wave * 16 + l15) * 72 + s2 * 32 + quad * 8);
#pragma unroll
            for (int vt = 0; vt < 8; ++vt) { const bf16x8 bfr = *(const LAS bf16x8*)(Vt + (vt * 16 + l15) * 72 + s2 * 32 + quad * 8);
                acc[vt] = __builtin_amdgcn_mfma_f32_16x16x32_bf16(a, bfr, acc[vt], 0, 0, 0); }
        }
        __syncthreads();
    }
#pragma unroll
    for (int vt = 0; vt < 8; ++vt)
#pragma unroll
        for (int r = 0; r < 4; ++r) Sout[(size_t)(wave * 16 + quad * 4 + r) * 128 + vt * 16 + l15] = acc[vt][r];
    if (tid < 128) Dout[tid] = __expf(CAR[tid]);
    __syncthreads();
}
__device__ __forceinline__ void ph_hgrn1(const Params& p, int l, LAS unsigned char* lds) {
    float* Sb = (float*)(p.ws + OFF_S); float* Db = (float*)(p.ws + OFF_D);
    constexpr int NI = NB * 8 * (NSEG - 1);
    for (int it = blockIdx.x; it < NI; it += gridDim.x) {
        const int seg = it % (NSEG - 1), bh = it / (NSEG - 1), b = bh >> 3, h = bh & 7;
        hgrn1_item_mfma(p, l, lds, (long)b * SEQ + seg * SEGT, h, Sb + ((size_t)bh * NSEG + seg + 1) * 16384, Db + ((size_t)bh * NSEG + seg) * 128);
    }
}
__device__ __forceinline__ void ph_hgrn2(const Params& p) {
    float* Sb = (float*)(p.ws + OFF_S); const float* Db = (const float*)(p.ws + OFF_D);
    const int nth = gridDim.x * 512;
    for (int e = blockIdx.x * 512 + tid_opaque(); e < NB * 8 * 16384; e += nth) {
        const int bh = e >> 14, kv = e & 16383, k = kv >> 7;
        float* base = Sb + (size_t)bh * NSEG * 16384 + kv; float carry = 0.f; base[0] = 0.f;
        for (int s = 1; s < NSEG; ++s) { const float d = Db[((size_t)bh * NSEG + (s - 1)) * 128 + k]; carry = d * carry + base[(size_t)s * 16384]; base[(size_t)s * 16384] = carry; }
    }
}
constexpr int H3_G = 0, H3_Q = 16384, H3_K = 32768, H3_QC = 49152, H3_KD = 57856, H3_VT = 78336, H3_S0 = 92672, H3_AT = 127488, H3_OS = 130048, H3_DS = 138240, H3_VS = 139264, H3_KC = 147456, H3_FL = 156160, H3_END = 156416;
template <bool SAMPLE>
__device__ __forceinline__ void hgrn3_item_mfma(const Params& p, int l, LAS unsigned char* lds, long rowbase, int h, const float* Sin, float* Sout, bool dry) {
    constexpr int NTOK = SAMPLE ? 16 : SEGT, NBLK = SAMPLE ? 1 : 2;
    const int tid = tid_opaque(), wave = tid >> 6, lane = tid & 63, l15 = lane & 15, quad = lane >> 4;
    bf16_t* PB = (bf16_t*)(p.ws + OFF_P);
    LAS float* G = (LAS float*)(lds + H3_G); LAS float* Qs = (LAS float*)(lds + H3_Q); LAS float* KKs = (LAS float*)(lds + H3_K);
    LAS bf16_t* QcS = (LAS bf16_t*)(lds + H3_QC); LAS bf16_t* KdTS = (LAS bf16_t*)(lds + H3_KD); LAS bf16_t* Vt = (LAS bf16_t*)(lds + H3_VT);
    LAS bf16_t* S0T = (LAS bf16_t*)(lds + H3_S0); LAS bf16_t* attS = (LAS bf16_t*)(lds + H3_AT);
    LAS float* Os = (LAS float*)(lds + H3_OS); LAS float* Ds = (LAS float*)(lds + H3_DS); LAS bf16_t* Vs2 = (LAS bf16_t*)(lds + H3_VS);
    LAS bf16_t* KcS = (LAS bf16_t*)(lds + H3_KC); LAS int* FLG = (LAS int*)(lds + H3_FL);
    for (int i = tid; i < (H3_S0 - H3_KD) / 16; i += 512) *(LAS u32x4*)(lds + H3_KD + i * 16) = (u32x4){0u, 0u, 0u, 0u};
    for (int i = tid; i < (H3_OS - H3_AT) / 16; i += 512) *(LAS u32x4*)(lds + H3_AT + i * 16) = (u32x4){0u, 0u, 0u, 0u};
    f32x4 acc[8];
#pragma unroll
    for (int vt = 0; vt < 8; ++vt) {
#pragma unroll
        for (int r = 0; r < 4; ++r) acc[vt][r] = Sin ? Sin[(size_t)(wave * 16 + quad * 4 + r) * 128 + vt * 16 + l15] : 0.f; }
    const int kc = tid & 15;
    int pt[5], pm[5];
#pragma unroll
    for (int pp = 0; pp < 5; ++pp) { const int pi = pp * 32 + (tid >> 4); int t = (int)((sqrtf(8.f * pi + 1.f) - 1.f) * 0.5f); if ((t + 1) * (t + 2) / 2 <= pi) ++t; if (t * (t + 1) / 2 > pi) --t;
        pt[pp] = pi < 136 ? t : -1; pm[pp] = pi - t * (t + 1) / 2; }
    const int st = tid >> 4, k8 = (tid & 15) * 8;
    float lbv[8];
#pragma unroll
    for (int i = 0; i < 8; ++i) lbv[i] = hgrn_lb(p, l, h * 128 + k8 + i);
    const int ptk = tid >> 5, pv4 = (tid & 31) * 4;
    const f32x4 gn4 = *(const f32x4*)(p.in[I_HON] + l * 128 + pv4);
    u32x4 r_hq = (u32x4){0u, 0u, 0u, 0u}, r_hf = r_hq, r_hi = r_hq; u32x2 r_hg[NBLK];
    if (st < NBLK * 16) { const bf16_t* rp = PB + (rowbase + st) * LDB_ + h * 128 + k8; r_hq = *(const u32x4*)rp; r_hf = *(const u32x4*)(rp + 1024); r_hi = *(const u32x4*)(rp + 2048); }
    __syncthreads();
    for (int c0 = 0; c0 < NTOK; c0 += 32) {
#pragma unroll
        for (int bq = 0; bq < NBLK; ++bq) r_hg[bq] = *(const u32x2*)(PB + (rowbase + c0 + bq * 16 + ptk) * LDB_ + 3072 + h * 128 + pv4);
        if (st < NBLK * 16) {
            float hq[8], hf[8], hi[8]; unpack8(r_hq, hq); unpack8(r_hf, hf); unpack8(r_hi, hi);
#pragma unroll
            for (int i = 0; i < 8; ++i) { const float sg = sigm(hf[i]); const float f = fmaxf(lbv[i] + (1.f - lbv[i]) * sg, 1e-26f);
                G[st * 128 + k8 + i] = __logf(f); KKs[st * 128 + k8 + i] = 1.f - f; Qs[st * 128 + k8 + i] = siluf(hq[i]); }
            *(LAS u32x4*)(Vs2 + st * 128 + k8) = r_hi;
        }
        if (tid < 2) FLG[tid] = 0;
        __syncthreads();
        if (c0 + 32 < NTOK && st < NBLK * 16) { const bf16_t* rp = PB + (rowbase + c0 + 32 + st) * LDB_ + h * 128 + k8; r_hq = *(const u32x4*)rp; r_hf = *(const u32x4*)(rp + 1024); r_hi = *(const u32x4*)(rp + 2048); }
        if (tid < 128 * NBLK) {
            const int k = tid & 127, blk = tid >> 7; float run = 0.f;
#pragma unroll
            for (int t = 0; t < 16; ++t) { const int o = (blk * 16 + t) * 128 + k; run += G[o]; G[o] = run; QcS[(blk * 16 + t) * 136 + k] = (bf16_t)f2bf(Qs[o] * __expf(run)); }
            Ds[blk * 128 + k] = __expf(run);
            if (run < -80.f) FLG[blk] = 1;
#pragma unroll
            for (int t = 0; t < 16; ++t) { const int o = (blk * 16 + t) * 128 + k; KcS[(blk * 16 + t) * 136 + k] = (bf16_t)f2bf(KKs[o] * __expf(fminf(-G[o], 85.f))); }
            float kd[16]; unsigned vw[8];
#pragma unroll
            for (int t = 0; t < 16; ++t) { const int o = (blk * 16 + t) * 128 + k; kd[t] = KKs[o] * __expf(run - G[o]); }
#pragma unroll
            for (int t = 0; t < 8; ++t) vw[t] = (unsigned)Vs2[(blk * 16 + 2 * t) * 128 + k] | ((unsigned)Vs2[(blk * 16 + 2 * t + 1) * 128 + k] << 16);
            *(LAS u32x4*)(KdTS + (blk * 128 + k) * 40) = pack8(*(float(*)[8])&kd[0]); *(LAS u32x4*)(KdTS + (blk * 128 + k) * 40 + 8) = pack8(*(float(*)[8])&kd[8]);
            *(LAS u32x4*)(Vt + k * 56 + blk * 16) = (u32x4){vw[0], vw[1], vw[2], vw[3]}; *(LAS u32x4*)(Vt + k * 56 + blk * 16 + 8) = (u32x4){vw[4], vw[5], vw[6], vw[7]};
        }
        __syncthreads();
#pragma unroll 1
        for (int blk = 0; blk < NBLK; ++blk) {
            const bool exact = FLG[blk] != 0;
            if (!exact) { if (wave == 0) { f32x4 C = (f32x4){0.f, 0.f, 0.f, 0.f};
#pragma unroll
                    for (int sl = 0; sl < 4; ++sl) { const bf16x8 a = *(const LAS bf16x8*)(QcS + (blk * 16 + l15) * 136 + sl * 32 + quad * 8); const bf16x8 bk = *(const LAS bf16x8*)(KcS + (blk * 16 + l15) * 136 + sl * 32 + quad * 8);
                        C = __builtin_amdgcn_mfma_f32_16x16x32_bf16(a, bk, C, 0, 0, 0); }
#pragma unroll
                    for (int r = 0; r < 4; ++r) { const int t = quad * 4 + r; attS[(blk * 16 + t) * 40 + l15] = (bf16_t)f2bf(l15 <= t ? C[r] : 0.f); } } }
            else
#pragma unroll
            for (int pp = 0; pp < 5; ++pp) if (pt[pp] >= 0) {
                const int ot = ((blk * 16 + pt[pp]) * 128 + kc * 8), om = ((blk * 16 + pm[pp]) * 128 + kc * 8);
                const f32x4 q0 = *(const LAS f32x4*)(Qs + ot), q1 = *(const LAS f32x4*)(Qs + ot + 4), k0 = *(const LAS f32x4*)(KKs + om), k1 = *(const LAS f32x4*)(KKs + om + 4);
                const f32x4 b0 = *(const LAS f32x4*)(G + ot), b1 = *(const LAS f32x4*)(G + ot + 4), c0v = *(const LAS f32x4*)(G + om), c1v = *(const LAS f32x4*)(G + om + 4);
                float sum = 0.f;
#pragma unroll
                for (int i = 0; i < 4; ++i) { sum += q0[i] * k0[i] * __expf(b0[i] - c0v[i]); sum += q1[i] * k1[i] * __expf(b1[i] - c1v[i]); }
                sum += row_ror<1>(sum); sum += row_ror<2>(sum); sum += row_ror<4>(sum); sum += row_ror<8>(sum);
                if (kc == 0) attS[(blk * 16 + pt[pp]) * 40 + pm[pp]] = (bf16_t)f2bf(sum);
            }
#pragma unroll
            for (int vt = 0; vt < 8; ++vt) { u32x2 w; w.x = pk2(acc[vt][0], acc[vt][1]); w.y = pk2(acc[vt][2], acc[vt][3]); *(LAS u32x2*)(S0T + (vt * 16 + l15) * 136 + wave * 16 + quad * 4) = w; }
            __syncthreads();
            {
                f32x4 C = (f32x4){0.f, 0.f, 0.f, 0.f};
#pragma unroll
                for (int sl = 0; sl < 4; ++sl) { const bf16x8 a = *(const LAS bf16x8*)(QcS + (blk * 16 + l15) * 136 + sl * 32 + quad * 8); const bf16x8 bq = *(const LAS bf16x8*)(S0T + (wave * 16 + l15) * 136 + sl * 32 + quad * 8);
                    C = __builtin_amdgcn_mfma_f32_16x16x32_bf16(a, bq, C, 0, 0, 0); }
                const bf16x8 a2 = *(const LAS bf16x8*)(attS + (blk * 16 + l15) * 40 + quad * 8); const bf16x8 b2 = *(const LAS bf16x8*)(Vt + (wave * 16 + l15) * 56 + blk * 16 + quad * 8);
                C = __builtin_amdgcn_mfma_f32_16x16x32_bf16(a2, b2, C, 0, 0, 0);
#pragma unroll
                for (int r = 0; r < 4; ++r) Os[(quad * 4 + r) * 128 + wave * 16 + l15] = C[r];
            }
            {
                const f32x4 d4 = *(const LAS f32x4*)(Ds + blk * 128 + wave * 16 + quad * 4);
                const bf16x8 a3 = *(const LAS bf16x8*)(KdTS + (blk * 128 + wave * 16 + l15) * 40 + quad * 8);
#pragma unroll
                for (int vt = 0; vt < 8; ++vt) { acc[vt] = acc[vt] * d4; const bf16x8 b3 = *(const LAS bf16x8*)(Vt + (vt * 16 + l15) * 56 + blk * 16 + quad * 8);
                    acc[vt] = __builtin_amdgcn_mfma_f32_16x16x32_bf16(a3, b3, acc[vt], 0, 0, 0); }
            }
            __syncthreads();
            {
                const f32x4 o4 = *(const LAS f32x4*)(Os + ptk * 128 + pv4);
                float ss = (o4[0] * o4[0] + o4[1] * o4[1]) + (o4[2] * o4[2] + o4[3] * o4[3]);
                ss += __shfl_xor(ss, 1); ss += __shfl_xor(ss, 2); ss += __shfl_xor(ss, 4); ss += __shfl_xor(ss, 8); ss += __shfl_xor(ss, 16);
                const float rstd = rsqrtf(ss * (1.f / 128.f) + EPS);
                bf16_t* gp = PB + (rowbase + c0 + blk * 16 + ptk) * LDB_ + 3072 + h * 128 + pv4;
                const u32x2 gw = NBLK == 1 ? r_hg[0] : (blk == 0 ? r_hg[0] : r_hg[NBLK - 1]);
                const float y0 = o4[0] * rstd * gn4[0] * siluf(bf2f(gw.x & 0xffffu)), y1 = o4[1] * rstd * gn4[1] * siluf(bf2f(gw.x >> 16)), y2 = o4[2] * rstd * gn4[2] * siluf(bf2f(gw.y & 0xffffu)), y3 = o4[3] * rstd * gn4[3] * siluf(bf2f(gw.y >> 16));
                u32x2 w; w.x = pk2(y0, y1); w.y = pk2(y2, y3);
                if (!dry) *(u32x2*)gp = w;
            }
        }
    }
    if (Sout) {
#pragma unroll
        for (int vt = 0; vt < 8; ++vt)
#pragma unroll
            for (int r = 0; r < 4; ++r) Sout[(size_t)(wave * 16 + quad * 4 + r) * 128 + vt * 16 + l15] = acc[vt][r];
    }
    __syncthreads();
}
__device__ __forceinline__ void ph_hgrn3(const Params& p, int l, LAS unsigned char* lds, bool dry) {
    float* Sb = (float*)(p.ws + OFF_S);
    constexpr int NPI = NB * 8 * NSEG, NSI = DB * 8;
    for (int it = blockIdx.x; it < NPI + NSI; it += gridDim.x) {
        if (it < NPI) { const int seg = it & (NSEG - 1), bh = it >> 4, b = bh >> 3, h = bh & 7;
            float* so = seg == NSEG - 1 ? p.out + O_NHP + (((size_t)l * NB + b) * 8 + h) * 16384 : nullptr;
            hgrn3_item_mfma<false>(p, l, lds, (long)b * SEQ + seg * SEGT, h, Sb + ((size_t)bh * NSEG + seg) * 16384, so, dry); }
        else { const int r = it - NPI, b = r >> 3, h = r & 7;
            hgrn3_item_mfma<true>(p, l, lds, (long)MP + b * DSQ, h, p.in[I_SH] + (((size_t)l * DB + b) * 8 + h) * 16384, p.out + O_NHS + (((size_t)l * DB + b) * 8 + h) * 16384, dry); }
    }
}

__device__ __forceinline__ void ph_conv(const Params& p, int l) {
    bf16_t* PC = (bf16_t*)(p.ws + OFF_P); bf16_t* XC = (bf16_t*)(p.ws + OFF_MG);
    const float* cw = p.in[I_CW] + (size_t)l * 4 * 1024; const float* cb = p.in[I_CB] + (size_t)l * 1024;
    const int nth = (gridDim.x * 512) & ~127;
    const int tid0 = blockIdx.x * 512 + tid_opaque(), c8 = (tid0 & 127) * 8;
    float wv[4][8], bv[8];
#pragma unroll
    for (int jj = 0; jj < 4; ++jj) { const f32x4 w0 = *(const f32x4*)(cw + jj * 1024 + c8), w1 = *(const f32x4*)(cw + jj * 1024 + c8 + 4);
#pragma unroll
        for (int i = 0; i < 4; ++i) { wv[jj][i] = w0[i]; wv[jj][4 + i] = w1[i]; } }
    { const f32x4 b0 = *(const f32x4*)(cb + c8), b1 = *(const f32x4*)(cb + c8 + 4);
#pragma unroll
      for (int i = 0; i < 4; ++i) { bv[i] = b0[i]; bv[4 + i] = b1[i]; } }
    if (tid0 < nth)
    for (int idx = tid0; idx < MT * 128; idx += nth) {
        const int row = idx >> 7;
        int t, bb;
        if (row < MP) { bb = row >> 12; t = row & 4095; } else { const int r = row - MP; bb = r >> 4; t = r & 15; }
        float acc[8];
#pragma unroll
        for (int i = 0; i < 8; ++i) acc[i] = bv[i];
        float xv[8];
#pragma unroll
        for (int jj = 0; jj < 4; ++jj) {
            const int ti = t - 3 + jj; bool have = true;
            if (ti >= 0) unpack8(*(const u32x4*)(PC + (size_t)(row - 3 + jj) * LDC_ + c8), xv);
            else if (row >= MP) { const float* sc = p.in[I_SC] + (((size_t)l * DB + bb) * 3 + (3 + ti)) * 1024 + c8; const f32x4 a0 = *(const f32x4*)sc, a1 = *(const f32x4*)(sc + 4);
#pragma unroll
                for (int i = 0; i < 4; ++i) { xv[i] = a0[i]; xv[4 + i] = a1[i]; } }
            else have = false;
            if (have) {
#pragma unroll
                for (int i = 0; i < 8; ++i) acc[i] += xv[i] * wv[jj][i]; }
        }
        *(u32x4*)(XC + (size_t)row * DM + c8) = pack8(acc);
        if (row < MP) { if (t >= SEQ - 3) { float* o = p.out + O_NCP + (((size_t)l * NB + bb) * 3 + (t - (SEQ - 3))) * 1024 + c8;
#pragma unroll
                for (int i = 0; i < 8; ++i) o[i] = xv[i]; } }
        else if (t >= DSQ - 3) { float* o = p.out + O_NCS + (((size_t)l * DB + bb) * 3 + (t - (DSQ - 3))) * 1024 + c8;
#pragma unroll
            for (int i = 0; i < 8; ++i) o[i] = xv[i]; }
    }
}
struct LruConst { float ba[4], bx[4], sp[4], w0[4], w1[4], w2[4], w3[4], cbv[4]; };
__device__ __forceinline__ void unpack4(u32x2 r, float (&o)[4]) { o[0] = bf2f(r.x & 0xffffu); o[1] = bf2f(r.x >> 16); o[2] = bf2f(r.y & 0xffffu); o[3] = bf2f(r.y >> 16); }
template <int SWEEP>
__device__ __forceinline__ void lru_scan_item(const Params& p, int l, LAS unsigned char* lds, int it, bool dry, const LruConst& K, int tid) {
    const int chl = tid & 63, sub = tid >> 6;
    bf16_t* PC = (bf16_t*)(p.ws + OFF_P);
    float* SUB = (float*)(p.ws + OFF_S); float* SEGB = SUB + (size_t)NB * 256 * 1024 * 2;
    const bool samp = it >= 512;
    int cg, seg = 0, b = 0, bb = 0; size_t row0;
    if (!samp) { cg = it & 3; seg = (it >> 2) & 31; b = it >> 7; row0 = (size_t)b * SEQ + seg * 128 + sub * 16; }
    else { const int r = it - 512; cg = r & 3; bb = (r >> 2) * 8 + sub; row0 = (size_t)MP + bb * DSQ; }
    const int ch = cg * 256 + chl * 4;
    float x1[4], x2[4], x3[4];
    if (SWEEP == 1) {
        if (!samp) { const int t0 = seg * 128 + sub * 16; const bf16_t* q = PC + row0 * LDC_ + ch;
            const u32x2 z = (u32x2){0u, 0u};
            unpack4(t0 >= 1 ? *(const u32x2*)(q - (size_t)LDC_) : z, x1); unpack4(t0 >= 2 ? *(const u32x2*)(q - (size_t)2 * LDC_) : z, x2); unpack4(t0 >= 3 ? *(const u32x2*)(q - (size_t)3 * LDC_) : z, x3); }
        else { const float* sc = p.in[I_SC] + ((size_t)l * DB + bb) * 3 * 1024 + ch; const f32x4 a1 = *(const f32x4*)(sc + 2048), a2 = *(const f32x4*)(sc + 1024), a3 = *(const f32x4*)sc;
#pragma unroll
            for (int i = 0; i < 4; ++i) { x1[i] = a1[i]; x2[i] = a2[i]; x3[i] = a3[i]; } }
    }
    float h[4] = {0.f, 0.f, 0.f, 0.f}, A[4] = {1.f, 1.f, 1.f, 1.f}, B[4] = {0.f, 0.f, 0.f, 0.f};
    if (SWEEP == 1 && samp) { const f32x4 h0 = *(const f32x4*)(p.in[I_SL] + ((size_t)l * DB + bb) * 1024 + ch);
#pragma unroll
        for (int i = 0; i < 4; ++i) h[i] = h0[i]; }
    if (SWEEP == 2) {
        if (!samp) {
            f32x4 su[8][2];
#pragma unroll
            for (int u = 0; u < 8; ++u) { su[u][0] = (f32x4){1.f, 0.f, 1.f, 0.f}; su[u][1] = su[u][0];
                if (u < sub) { const f32x4* q = (const f32x4*)(SUB + (((size_t)b * 256 + seg * 8 + u) * 1024 + ch) * 2); su[u][0] = q[0]; su[u][1] = q[1]; } }
#pragma unroll 1
            for (int hf = 0; hf * 4 < seg; ++hf) { f32x4 sg[4][2];
#pragma unroll
                for (int i = 0; i < 4; ++i) { const int sgi = hf * 4 + i; sg[i][0] = (f32x4){1.f, 0.f, 1.f, 0.f}; sg[i][1] = sg[i][0];
                    if (sgi < seg) { const f32x4* q = (const f32x4*)(SEGB + (((size_t)b * 32 + sgi) * 1024 + ch) * 2); sg[i][0] = q[0]; sg[i][1] = q[1]; } }
#pragma unroll
                for (int i = 0; i < 4; ++i) { h[0] = sg[i][0][0] * h[0] + sg[i][0][1]; h[1] = sg[i][0][2] * h[1] + sg[i][0][3]; h[2] = sg[i][1][0] * h[2] + sg[i][1][1]; h[3] = sg[i][1][2] * h[3] + sg[i][1][3]; } }
#pragma unroll
            for (int u = 0; u < 8; ++u) { h[0] = su[u][0][0] * h[0] + su[u][0][1]; h[1] = su[u][0][2] * h[1] + su[u][0][3]; h[2] = su[u][1][0] * h[2] + su[u][1][1]; h[3] = su[u][1][2] * h[3] + su[u][1][3]; }
        } else { const f32x4 h0 = *(const f32x4*)(p.in[I_SL] + ((size_t)l * DB + bb) * 1024 + ch);
#pragma unroll
            for (int i = 0; i < 4; ++i) h[i] = h0[i]; }
    }
    if (SWEEP == 1) {
#pragma unroll 8
        for (int t = 0; t < 16; ++t) {
            bf16_t* q = PC + (row0 + t) * LDC_ + ch;
            float x0[4], rp[4], ip[4]; unpack4(*(const u32x2*)q, x0); unpack4(*(const u32x2*)(q + 3072), rp); unpack4(*(const u32x2*)(q + 4096), ip);
            unsigned oa[4], ob[4];
#pragma unroll
            for (int i = 0; i < 4; ++i) {
                const float xc = K.cbv[i] + K.w3[i] * x0[i] + K.w2[i] * x1[i] + K.w1[i] * x2[i] + K.w0[i] * x3[i];
                x3[i] = x2[i]; x2[i] = x1[i]; x1[i] = x0[i];
                const float r = sigm(rp[i] + K.ba[i]), ig = sigm(ip[i] + K.bx[i]);
                const float la = -8.f * r * K.sp[i], a = __expf(la), x = 2.f * la;
                const float ser = -x * (1.f + x * (0.5f + x * (0.16666667f + x * (0.041666668f + x * 0.008333334f))));
                const float om = x > -0.3f ? ser : 1.f - a * a;
                const float bc = sqrtf(om) * (ig * xc);
                const float lser = -la * (1.f + la * (0.5f + la * (0.16666667f + la * (0.041666668f + la * 0.008333334f))));
                oa[i] = f2bf(la > -0.3f ? lser : 1.f - a); ob[i] = f2bf(bc);
                const float ar = 1.f - bf2f(oa[i]), br = bf2f(ob[i]);
                A[i] *= ar; B[i] = ar * B[i] + br; h[i] = ar * h[i] + br;
            }
            if (samp) { float lg[4]; unpack4(*(const u32x2*)(q + 1024), lg); u32x2 w; w.x = pk2(h[0] * gelu_tanh(lg[0]), h[1] * gelu_tanh(lg[1])); w.y = pk2(h[2] * gelu_tanh(lg[2]), h[3] * gelu_tanh(lg[3])); *(u32x2*)(q + 1024) = w; }
            u32x2 wa; wa.x = oa[0] | (oa[1] << 16); wa.y = oa[2] | (oa[3] << 16); u32x2 wb; wb.x = ob[0] | (ob[1] << 16); wb.y = ob[2] | (ob[3] << 16);
            *(u32x2*)(q + 3072) = wa; *(u32x2*)(q + 4096) = wb;
        }
    } else {
#pragma unroll 8
        for (int t = 0; t < 16; ++t) {
            bf16_t* q = PC + (row0 + t) * LDC_ + ch;
            float oa[4], ob[4], lg[4]; unpack4(*(const u32x2*)(q + 3072), oa); unpack4(*(const u32x2*)(q + 4096), ob); unpack4(*(const u32x2*)(q + 1024), lg);
            float yv[4];
#pragma unroll
            for (int i = 0; i < 4; ++i) { h[i] = (1.f - oa[i]) * h[i] + ob[i]; yv[i] = h[i] * gelu_tanh(lg[i]); }
            u32x2 w; w.x = pk2(yv[0], yv[1]); w.y = pk2(yv[2], yv[3]);
            if (!dry) *(u32x2*)(q + 1024) = w;
        }
    }
    if (SWEEP == 1 && !samp) {
        f32x4* qs = (f32x4*)(SUB + (((size_t)b * 256 + seg * 8 + sub) * 1024 + ch) * 2);
        qs[0] = (f32x4){A[0], B[0], A[1], B[1]}; qs[1] = (f32x4){A[2], B[2], A[3], B[3]};
        LAS f32x4* ex = (LAS f32x4*)lds;
        ex[(sub * 64 + chl) * 2] = (f32x4){A[0], B[0], A[1], B[1]}; ex[(sub * 64 + chl) * 2 + 1] = (f32x4){A[2], B[2], A[3], B[3]};
        __syncthreads();
        if (sub == 0) { float a[4] = {1.f, 1.f, 1.f, 1.f}, bs[4] = {0.f, 0.f, 0.f, 0.f};
#pragma unroll
            for (int u = 0; u < 8; ++u) { const f32x4 e0 = ex[(u * 64 + chl) * 2], e1 = ex[(u * 64 + chl) * 2 + 1];
                a[0] *= e0[0]; bs[0] = e0[0] * bs[0] + e0[1]; a[1] *= e0[2]; bs[1] = e0[2] * bs[1] + e0[3]; a[2] *= e1[0]; bs[2] = e1[0] * bs[2] + e1[1]; a[3] *= e1[2]; bs[3] = e1[2] * bs[3] + e1[3]; }
            f32x4* qg = (f32x4*)(SEGB + (((size_t)b * 32 + seg) * 1024 + ch) * 2);
            qg[0] = (f32x4){a[0], bs[0], a[1], bs[1]}; qg[1] = (f32x4){a[2], bs[2], a[3], bs[3]}; }
        __syncthreads();
    } else if (SWEEP == 1) {
        *(f32x4*)(p.out + O_NLS + ((size_t)l * DB + bb) * 1024 + ch) = (f32x4){h[0], h[1], h[2], h[3]};
    } else if (SWEEP == 2) {
        if (!samp) { if (seg == 31 && sub == 7) *(f32x4*)(p.out + O_NLP + ((size_t)l * NB + b) * 1024 + ch) = (f32x4){h[0], h[1], h[2], h[3]}; }
        else *(f32x4*)(p.out + O_NLS + ((size_t)l * DB + bb) * 1024 + ch) = (f32x4){h[0], h[1], h[2], h[3]};
    }
}
template <int SWEEP>
__device__ __forceinline__ void ph_lru_scan(const Params& p, int l, LAS unsigned char* lds, bool dry) {
    constexpr int NI = SWEEP == 1 ? 512 + 16 : 512;
    const int tid = tid_opaque(), ch = (blockIdx.x & 3) * 256 + (tid & 63) * 4;
    LruConst K;
#pragma unroll
    for (int i = 0; i < 4; ++i) { K.ba[i] = p.in[I_LBA][l * 1024 + ch + i]; K.bx[i] = p.in[I_LBX][l * 1024 + ch + i]; K.sp[i] = log1pf(expf(-p.in[I_LAM][l * 1024 + ch + i]));
        const float* cw = p.in[I_CW] + (size_t)l * 4 * 1024 + ch + i; K.w0[i] = cw[0]; K.w1[i] = cw[1024]; K.w2[i] = cw[2048]; K.w3[i] = cw[3072]; K.cbv[i] = p.in[I_CB][l * 1024 + ch + i]; }
    const int G4 = (int)gridDim.x & ~3;
    if ((int)blockIdx.x < G4) for (int it = blockIdx.x; it < NI; it += G4) lru_scan_item<SWEEP>(p, l, lds, it, dry, K, tid);
}

#define XB_TMO      128
#define XB_XCNT(j)  (256  + 64 * (j))
#define XB_XSUB(j)  (1280 + 64 * (j))
#define XB_XGEN(j)  (2304 + 64 * (j))
#define XB_TOP      3328
#define XB_TOPGEN   3392
#define XCD_BAR_WORDS 3456
#define XB_SPIN_CAP (1u << 18)
__device__ __forceinline__ unsigned xb_ld(unsigned* p)              { return __hip_atomic_load(p, __ATOMIC_RELAXED, __HIP_MEMORY_SCOPE_AGENT); }
__device__ __forceinline__ unsigned xb_add(unsigned* p, unsigned v) { return __hip_atomic_fetch_add(p, v, __ATOMIC_RELAXED, __HIP_MEMORY_SCOPE_AGENT); }
__device__ __forceinline__ unsigned xb_xcc_id() { return (unsigned)__builtin_amdgcn_s_getreg((3 << 11) | 20) & 0xFu; }
#define XB_SPIN(cond, bar) do { unsigned _sp = 0; while (cond) { __builtin_amdgcn_s_sleep(1); \
    if ((++_sp & 255u) == 0u) { if (xb_ld(&(bar)[XB_TMO])) break; if (_sp > XB_SPIN_CAP) { atomicAdd(&(bar)[XB_TMO], 1u); break; } } } } while (0)
struct XcdBarrier { unsigned* bar; unsigned x; volatile LAS unsigned* st; };
__device__ __forceinline__ XcdBarrier xcd_barrier_post(unsigned* bar, volatile LAS unsigned* st) {
    XcdBarrier b; b.bar = bar; b.x = xb_xcc_id(); b.st = st;
    if (threadIdx.x == 0) (void)xb_add(&bar[XB_XCNT(b.x)], 1u);
    return b;
}
__device__ __forceinline__ void xcd_barrier_complete(unsigned* bar, unsigned x, unsigned& nloc, unsigned& nx) {
    const unsigned G = gridDim.x * gridDim.y * gridDim.z;
    unsigned sum, cnt, mine, sp = 0u;
    for (;;) {
        sum = 0u; cnt = 0u; mine = 0u;
#pragma unroll
        for (unsigned j = 0; j < 16; ++j) { const unsigned c = xb_ld(&bar[XB_XCNT(j)]); sum += c; cnt += (c > 0u) ? 1u : 0u; mine = (j == x) ? c : mine; }
        if (sum == G) break;
        __builtin_amdgcn_s_sleep(1);
        if ((++sp & 255u) == 0u) { if (xb_ld(&bar[XB_TMO])) break; if (sp > XB_SPIN_CAP) { atomicAdd(&bar[XB_TMO], 1u); break; } }
    }
    nloc = mine > 0u ? mine : 1u; nx = cnt > 0u ? cnt : 1u;
}
__device__ __forceinline__ void xcd_barrier(const XcdBarrier& b) {
    asm volatile("s_waitcnt vmcnt(0)" ::: "memory");
    __syncthreads();
    if (threadIdx.x == 0) {
        unsigned* bar = b.bar;
        __builtin_amdgcn_s_waitcnt(0);
        unsigned nloc = b.st[0], nx = b.st[1];
        if (nloc == 0u) { xcd_barrier_complete(bar, b.x, nloc, nx); b.st[0] = nloc; b.st[1] = nx; }
        const unsigned old = xb_add(&bar[XB_XSUB(b.x)], 1u);
        const unsigned gen = old / nloc;
        if (old + 1u == (gen + 1u) * nloc) {
            __builtin_amdgcn_fence(__ATOMIC_RELEASE, "agent");
            asm volatile("s_waitcnt vmcnt(0)" ::: "memory");
            const unsigned og = xb_add(&bar[XB_TOP], 1u);
            const unsigned tg = og / nx;
            if (og + 1u == (tg + 1u) * nx) xb_add(&bar[XB_TOPGEN], 1u);
            else XB_SPIN(xb_ld(&bar[XB_TOPGEN]) == tg, bar);
            __builtin_amdgcn_fence(__ATOMIC_ACQUIRE, "agent");
            xb_add(&bar[XB_XGEN(b.x)], 1u);
            asm volatile("s_waitcnt vmcnt(0)" ::: "memory");
        } else {
            XB_SPIN(xb_ld(&bar[XB_XGEN(b.x)]) == gen, bar);
            __builtin_amdgcn_fence(__ATOMIC_ACQUIRE, "agent");
            asm volatile("s_waitcnt vmcnt(0)" ::: "memory");
        }
    }
    __syncthreads();
}

constexpr int NPL = 22, NPH = DEPTH * NPL + 1;
template <int K>
__device__ __forceinline__ void run_phase(const Params& p, int l, LAS unsigned char* lds, bool dry) {
    bf16_t* Wb = (bf16_t*)(p.ws + OFF_W); bf16_t* H = (bf16_t*)(p.ws + OFF_H); bf16_t* MG = (bf16_t*)(p.ws + OFF_MG); bf16_t* P = (bf16_t*)(p.ws + OFF_P);
    float* X = p.out;
    if constexpr (K == 0) { ph_convert(p, l, lds); ph_norm(p, p.in[I_NF1] + l * DM, l == 0, 11); }
    else if constexpr (K == 1) { EpiSwiGLU e; e.G = P; run_gemm(lds, H, DM, Wb + W_UP1, 2 * DFF, DM, e); }
    else if constexpr (K == 2) run_gemm_resid(lds, P, DFF, Wb + W_DN1, DFF, X, 0.5f, (float*)(p.ws + OFF_S));
    else if constexpr (K == 3) ph_norm(p, p.in[I_NMIX] + l * DM, false, 11);
    else if constexpr (K == 4) { EpiStore e; e.O = P; e.ldc = LDC_; run_gemm(lds, H, DM, Wb + W_IN + (size_t)2560 * 1024, 3072, DM, e); }
    else if constexpr (K == 5) ph_conv(p, l);
    else if constexpr (K == 6) { EpiStoreLru e; e.O = P; e.ldc = LDC_; run_gemm_lru(lds, MG, Wb + W_LRU, e); }
    else if constexpr (K == 7) ph_lru_scan<1>(p, l, lds, false);
    else if constexpr (K == 8) ph_lru_scan<2>(p, l, lds, dry);
    else if constexpr (K == 9) { EpiGate e; e.MG = MG; e.gate = P + 2048; e.ldg = LDC_; e.accum = 0; run_gemm(lds, P + 1024, LDC_, Wb + W_LO, DM, DM, e); }
    else if constexpr (K == 10) { EpiStore e; e.O = P; e.ldc = LDA_; run_gemm(lds, H, DM, Wb + W_IN, 2560, DM, e); }
    else if constexpr (K == 11) ph_attn(p, l, lds, dry);
    else if constexpr (K == 12) { EpiGate e; e.MG = MG; e.gate = P + 1536; e.ldg = LDA_; e.accum = 1; run_gemm(lds, P, LDA_, Wb + W_AO, DM, DM, e); }
    else if constexpr (K == 13) { EpiStore e; e.O = P; e.ldc = LDB_; run_gemm(lds, H, DM, Wb + W_IN + (size_t)5632 * 1024, 5120, DM, e, MP); }
    else if constexpr (K == 14) {
        if ((int)gridDim.x >= 64) { pg8::TailOrder S; S.c = (int)blockIdx.x - ((int)gridDim.x - 40);
            if (S.c >= 0) { EpiStore e; e.O = P; e.ldc = LDB_; pg8::Gemm g; g.A = H; g.Bt = Wb + W_IN + (size_t)5632 * 1024; g.M = MT; g.N = 5120; g.K = DM; g.lda = DM; g.ldb = DM;
                pg8::gemm_phase<EpiStore, pg8::TailOrder>(lds, g, S, e); } }
        else { EpiStore e; e.O = P; e.ldc = LDB_; pg8::Gemm g; g.A = H + (size_t)MP * DM; g.Bt = Wb + W_IN + (size_t)5632 * 1024; g.M = MS; g.N = 5120; g.K = DM; g.lda = DM; g.ldb = DM;
            EpiStore e2 = e; e2.O = P + (size_t)MP * LDB_; pg8::StaticOrder S; S.init(MS, 5120, (int)gridDim.x, (int)blockIdx.x); pg8::gemm_phase<EpiStore, pg8::StaticOrder>(lds, g, S, e2); }
        ph_hgrn1(p, l, lds); }
    else if constexpr (K == 15) ph_hgrn2(p);
    else if constexpr (K == 16) ph_hgrn3(p, l, lds, dry);
    else if constexpr (K == 17) { EpiGate e; e.MG = MG; e.gate = P + 4096; e.ldg = LDB_; e.accum = 1; run_gemm(lds, P + 3072, LDB_, Wb + W_HO, DM, DM, e); }
    else if constexpr (K == 18) run_gemm_resid(lds, MG, DM, Wb + W_OUT, DM, X, 1.f, (float*)(p.ws + OFF_S));
    else if constexpr (K == 19) ph_norm(p, p.in[I_NF2] + l * DM, false, 4);
    else if constexpr (K == 20) { EpiSwiGLU e; e.G = P; run_gemm(lds, H, DM, Wb + W_UP2, 2 * DFF, DM, e); }
    else if constexpr (K == 21) run_gemm_resid(lds, P, DFF, Wb + W_DN2, DFF, X, 0.5f, (float*)(p.ws + OFF_S));
    else {
        const float* part = (const float*)(p.ws + OFF_S);
        for (int i = blockIdx.x * 512 + tid_opaque(); i < MS * DM / 4; i += gridDim.x * 512) { f32x4 v = ((f32x4*)(X + (size_t)MP * DM))[i];
            for (int c = 0; c < 11; ++c) v += ((const f32x4*)(part + (size_t)c * MS * DM))[i];
            ((f32x4*)(X + (size_t)MP * DM))[i] = v; }
    }
}

__global__ void __launch_bounds__(512, 2) mega(Params p, int ph_lo, int ph_hi) {
    extern __shared__ __attribute__((aligned(16))) unsigned char shm[];
    LAS unsigned char* lds = (LAS unsigned char*)shm;
    cg::grid_group grid = cg::this_grid();
    volatile LAS unsigned* st = (volatile LAS unsigned*)(lds + LDS_MAIN);
    if (threadIdx.x < 4) st[threadIdx.x] = 0u;
    __syncthreads();
    const XcdBarrier xb = xcd_barrier_post(p.bar, st);
    if (ph_hi < 0) grid.sync();
#define SEAM(ph) { xcd_barrier(xb); }
#define PHASE(L, K) { constexpr int ph = (L) * NPL + (K); if (ph >= ph_lo && ph < ph_hi) { if constexpr ((DUP_MASK >> (K)) & 1) { run_phase<K>(p, L, lds, p.one != 0); SEAM(1) } run_phase<K>(p, L, lds, false); if (ph + 1 < ph_hi) SEAM(ph) } }
#define LAYER(L) PHASE(L, 0) PHASE(L, 1) PHASE(L, 2) PHASE(L, 3) PHASE(L, 4) PHASE(L, 5) PHASE(L, 6) PHASE(L, 7) PHASE(L, 8) PHASE(L, 9) \
    PHASE(L, 10) PHASE(L, 11) PHASE(L, 12) PHASE(L, 13) PHASE(L, 14) PHASE(L, 15) PHASE(L, 16) PHASE(L, 17) PHASE(L, 18) PHASE(L, 19) PHASE(L, 20) PHASE(L, 21)
    LAYER(0)
    LAYER(1)
    PHASE(1, 22)
#undef LAYER
#undef PHASE
}

extern "C" void kernel_launch(void* const* d_in, const int* in_sizes, int n_in, void* d_out, int out_size, void* d_ws, size_t ws_size, hipStream_t stream) {
    static int grid = 0;
    if (grid == 0) {
        if (n_in != 31 || ws_size < WS_NEED) { fprintf(stderr, "kernel_launch: unexpected n_in %d or ws %zu < %zu\n", n_in, ws_size, (size_t)WS_END); grid = -1; return; }
        int dev = 0, cus = 0, per_cu = 0;
        (void)hipGetDevice(&dev); (void)hipDeviceGetAttribute(&cus, hipDeviceAttributeMultiprocessorCount, dev);
        if (hipFuncSetAttribute((const void*)mega, hipFuncAttributeMaxDynamicSharedMemorySize, LDS_BYTES) != hipSuccess) { fprintf(stderr, "hipFuncSetAttribute failed\n"); grid = -1; return; }
        if (hipOccupancyMaxActiveBlocksPerMultiprocessor(&per_cu, (const void*)mega, 512, LDS_BYTES) != hipSuccess || per_cu < 1) { fprintf(stderr, "occupancy query: %d\n", per_cu); per_cu = 1; }
        (void)hipGetLastError();
        grid = cus * 1;
    }
    if (grid < 0) return;
    Params p{};
    for (int i = 0; i < 31; ++i) p.in[i] = (const float*)d_in[i];
    p.out = (float*)d_out; p.ws = (unsigned char*)d_ws; p.one = 1; p.bar = (unsigned*)((unsigned char*)d_ws + OFF_BAR);
    (void)hipMemsetAsync((unsigned char*)d_ws + OFF_BAR, 0, 3456 * 4, stream);
#if ONE_LAUNCH
    int lo = 0, hi = NPH;
    void* args[] = {&p, &lo, &hi};
    hipError_t e = hipLaunchCooperativeKernel((const void*)mega, dim3(grid), dim3(512), args, LDS_BYTES, stream);
    if (e != hipSuccess) fprintf(stderr, "cooperative launch failed: %s (grid %d)\n", hipGetErrorString(e), grid);
#else
    for (int ph = 0; ph < NPH; ++ph) mega<<<dim3(grid), dim3(512), LDS_BYTES, stream>>>(p, ph, ph + 1);
#endif
}
```

```cpp
#include <hip/hip_runtime.h>
#include <hip/hip_cooperative_groups.h>
#include <cstdio>
#include <cstdint>
namespace cg = cooperative_groups;

#ifndef ONE_LAUNCH
#define ONE_LAUNCH 1
#endif

#ifndef DUP_MASK
#define DUP_MASK 0
#endif
#define LAS __attribute__((address_space(3)))
typedef unsigned short bf16_t;
typedef short bf16x8 __attribute__((ext_vector_type(8)));
typedef short bf16x4 __attribute__((ext_vector_type(4)));
typedef float f32x4 __attribute__((ext_vector_type(4)));
typedef unsigned u32x4 __attribute__((ext_vector_type(4)));
typedef unsigned u32x2 __attribute__((ext_vector_type(2)));

constexpr int DM = 1024, NB = 4, SEQ = 4096, DEPTH = 2, DB = 32, DSQ = 16, DFF = 2816;
constexpr int MP = NB * SEQ, MS = DB * DSQ, MT = MP + MS;
constexpr int INC = 10752;
constexpr int LDA_ = 2560, LDC_ = 5120, LDB_ = 5120;
constexpr float EPS = 1e-6f;
constexpr int NSEG = 16, SEGT = 256;

constexpr size_t W_UP1 = 0, W_DN1 = W_UP1 + (size_t)5632 * 1024, W_IN = W_DN1 + (size_t)1024 * 2816, W_AO = W_IN + (size_t)INC * 1024,
                 W_HO = W_AO + 1048576, W_LO = W_HO + 1048576, W_OUT = W_LO + 1048576, W_UP2 = W_OUT + 1048576, W_DN2 = W_UP2 + (size_t)5632 * 1024,
                 W_LRU = W_DN2 + (size_t)1024 * 2816, W_END = W_LRU + (size_t)2048 * 256;
constexpr size_t OFF_W = 0, OFF_H = OFF_W + W_END * 2, OFF_MG = OFF_H + (size_t)MT * 1024 * 2, OFF_P = OFF_MG + (size_t)MT * 1024 * 2,
                 OFF_S = OFF_P + (size_t)MT * 5120 * 2, OFF_D = OFF_S + (size_t)NB * 8 * NSEG * 16384 * 4, WS_END = OFF_D + (size_t)NB * 8 * NSEG * 128 * 4;
constexpr size_t O_NKP = 17301504, O_NVP = 17563648, O_NHP = 17825792, O_NCP = 18874368, O_NLP = 18898944, O_NKS = 18907136, O_NVS = 19169280,
                 O_NHS = 19431424, O_NCS = 27820032, O_NLS = 28016640;

constexpr int LDS_MAIN = 156416, LDS_BYTES = LDS_MAIN + 16;
constexpr size_t OFF_BAR = (WS_END + 255) / 256 * 256, WS_NEED = OFF_BAR + 3456 * 4;

struct Params { const float* in[31]; float* out; unsigned char* ws; unsigned* bar; long one; };
enum { I_XP = 0, I_XS, I_CK, I_CV, I_SH, I_SC, I_SL, I_NF1, I_UP1, I_DN1, I_NMIX, I_WIN, I_QN, I_KN, I_SINK, I_WAO, I_LBL, I_HON, I_WHO, I_CW, I_CB,
       I_LWA, I_LBA, I_LWX, I_LBX, I_LAM, I_WLO, I_WOUT, I_NF2, I_UP2, I_DN2 };

__device__ __forceinline__ float bf2f(unsigned v) { return __uint_as_float(v << 16); }
__device__ __forceinline__ unsigned f2bf(float f) { unsigned u = __float_as_uint(f); u += 0x7FFFu + ((u >> 16) & 1u); return u >> 16; }
__device__ __forceinline__ unsigned pk2(float lo, float hi) { return f2bf(lo) | (f2bf(hi) << 16); }
__device__ __forceinline__ float sigm(float x) { return 1.f / (1.f + __expf(-x)); }
__device__ __forceinline__ float siluf(float x) { return x / (1.f + __expf(-x)); }
__device__ __forceinline__ float gelu_tanh(float x) { const float u = 0.7978845608028654f * (x + 0.044715f * x * x * x); const float e = __expf(2.f * u); const float th = 1.f - 2.f / (e + 1.f); return 0.5f * x * (1.f + th); }
__device__ __forceinline__ void unpack8(u32x4 r, float (&o)[8]) {
    o[0] = bf2f(r.x & 0xffffu); o[1] = bf2f(r.x >> 16); o[2] = bf2f(r.y & 0xffffu); o[3] = bf2f(r.y >> 16);
    o[4] = bf2f(r.z & 0xffffu); o[5] = bf2f(r.z >> 16); o[6] = bf2f(r.w & 0xffffu); o[7] = bf2f(r.w >> 16);
}
__device__ __forceinline__ u32x4 pack8(const float (&v)[8]) { u32x4 r; r.x = pk2(v[0], v[1]); r.y = pk2(v[2], v[3]); r.z = pk2(v[4], v[5]); r.w = pk2(v[6], v[7]); return r; }
__device__ __forceinline__ int tid_opaque() { int t = (int)__builtin_amdgcn_workitem_id_x(); asm volatile("" : "+v"(t)); return t; }
typedef float f32x2 __attribute__((ext_vector_type(2)));
template <int N> __device__ __forceinline__ float row_ror(float x) { return __builtin_bit_cast(float, __builtin_amdgcn_update_dpp(0, __builtin_bit_cast(int, x), 0x120 + N, 0xf, 0xf, false)); }
#define LDS_WAIT() asm volatile("s_waitcnt lgkmcnt(0)" ::: "memory")

namespace pg8 {
constexpr int BM = 256, BK = 64, HALF = 128, HTB = HALF * BK * 2, STAGE_BYTES = 8 * HTB, NXCD = 8, WGM = 8;
__device__ __forceinline__ int lds_byte(int r, int c) { const int st = (r >> 4) * 2 + (c >> 5), rr = r & 15, cc = c & 31, ob = rr * 64 + cc * 2; return st * 1024 + (ob ^ (((ob >> 9) & 1) << 5)); }
__device__ __forceinline__ void stage_rc(int b, int& R, int& C) { const int st = b / 1024, sb = b % 1024, swz = sb ^ (((sb >> 9) & 1) << 5); R = (st >> 1) * 16 + swz / 64; C = (st & 1) * 32 + (swz % 64) / 2; }
struct Unit { int pm, pn, aoff, boff; };
struct Gemm { const bf16_t* A; const bf16_t* Bt; int M, N, K, lda, ldb; };
struct StaticOrder {
    int nM, nN, nwg, G, c;
    __device__ void init(int M, int N, int G_, int c_) { nM = M / BM; nN = N / BM; nwg = nM * nN; G = G_; c = c_; }
    __device__ bool next(int i, Unit& u) const {
        const long L = (long)i * G + c; if (L >= nwg) return false;
        int wgid = (int)L; { const int q = nwg / NXCD, r = nwg % NXCD, xcd = wgid % NXCD, off = wgid / NXCD; wgid = (xcd < r ? xcd * (q + 1) : r * (q + 1) + (xcd - r) * q) + off; }
        const int nig = WGM * nN, gid = wgid / nig, fm = gid * WGM, gsz = (nM - fm) < WGM ? (nM - fm) : WGM;
        u.pm = fm + ((wgid % nig) % gsz); u.pn = (wgid % nig) / gsz; u.aoff = 0; u.boff = 0; return true;
    }
};
struct LruOrder : StaticOrder {
    __device__ bool next(int i, Unit& u) const { if (!StaticOrder::next(i, u)) return false; u.aoff = (u.pn >> 1) * 512; return true; }
};
struct SplitOrder {
    int nchunk, total, c;
    __device__ void init(int nunits, int nchunk_, int c_) { nchunk = nchunk_; total = nunits * nchunk_; c = c_; }
    __device__ bool next(int i, Unit& u) const { if (i != 0 || c >= total) return false; const int unit = c / nchunk, ch = c % nchunk; u.pm = unit >> 2; u.pn = unit & 3; u.aoff = ch * 512; u.boff = ch * 512; return true; }
};
struct TailOrder {
    int c;
    __device__ bool next(int i, Unit& u) const { if (c < 0 || i > 0 || c >= 40) return false; u.pm = 64 + c / 20; u.pn = c % 20; u.aoff = 0; u.boff = 0; return true; }
};
template <class Epi, class Sched>
__device__ __forceinline__ void gemm_phase(LAS unsigned char* lds, const Gemm g, const Sched& S, const Epi& E) {
    const int tid = tid_opaque(), wid = __builtin_amdgcn_readfirstlane(tid >> 6), lane = tid & 63, wr = wid >> 2, wc = wid & 3, fr = lane & 15, fq = lane >> 4;
    const int K = g.K, nt = K / BK, lda = g.lda, ldb = g.ldb;
    unsigned voffA[2], voffB[2];
#pragma unroll
    for (int i = 0; i < 2; ++i) { int R, C; stage_rc(tid * 16 + i * 8192, R, C); voffA[i] = (unsigned)(R * lda + C) * 2u; voffB[i] = (unsigned)(R * ldb + C) * 2u; }
    const size_t kstep = (size_t)(BK * 2);
    const size_t hstepA = (size_t)HALF * lda * 2, tstepA = 2 * hstepA;
    const size_t hstepB = (size_t)HALF * ldb * 2, tstepB = 2 * hstepB;
    const unsigned ldsw = (unsigned)wid * 1024u;
    const int aoff = lds_byte(wr * 64 + fr, fq * 8), boff = lds_byte(wc * 32 + fr, fq * 8);
#define PG8_SA(b, h) (((b) * 2 + (h)) * HTB)
#define PG8_SB(b, h) ((4 + (b) * 2 + (h)) * HTB)
#define PG8_STAGE(bufoff, gbase, voff) do { _Pragma("unroll") for (int _i = 0; _i < 2; ++_i) \
        __builtin_amdgcn_global_load_lds((const unsigned*)((const char*)(gbase) + (voff)[_i]), (LAS unsigned*)(lds + (bufoff) + ldsw + _i * 8192), 16, 0, 0); } while (0)
#define PG8_LDA(dst, b, h) do { _Pragma("unroll") for (int m = 0; m < 4; ++m) _Pragma("unroll") for (int k = 0; k < 2; ++k) dst[m][k] = *(const LAS bf16x8*)(lds + PG8_SA(b, h) + aoff + m * 2048 + k * 1024); } while (0)
#define PG8_LDB(dst, b, h) do { _Pragma("unroll") for (int n = 0; n < 2; ++n) _Pragma("unroll") for (int k = 0; k < 2; ++k) dst[n][k] = *(const LAS bf16x8*)(lds + PG8_SB(b, h) + boff + n * 2048 + k * 1024); } while (0)
#define PG8_MMA(ai, bj, At, Bt) do { __builtin_amdgcn_s_setprio(1); _Pragma("unroll") for (int m = 0; m < 4; ++m) _Pragma("unroll") for (int n = 0; n < 2; ++n) _Pragma("unroll") for (int k = 0; k < 2; ++k) \
        acc[ai][bj][m][n] = __builtin_amdgcn_mfma_f32_16x16x32_bf16(Bt[n][k], At[m][k], acc[ai][bj][m][n], 0, 0, 0); __builtin_amdgcn_s_setprio(0); } while (0)
#define PG8_WAIT_V(n) asm volatile("s_waitcnt vmcnt(" #n ")" ::: "memory")
#define PG8_WAIT_L(n) asm volatile("s_waitcnt lgkmcnt(" #n ")" ::: "memory")
#define PG8_BAR __builtin_amdgcn_s_barrier()
#define PG8_SCHED __builtin_amdgcn_sched_barrier(0)
    Unit cur, nxt; int ui = 0;
    if (!S.next(0, cur)) return;
    f32x4 acc[2][2][4][2];
#pragma unroll
    for (int a = 0; a < 2; ++a)
#pragma unroll
        for (int b = 0; b < 2; ++b)
#pragma unroll
            for (int m = 0; m < 4; ++m)
#pragma unroll
                for (int n = 0; n < 2; ++n) acc[a][b][m][n] = (f32x4){0.f, 0.f, 0.f, 0.f};
    bf16x8 At[4][2], B0[2][2], B1[2][2];
    const char* cA = (const char*)g.A + (size_t)cur.pm * tstepA + cur.aoff; const char* cB = (const char*)g.Bt + (size_t)cur.pn * tstepB + cur.boff;
    PG8_STAGE(PG8_SB(0, 0), cB, voffB); PG8_STAGE(PG8_SA(0, 0), cA, voffA); PG8_STAGE(PG8_SB(0, 1), cB + hstepB, voffB); PG8_STAGE(PG8_SA(0, 1), cA + hstepA, voffA);
    if (wr == 1) PG8_BAR;
    PG8_WAIT_V(4); PG8_BAR;
    PG8_STAGE(PG8_SB(1, 0), cB + kstep, voffB); PG8_STAGE(PG8_SA(1, 0), cA + kstep, voffA); PG8_STAGE(PG8_SB(1, 1), cB + hstepB + kstep, voffB);
    PG8_WAIT_V(6); PG8_BAR;
    for (;;) {
        const bool has_next = S.next(ui + 1, nxt);
        const char* nA = has_next ? (const char*)g.A + (size_t)nxt.pm * tstepA + nxt.aoff : cA; const char* nB = has_next ? (const char*)g.Bt + (size_t)nxt.pn * tstepB + nxt.boff : cB;
        for (int t = 0; t < nt; t += 2) {
            const bool last = (t == nt - 2);
            const char* a1 = cA + (size_t)(t + 1) * kstep;
            const char* a2 = last ? nA : cA + (size_t)(t + 2) * kstep; const char* b2 = last ? nB : cB + (size_t)(t + 2) * kstep;
            const char* a3 = a2 + kstep; const char* b3 = b2 + kstep;
            PG8_LDB(B0, 0, 0); PG8_SCHED; PG8_LDA(At, 0, 0); PG8_STAGE(PG8_SA(1, 1), a1 + hstepA, voffA);
            PG8_WAIT_L(8); PG8_BAR; PG8_WAIT_L(0); PG8_MMA(0, 0, At, B0); PG8_BAR; PG8_SCHED;
            PG8_LDB(B1, 0, 1); PG8_STAGE(PG8_SB(0, 0), b2, voffB);
            PG8_BAR; PG8_WAIT_L(0); PG8_MMA(0, 1, At, B1); PG8_BAR;
            PG8_LDA(At, 0, 1); PG8_STAGE(PG8_SA(0, 0), a2, voffA);
            PG8_BAR; PG8_WAIT_L(0); PG8_MMA(1, 0, At, B0); PG8_BAR; PG8_SCHED;
            PG8_STAGE(PG8_SB(0, 1), b2 + hstepB, voffB);
            PG8_WAIT_V(6); PG8_BAR; PG8_MMA(1, 1, At, B1); PG8_BAR;
            PG8_LDB(B0, 1, 0); PG8_SCHED; PG8_LDA(At, 1, 0); PG8_STAGE(PG8_SA(0, 1), a2 + hstepA, voffA);
            PG8_WAIT_L(8); PG8_BAR; PG8_WAIT_L(0); PG8_MMA(0, 0, At, B0); PG8_BAR; PG8_SCHED;
            PG8_LDB(B1, 1, 1); PG8_STAGE(PG8_SB(1, 0), b3, voffB);
            PG8_BAR; PG8_WAIT_L(0); PG8_MMA(0, 1, At, B1); PG8_BAR;
            PG8_LDA(At, 1, 1); PG8_STAGE(PG8_SA(1, 0), a3, voffA);
            PG8_BAR; PG8_WAIT_L(0); PG8_MMA(1, 0, At, B0); PG8_BAR; PG8_SCHED;
            PG8_STAGE(PG8_SB(1, 1), b3 + hstepB, voffB);
            PG8_WAIT_V(6); PG8_BAR; PG8_MMA(1, 1, At, B1); PG8_BAR;
        }
        E(acc, cur, wr, wc, fr, fq);
        if (!has_next) break;
#pragma unroll
        for (int a = 0; a < 2; ++a)
#pragma unroll
            for (int b = 0; b < 2; ++b)
#pragma unroll
                for (int m = 0; m < 4; ++m)
#pragma unroll
                    for (int n = 0; n < 2; ++n) acc[a][b][m][n] = (f32x4){0.f, 0.f, 0.f, 0.f};
        cur = nxt; cA = nA; cB = nB; ++ui;
    }
    PG8_WAIT_V(0);
    if (wr == 0) PG8_BAR;
    PG8_BAR;
#undef PG8_SA
#undef PG8_SB
#undef PG8_STAGE
#undef PG8_LDA
#undef PG8_LDB
#undef PG8_MMA
#undef PG8_WAIT_V
#undef PG8_WAIT_L
#undef PG8_BAR
#undef PG8_SCHED
}
}
using pg8::Unit;

template <int LRU> struct EpiStoreT {
    bf16_t* O; int ldc;
    __device__ __forceinline__ void operator()(const f32x4 (&acc)[2][2][4][2], const Unit& u, int wr, int wc, int fr, int fq) const {
        const int row0 = u.pm * 256 + wr * 64 + fr, col0 = (LRU ? 3072 + (u.pn & 1) * 1024 + (u.pn >> 1) * 256 : u.pn * 256) + wc * 32 + 4 * fq;
#pragma unroll
        for (int ai = 0; ai < 2; ++ai)
#pragma unroll
            for (int m = 0; m < 4; ++m) { bf16_t* rowp = O + (size_t)(row0 + ai * 128 + m * 16) * ldc + col0;
#pragma unroll
                for (int bj = 0; bj < 2; ++bj)
#pragma unroll
                    for (int n = 0; n < 2; ++n) { const f32x4 v = acc[ai][bj][m][n]; u32x2 w; w.x = pk2(v[0], v[1]); w.y = pk2(v[2], v[3]); *(u32x2*)(rowp + bj * 128 + n * 16) = w; } }
    }
};
struct EpiSwiGLU {
    bf16_t* G;
    __device__ __forceinline__ void operator()(const f32x4 (&acc)[2][2][4][2], const Unit& u, int wr, int wc, int fr, int fq) const {
        const int row0 = u.pm * 256 + wr * 64 + fr, col0 = (u.pn * 256 + wc * 32) / 2 + 4 * fq;
#pragma unroll
        for (int ai = 0; ai < 2; ++ai)
#pragma unroll
            for (int m = 0; m < 4; ++m) { bf16_t* rowp = G + (size_t)(row0 + ai * 128 + m * 16) * DFF + col0;
#pragma unroll
                for (int bj = 0; bj < 2; ++bj) { const f32x4 gt = acc[ai][bj][m][0], vl = acc[ai][bj][m][1]; u32x2 w;
                    w.x = pk2(siluf(gt[0]) * vl[0], siluf(gt[1]) * vl[1]); w.y = pk2(siluf(gt[2]) * vl[2], siluf(gt[3]) * vl[3]); *(u32x2*)(rowp + bj * 64) = w; } }
    }
};
struct EpiResid {
    float* X; float scale;
    __device__ __forceinline__ void operator()(const f32x4 (&acc)[2][2][4][2], const Unit& u, int wr, int wc, int fr, int fq) const {
        const int row0 = u.pm * 256 + wr * 64 + fr, col0 = u.pn * 256 + wc * 32 + 4 * fq;
#pragma unroll
        for (int ai = 0; ai < 2; ++ai)
#pragma unroll
            for (int m = 0; m < 4; ++m) { float* rowp = X + (size_t)(row0 + ai * 128 + m * 16) * DM + col0;
#pragma unroll
                for (int bj = 0; bj < 2; ++bj)
#pragma unroll
                    for (int n = 0; n < 2; ++n) { f32x4* q = (f32x4*)(rowp + bj * 128 + n * 16); const f32x4 o = *q; *q = o + acc[ai][bj][m][n] * scale; } }
    }
};
struct EpiPart {
    float* PART; float scale;
    __device__ __forceinline__ void operator()(const f32x4 (&acc)[2][2][4][2], const Unit& u, int wr, int wc, int fr, int fq) const {
        const int row0 = u.pm * 256 + wr * 64 + fr, col0 = u.pn * 256 + wc * 32 + 4 * fq;
        float* base = PART + (size_t)(u.aoff >> 9) * MS * DM;
#pragma unroll
        for (int ai = 0; ai < 2; ++ai)
#pragma unroll
            for (int m = 0; m < 4; ++m) { float* rowp = base + (size_t)(row0 + ai * 128 + m * 16) * DM + col0;
#pragma unroll
                for (int bj = 0; bj < 2; ++bj)
#pragma unroll
                    for (int n = 0; n < 2; ++n) *(f32x4*)(rowp + bj * 128 + n * 16) = acc[ai][bj][m][n] * scale; }
    }
};
struct EpiGate {
    bf16_t* MG; const bf16_t* gate; int ldg; int accum;
    __device__ __forceinline__ void operator()(const f32x4 (&acc)[2][2][4][2], const Unit& u, int wr, int wc, int fr, int fq) const {
        const int row0 = u.pm * 256 + wr * 64 + fr, col0 = u.pn * 256 + wc * 32 + 4 * fq;
#pragma unroll
        for (int ai = 0; ai < 2; ++ai)
#pragma unroll
            for (int m = 0; m < 4; ++m) { const size_t r = (size_t)(row0 + ai * 128 + m * 16); bf16_t* rowp = MG + r * DM + col0; const bf16_t* gp = gate + r * ldg + col0;
#pragma unroll
                for (int bj = 0; bj < 2; ++bj)
#pragma unroll
                    for (int n = 0; n < 2; ++n) { const f32x4 v = acc[ai][bj][m][n]; const u32x2 gw = *(const u32x2*)(gp + bj * 128 + n * 16);
                        float o0 = sigm(bf2f(gw.x & 0xffffu)) * v[0], o1 = sigm(bf2f(gw.x >> 16)) * v[1], o2 = sigm(bf2f(gw.y & 0xffffu)) * v[2], o3 = sigm(bf2f(gw.y >> 16)) * v[3];
                        u32x2* q = (u32x2*)(rowp + bj * 128 + n * 16);
                        if (accum) { const u32x2 old = *q; o0 += bf2f(old.x & 0xffffu); o1 += bf2f(old.x >> 16); o2 += bf2f(old.y & 0xffffu); o3 += bf2f(old.y >> 16); }
                        u32x2 w; w.x = pk2(o0, o1); w.y = pk2(o2, o3); *q = w; } }
    }
};
template <class Epi> __device__ __forceinline__ void run_gemm(LAS unsigned char* lds, const bf16_t* A, int lda, const bf16_t* Bt, int N, int K, const Epi& E, int Mrows = MT) {
    pg8::Gemm g; g.A = A; g.Bt = Bt; g.M = Mrows; g.N = N; g.K = K; g.lda = lda; g.ldb = K;
    pg8::StaticOrder S; S.init(Mrows, N, (int)gridDim.x, (int)blockIdx.x);
    pg8::gemm_phase<Epi, pg8::StaticOrder>(lds, g, S, E);
}
__device__ __forceinline__ void run_gemm_resid(LAS unsigned char* lds, const bf16_t* A, int lda, const bf16_t* Bt, int K, float* X, float scale, float* PART) {
    EpiResid e; e.X = X; e.scale = scale;
    run_gemm(lds, A, lda, Bt, DM, K, e, MP);
    EpiPart ea; ea.PART = PART; ea.scale = scale;
    pg8::Gemm g; g.A = A + (size_t)MP * lda; g.Bt = Bt; g.M = MS; g.N = DM; g.K = 256; g.lda = lda; g.ldb = K;
    pg8::SplitOrder S; S.init(8, K / 256, (int)blockIdx.x);
    pg8::gemm_phase<EpiPart, pg8::SplitOrder>(lds, g, S, ea);
}
typedef EpiStoreT<0> EpiStore; typedef EpiStoreT<1> EpiStoreLru;
__device__ __forceinline__ void run_gemm_lru(LAS unsigned char* lds, const bf16_t* A, const bf16_t* Bt, const EpiStoreLru& E) {
    pg8::Gemm g; g.A = A; g.Bt = Bt; g.M = MT; g.N = 2048; g.K = 256; g.lda = DM; g.ldb = 256;
    pg8::LruOrder S; S.init(MT, 2048, (int)gridDim.x, (int)blockIdx.x);
    pg8::gemm_phase<EpiStoreLru, pg8::LruOrder>(lds, g, S, E);
}

__device__ __forceinline__ int srccol(int kind, int j) {
    if (kind == 0) return j;
    if (kind == 1) { const int grp = j >> 5, w = j & 31; return w < 16 ? grp * 16 + w : DFF + grp * 16 + (w - 16); }
    if (j < 1536) return j;
    if (j < 2560) return 7680 + (j - 1536);
    if (j < 4608) return 5632 + (j - 2560);
    if (j < 5632) return 9728 + (j - 4608);
    if (j < 9728) return 1536 + (j - 5632);
    return 8704 + (j - 9728);
}
__device__ __forceinline__ void conv_item(const float* W, int K, int N, bf16_t* WT, int kind, LAS float* scr, int item, int lane) {
    const int nblk = N / 32, kb = item / nblk, nb = item % nblk, k0 = 64 * kb, n0 = 32 * nb;
    const int sc = srccol(kind, n0 + (lane & 31));
    float wv[32];
#pragma unroll
    for (int i = 0; i < 32; ++i) { const int kk = 2 * i + (lane >> 5); wv[i] = W[(size_t)(k0 + kk) * N + sc]; }
#pragma unroll
    for (int i = 0; i < 32; ++i) { const int kk = 2 * i + (lane >> 5); scr[kk * 33 + (lane & 31)] = wv[i]; }
    LDS_WAIT();
    const int c = lane & 7;
#pragma unroll
    for (int j = 0; j < 4; ++j) { const int n = (lane >> 3) + 8 * j; const LAS float* s = scr + (8 * c) * 33 + n;
        u32x4 o; o.x = pk2(s[0 * 33], s[1 * 33]); o.y = pk2(s[2 * 33], s[3 * 33]); o.z = pk2(s[4 * 33], s[5 * 33]); o.w = pk2(s[6 * 33], s[7 * 33]);
        *(u32x4*)(WT + (size_t)(n0 + n) * K + k0 + 8 * c) = o; }
    LDS_WAIT();
}
__device__ __forceinline__ void ph_convert(const Params& p, int l, LAS unsigned char* lds) {
    const int wave = tid_opaque() >> 6, lane = tid_opaque() & 63;
    LAS float* scr = (LAS float*)(lds + wave * 8704);
    bf16_t* Wb = (bf16_t*)(p.ws + OFF_W);
    const int gw = blockIdx.x * 8 + wave, NGW = gridDim.x * 8;
    constexpr int I_UP = (1024 / 64) * (5632 / 32), I_DN = (2816 / 64) * (1024 / 32), I_IN = (1024 / 64) * (INC / 32), I_SQ = (1024 / 64) * (1024 / 32);
    constexpr int NIT = 2 * I_UP + 2 * I_DN + I_IN + 4 * I_SQ;
    for (int it = gw; it < NIT; it += NGW) {
        int r = it;
        if (r < I_UP) { conv_item(p.in[I_UP1] + (size_t)l * 1024 * 5632, 1024, 5632, Wb + W_UP1, 1, scr, r, lane); continue; } r -= I_UP;
        if (r < I_DN) { conv_item(p.in[I_DN1] + (size_t)l * 2816 * 1024, 2816, 1024, Wb + W_DN1, 0, scr, r, lane); continue; } r -= I_DN;
        if (r < I_IN) { conv_item(p.in[I_WIN] + (size_t)l * 1024 * INC, 1024, INC, Wb + W_IN, 2, scr, r, lane); continue; } r -= I_IN;
        if (r < I_SQ) { conv_item(p.in[I_WAO] + (size_t)l * 1048576, 1024, 1024, Wb + W_AO, 0, scr, r, lane); continue; } r -= I_SQ;
        if (r < I_SQ) { conv_item(p.in[I_WHO] + (size_t)l * 1048576, 1024, 1024, Wb + W_HO, 0, scr, r, lane); continue; } r -= I_SQ;
        if (r < I_SQ) { conv_item(p.in[I_WLO] + (size_t)l * 1048576, 1024, 1024, Wb + W_LO, 0, scr, r, lane); continue; } r -= I_SQ;
        if (r < I_SQ) { conv_item(p.in[I_WOUT] + (size_t)l * 1048576, 1024, 1024, Wb + W_OUT, 0, scr, r, lane); continue; } r -= I_SQ;
        if (r < I_UP) { conv_item(p.in[I_UP2] + (size_t)l * 1024 * 5632, 1024, 5632, Wb + W_UP2, 1, scr, r, lane); continue; } r -= I_UP;
        conv_item(p.in[I_DN2] + (size_t)l * 2816 * 1024, 2816, 1024, Wb + W_DN2, 0, scr, r, lane);
    }
    for (int idx = blockIdx.x * 512 + tid_opaque(); idx < 2048 * 256; idx += gridDim.x * 512) {
        const int j = idx >> 8, k = idx & 255, pn = j >> 8, i = j & 255, g = pn >> 1, typ = pn & 1;
        const int blk = g * 4 + (i >> 6), dd = i & 63, blk_in = g * 4 + (k >> 6), cc = k & 63;
        float v = 0.f;
        if (blk == blk_in) v = p.in[typ ? I_LWX : I_LWA][(((size_t)l * 16 + blk) * 64 + cc) * 64 + dd];
        Wb[W_LRU + idx] = (bf16_t)f2bf(v);
    }
}

__device__ __forceinline__ float wave_sum(float v) {
#pragma unroll
    for (int o = 1; o < 64; o <<= 1) v += __shfl_xor(v, o);
    return v;
}
template <int NCH>
__device__ __forceinline__ void ph_norm(const Params& p, const float* g, bool init) {
    constexpr int nchunk = NCH;
    const int wave = tid_opaque() >> 6, lane = tid_opaque() & 63;
    const int gw = blockIdx.x * 8 + wave, NGW = gridDim.x * 8;
    float* X = p.out; bf16_t* H = (bf16_t*)(p.ws + OFF_H);
    f32x4 gv[4];
#pragma unroll
    for (int j = 0; j < 4; ++j) gv[j] = ((const f32x4*)g)[lane + 64 * j];
    for (int row = gw; row < MT; row += NGW) {
        const float* src = init ? (row < MP ? p.in[I_XP] + (size_t)row * DM : p.in[I_XS] + (size_t)(row - MP) * DM) : X + (size_t)row * DM;
        f32x4 v[4]; float s = 0.f;
#pragma unroll
        for (int j = 0; j < 4; ++j) v[j] = ((const f32x4*)src)[lane + 64 * j];
        const bool fold = !init && row >= MP && nchunk > 0;
        if (fold) { const float* part = (const float*)(p.ws + OFF_S) + (size_t)(row - MP) * DM;
            f32x4 pv[NCH][4];
#pragma unroll
            for (int c = 0; c < NCH; ++c)
#pragma unroll
                for (int j = 0; j < 4; ++j) pv[c][j] = ((const f32x4*)(part + (size_t)c * MS * DM))[lane + 64 * j];
#pragma unroll
            for (int c = 0; c < NCH; ++c)
#pragma unroll
                for (int j = 0; j < 4; ++j) v[j] += pv[c][j]; }
#pragma unroll
        for (int j = 0; j < 4; ++j) s += (v[j][0] * v[j][0] + v[j][1] * v[j][1]) + (v[j][2] * v[j][2] + v[j][3] * v[j][3]);
        s = wave_sum(s);
        const float rstd = rsqrtf(s * (1.f / DM) + EPS);
#pragma unroll
        for (int j = 0; j < 4; ++j) { u32x2 w; w.x = pk2(v[j][0] * rstd * gv[j][0], v[j][1] * rstd * gv[j][1]); w.y = pk2(v[j][2] * rstd * gv[j][2], v[j][3] * rstd * gv[j][3]);
            *(u32x2*)(H + (size_t)row * DM + (lane + 64 * j) * 4) = w;
            if (init || fold) ((f32x4*)(X + (size_t)row * DM))[lane + 64 * j] = v[j]; }
    }
}

constexpr int KS_LD = 72, VT_LD = 200;
constexpr int KS_OFF = 0, VT_OFF = 192 * KS_LD * 2;
template <bool SAMPLE>
__device__ __forceinline__ void attn_item(const Params& p, int l, LAS unsigned char* lds, int b, int c, int kvh, bool dry) {
    const int tid = tid_opaque(), wave = tid >> 6, lane = tid & 63, l15 = lane & 15, quad = lane >> 4;
    bf16_t* PA = (bf16_t*)(p.ws + OFF_P);
    LAS bf16_t* Ks = (LAS bf16_t*)(lds + KS_OFF); LAS bf16_t* Vt = (LAS bf16_t*)(lds + VT_OFF);
    const float* kg = p.in[I_KN] + l * 64; const float* qg = p.in[I_QN] + l * 64;
    constexpr int NQT = SAMPLE ? 1 : 2, NKT = SAMPLE ? 10 : 12;
    const bool active = SAMPLE ? (wave < 4) : true;
    const int g = SAMPLE ? (wave & 3) : (wave >> 1), tokbase = SAMPLE ? 0 : (wave & 1) * 32;
    const int hq = kvh * 4 + g;
    u32x4 qraw[NQT][2]; long qrow[NQT];
#pragma unroll
    for (int qt = 0; qt < NQT; ++qt) {
        const int tok = tokbase + qt * 16 + l15;
        qrow[qt] = SAMPLE ? ((long)MP + b * DSQ + tok) : ((long)b * SEQ + c * 64 + tok);
        const bf16_t* qp = PA + qrow[qt] * LDA_ + hq * 64;
        qraw[qt][0] = *(const u32x4*)(qp + quad * 8); qraw[qt][1] = *(const u32x4*)(qp + 32 + quad * 8);
    }
    {
        const int d8 = (tid & 7) * 8;
        float kgv[8];
#pragma unroll
        for (int i = 0; i < 8; ++i) kgv[i] = kg[d8 + i];
#pragma unroll
        for (int pass = 0; pass < 3; ++pass) {
            const int j = pass * 64 + (tid >> 3);
            float kf[8], vf[8]; bool valid, need_norm; long row = 0;
            if (!SAMPLE) { const int tk = (c - 2) * 64 + j; valid = tk >= 0; need_norm = true; row = (long)b * SEQ + tk; }
            else { valid = j < 144; need_norm = j >= 128; row = (long)MP + b * DSQ + (j - 128); }
            if (valid && need_norm) {
                const u32x4 kr = *(const u32x4*)(PA + row * LDA_ + 1024 + kvh * 64 + d8); const u32x4 vr = *(const u32x4*)(PA + row * LDA_ + 1280 + kvh * 64 + d8);
                unpack8(kr, kf); unpack8(vr, vf);
            } else if (valid) {
                const float* ck = p.in[I_CK] + ((((size_t)l * DB + b) * 128 + j) * 4 + kvh) * 64 + d8; const float* cv = p.in[I_CV] + ((((size_t)l * DB + b) * 128 + j) * 4 + kvh) * 64 + d8;
                const f32x4 a0 = *(const f32x4*)ck, a1 = *(const f32x4*)(ck + 4), b0 = *(const f32x4*)cv, b1 = *(const f32x4*)(cv + 4);
#pragma unroll
                for (int i = 0; i < 4; ++i) { kf[i] = a0[i]; kf[4 + i] = a1[i]; vf[i] = b0[i]; vf[4 + i] = b1[i]; }
            } else {
#pragma unroll
                for (int i = 0; i < 8; ++i) { kf[i] = 0.f; vf[i] = 0.f; }
            }
            float ss = 0.f;
#pragma unroll
            for (int i = 0; i < 8; ++i) ss += kf[i] * kf[i];
            ss += __shfl_xor(ss, 1); ss += __shfl_xor(ss, 2); ss += __shfl_xor(ss, 4);
            if (need_norm) { const float rstd = rsqrtf(ss * (1.f / 64.f) + EPS);
#pragma unroll
                for (int i = 0; i < 8; ++i) kf[i] = kf[i] * rstd * kgv[i]; }
            *(LAS u32x4*)(Ks + j * KS_LD + d8) = pack8(kf);
#pragma unroll
            for (int i = 0; i < 8; ++i) Vt[(d8 + i) * VT_LD + j] = (bf16_t)f2bf(vf[i]);
            if (!SAMPLE) { const int tk = (c - 2) * 64 + j;
                if (j >= 128 && tk >= SEQ - 128) { const size_t o = ((((size_t)l * NB + b) * 128 + (tk - (SEQ - 128))) * 4 + kvh) * 64 + d8;
#pragma unroll
                    for (int i = 0; i < 8; ++i) { p.out[O_NKP + o + i] = kf[i]; p.out[O_NVP + o + i] = vf[i]; } } }
            else if (j >= 128 && j < 144) { const size_t o = ((((size_t)l * DB + b) * DSQ + (j - 128)) * 4 + kvh) * 64 + d8;
#pragma unroll
                for (int i = 0; i < 8; ++i) { p.out[O_NKS + o + i] = kf[i]; p.out[O_NVS + o + i] = vf[i]; } }
        }
    }
    __syncthreads();
    if (active) {
        const float sink = p.in[I_SINK][l * 16 + hq];
        const int kmin = SAMPLE ? 0 : (c >= 2 ? 0 : (2 - c) * 64), kmax = SAMPLE ? 144 : 192;
        bf16x8 qf[NQT][2];
#pragma unroll
        for (int qt = 0; qt < NQT; ++qt) {
            float q0[8], q1[8]; unpack8(qraw[qt][0], q0); unpack8(qraw[qt][1], q1);
            float ss = 0.f;
#pragma unroll
            for (int i = 0; i < 8; ++i) ss += q0[i] * q0[i] + q1[i] * q1[i];
            ss += __shfl_xor(ss, 16); ss += __shfl_xor(ss, 32);
            const float sc = rsqrtf(ss * (1.f / 64.f) + EPS) * 0.125f;
#pragma unroll
            for (int i = 0; i < 8; ++i) { q0[i] = q0[i] * sc * qg[quad * 8 + i]; q1[i] = q1[i] * sc * qg[32 + quad * 8 + i]; }
            const u32x4 w0 = pack8(q0), w1 = pack8(q1);
            qf[qt][0] = __builtin_bit_cast(bf16x8, w0); qf[qt][1] = __builtin_bit_cast(bf16x8, w1);
        }
        f32x4 st[NKT][NQT];
#pragma unroll
        for (int kt = 0; kt < NKT; ++kt) {
#pragma unroll
            for (int qt = 0; qt < NQT; ++qt) st[kt][qt] = (f32x4){0.f, 0.f, 0.f, 0.f};
#pragma unroll
            for (int ds = 0; ds < 2; ++ds) {
                const bf16x8 kfr = *(const LAS bf16x8*)(Ks + (kt * 16 + l15) * KS_LD + ds * 32 + quad * 8);
#pragma unroll
                for (int qt = 0; qt < NQT; ++qt) st[kt][qt] = __builtin_amdgcn_mfma_f32_16x16x32_bf16(kfr, qf[qt][ds], st[kt][qt], 0, 0, 0);
            }
        }
        float inv[NQT];
#pragma unroll
        for (int qt = 0; qt < NQT; ++qt) {
            float m = -1e30f;
#pragma unroll
            for (int kt = 0; kt < NKT; ++kt)
#pragma unroll
                for (int j = 0; j < 4; ++j) { const int key = kt * 16 + quad * 4 + j; const bool ok = key >= kmin && key < kmax; if (ok) m = fmaxf(m, st[kt][qt][j]); }
            m = fmaxf(m, __shfl_xor(m, 16)); m = fmaxf(m, __shfl_xor(m, 32));
            m = fmaxf(m, sink);
            float sum = 0.f;
#pragma unroll
            for (int kt = 0; kt < NKT; ++kt)
#pragma unroll
                for (int j = 0; j < 4; ++j) { const int key = kt * 16 + quad * 4 + j; const bool ok = key >= kmin && key < kmax; const float e = ok ? __expf(st[kt][qt][j] - m) : 0.f; st[kt][qt][j] = e; sum += e; }
            sum += __shfl_xor(sum, 16); sum += __shfl_xor(sum, 32);
            inv[qt] = 1.f / (sum + __expf(sink - m));
        }
        f32x4 ot[4][NQT];
#pragma unroll
        for (int dt = 0; dt < 4; ++dt)
#pragma unroll
            for (int qt = 0; qt < NQT; ++qt) ot[dt][qt] = (f32x4){0.f, 0.f, 0.f, 0.f};
#pragma unroll
        for (int s = 0; s < NKT / 2; ++s) {
            bf16x8 pf[NQT];
#pragma unroll
            for (int qt = 0; qt < NQT; ++qt) { u32x4 w; w.x = pk2(st[2 * s][qt][0], st[2 * s][qt][1]); w.y = pk2(st[2 * s][qt][2], st[2 * s][qt][3]);
                w.z = pk2(st[2 * s + 1][qt][0], st[2 * s + 1][qt][1]); w.w = pk2(st[2 * s + 1][qt][2], st[2 * s + 1][qt][3]); pf[qt] = __builtin_bit_cast(bf16x8, w); }
#pragma unroll
            for (int dt = 0; dt < 4; ++dt) {
                const LAS bf16_t* vp = Vt + (dt * 16 + l15) * VT_LD + 32 * s + quad * 4;
                const u32x2 lo = *(const LAS u32x2*)vp, hi = *(const LAS u32x2*)(vp + 16);
                u32x4 w; w.x = lo.x; w.y = lo.y; w.z = hi.x; w.w = hi.y;
                const bf16x8 vfr = __builtin_bit_cast(bf16x8, w);
#pragma unroll
                for (int qt = 0; qt < NQT; ++qt) ot[dt][qt] = __builtin_amdgcn_mfma_f32_16x16x32_bf16(vfr, pf[qt], ot[dt][qt], 0, 0, 0);
            }
        }
#pragma unroll
        for (int qt = 0; qt < NQT; ++qt) {
            bf16_t* op = PA + qrow[qt] * LDA_ + hq * 64 + quad * 4;
#pragma unroll
            for (int dt = 0; dt < 4; ++dt) { u32x2 w; w.x = pk2(ot[dt][qt][0] * inv[qt], ot[dt][qt][1] * inv[qt]); w.y = pk2(ot[dt][qt][2] * inv[qt], ot[dt][qt][3] * inv[qt]); if (!dry) *(u32x2*)(op + dt * 16) = w; }
        }
    }
    __syncthreads();
}
__device__ __forceinline__ void ph_attn(const Params& p, int l, LAS unsigned char* lds, bool dry) {
    constexpr int NPI = NB * 64 * 4, NSI = DB * 4;
    for (int it = blockIdx.x; it < NPI + NSI; it += gridDim.x) {
        if (it < NPI) { const int kvh = it & 3, c = (it >> 2) & 63, b = it >> 8; attn_item<false>(p, l, lds, b, c, kvh, dry); }
        else { const int r = it - NPI; attn_item<true>(p, l, lds, r >> 2, 0, r & 3, dry); }
    }
}

__device__ __forceinline__ float hgrn_lb(const Params& p, int l, int idx) {
    if (l == 0) return 0.f;
    const float a = p.in[I_LBL][idx], b = p.in[I_LBL][1024 + idx]; const float m = fmaxf(a, b); const float ea = __expf(a - m), eb = __expf(b - m);
    const float p0 = ea / (ea + eb), p1 = eb / (ea + eb); return (p0 + p1) - p0;
}
template <int MODE>
__device__ __forceinline__ void hgrn_item(const Params& p, int l, LAS unsigned char* lds, long rowbase, int ntok, int h, const float* Sin, float* Sout, float* Dout, bool dry) {
    const int tid = tid_opaque(), wave = tid >> 6, lane = tid & 63, kgi = lane & 15, vs = lane >> 4, vcol = wave * 16 + vs * 4;
    bf16_t* PB = (bf16_t*)(p.ws + OFF_P);
    LAS float* Fs = (LAS float*)lds; LAS float* Kk = Fs + 4096; LAS float* Qs = Kk + 4096; LAS float* Vs = Qs + 4096; LAS float* Os = Vs + 4096;
    f32x2 Sa[8], Sb[8];
#pragma unroll
    for (int i = 0; i < 8; ++i) { f32x4 v = (f32x4){0.f, 0.f, 0.f, 0.f}; if (Sin) v = *(const f32x4*)(Sin + (size_t)(kgi * 8 + i) * 128 + vcol);
        Sa[i] = (f32x2){v[0], v[1]}; Sb[i] = (f32x2){v[2], v[3]}; }
    float Dp[8];
#pragma unroll
    for (int i = 0; i < 8; ++i) Dp[i] = 1.f;
    const int st = tid >> 4, k8 = (tid & 15) * 8;
    float lbv[8], gnv[8];
#pragma unroll
    for (int i = 0; i < 8; ++i) { lbv[i] = hgrn_lb(p, l, h * 128 + k8 + i); gnv[i] = p.in[I_HON][l * 128 + k8 + i]; }
    u32x4 r_hq = (u32x4){0u, 0u, 0u, 0u}, r_hf = r_hq, r_hi = r_hq, r_hg = r_hq;
    { const int nb0 = ntok < 32 ? ntok : 32;
      if (st < nb0) { const bf16_t* rp = PB + (rowbase + st) * LDB_ + h * 128 + k8; r_hf = *(const u32x4*)(rp + 1024); r_hi = *(const u32x4*)(rp + 2048); if (MODE == 1) r_hq = *(const u32x4*)rp; } }
    for (int t0 = 0; t0 < ntok; t0 += 32) {
        const int nb = (ntok - t0) < 32 ? (ntok - t0) : 32;
        if (st < nb) {
            float hf[8], hi[8]; unpack8(r_hf, hf); unpack8(r_hi, hi);
            float fv[8];
#pragma unroll
            for (int i = 0; i < 8; ++i) { const float sg = sigm(hf[i]); const float f = lbv[i] + (1.f - lbv[i]) * sg; fv[i] = fmaxf(f, 1e-26f); }
            *(LAS f32x4*)(Fs + st * 128 + k8) = (f32x4){fv[0], fv[1], fv[2], fv[3]}; *(LAS f32x4*)(Fs + st * 128 + k8 + 4) = (f32x4){fv[4], fv[5], fv[6], fv[7]};
            *(LAS f32x4*)(Vs + st * 128 + k8) = (f32x4){hi[0], hi[1], hi[2], hi[3]}; *(LAS f32x4*)(Vs + st * 128 + k8 + 4) = (f32x4){hi[4], hi[5], hi[6], hi[7]};
            if (MODE == 1) { float hq[8]; unpack8(r_hq, hq);
                *(LAS f32x4*)(Qs + st * 128 + k8) = (f32x4){siluf(hq[0]), siluf(hq[1]), siluf(hq[2]), siluf(hq[3])}; *(LAS f32x4*)(Qs + st * 128 + k8 + 4) = (f32x4){siluf(hq[4]), siluf(hq[5]), siluf(hq[6]), siluf(hq[7])}; }
        }
        __syncthreads();
        { const int t1 = t0 + 32; const int nb1 = (ntok - t1) < 32 ? (ntok - t1) : 32;
          if (t1 < ntok && st < nb1) { const bf16_t* rp = PB + (rowbase + t1 + st) * LDB_ + h * 128 + k8; r_hf = *(const u32x4*)(rp + 1024); r_hi = *(const u32x4*)(rp + 2048); if (MODE == 1) r_hq = *(const u32x4*)rp; }
          if (MODE == 1 && st < nb) r_hg = *(const u32x4*)(PB + (rowbase + t0 + st) * LDB_ + 3072 + h * 128 + k8); }
#pragma unroll 4
        for (int t = 0; t < nb; ++t) {
            const f32x4 f0 = *(const LAS f32x4*)(Fs + t * 128 + kgi * 8), f1 = *(const LAS f32x4*)(Fs + t * 128 + kgi * 8 + 4);
            const f32x4 v4 = *(const LAS f32x4*)(Vs + t * 128 + vcol);
            f32x4 q0 = (f32x4){0.f, 0.f, 0.f, 0.f}, q1 = q0;
            if (MODE == 1) { q0 = *(const LAS f32x4*)(Qs + t * 128 + kgi * 8); q1 = *(const LAS f32x4*)(Qs + t * 128 + kgi * 8 + 4); }
            f32x2 oa = (f32x2){0.f, 0.f}, ob = oa; const f32x2 va = (f32x2){v4[0], v4[1]}, vb = (f32x2){v4[2], v4[3]};
#pragma unroll
            for (int i = 0; i < 8; ++i) { const float fi = i < 4 ? f0[i & 3] : f1[i & 3], qi = i < 4 ? q0[i & 3] : q1[i & 3];
                if (MODE == 0) Dp[i] *= fi;
                const f32x2 f2 = (f32x2){fi, fi}, q2 = (f32x2){qi, qi};
                Sa[i] = va + f2 * (Sa[i] - va); Sb[i] = vb + f2 * (Sb[i] - vb);
                if (MODE == 1) { oa += Sa[i] * q2; ob += Sb[i] * q2; } }
            if (MODE == 1) {
                float o[4] = {oa[0], oa[1], ob[0], ob[1]};
#pragma unroll
                for (int j = 0; j < 4; ++j) { o[j] += row_ror<1>(o[j]); o[j] += row_ror<2>(o[j]); o[j] += row_ror<4>(o[j]); o[j] += row_ror<8>(o[j]); }
                if (kgi == 0) *(LAS f32x4*)(Os + t * 128 + vcol) = (f32x4){o[0], o[1], o[2], o[3]};
            }
        }
        __syncthreads();
        if (MODE == 1 && st < nb) {
            const f32x4 o0 = *(const LAS f32x4*)(Os + st * 128 + k8), o1 = *(const LAS f32x4*)(Os + st * 128 + k8 + 4);
            float ov[8] = {o0[0], o0[1], o0[2], o0[3], o1[0], o1[1], o1[2], o1[3]};
            float ss = 0.f;
#pragma unroll
            for (int i = 0; i < 8; ++i) ss += ov[i] * ov[i];
            ss += __shfl_xor(ss, 1); ss += __shfl_xor(ss, 2); ss += __shfl_xor(ss, 4); ss += __shfl_xor(ss, 8);
            const float rstd = rsqrtf(ss * (1.f / 128.f) + EPS);
            bf16_t* gp = PB + (rowbase + t0 + st) * LDB_ + 3072 + h * 128 + k8;
            float hg[8]; unpack8(r_hg, hg);
#pragma unroll
            for (int i = 0; i < 8; ++i) ov[i] = ov[i] * rstd * gnv[i] * siluf(hg[i]);
            if (!dry) *(u32x4*)gp = pack8(ov);
        }
    }
    if (Sout) {
#pragma unroll
        for (int i = 0; i < 8; ++i) *(f32x4*)(Sout + (size_t)(kgi * 8 + i) * 128 + vcol) = (f32x4){Sa[i][0], Sa[i][1], Sb[i][0], Sb[i][1]};
    }
    if (MODE == 0 && wave == 0 && vs == 0) {
#pragma unroll
        for (int i = 0; i < 8; ++i) Dout[kgi * 8 + i] = Dp[i];
    }
    __syncthreads();
}
__device__ __forceinline__ void hgrn1_item_mfma(const Params& p, int l, LAS unsigned char* lds, long rowbase, int h, float* Sout, float* Dout) {
    const int tid = tid_opaque(), wave = tid >> 6, lane = tid & 63, l15 = lane & 15, quad = lane >> 4;
    const bf16_t* PB = (const bf16_t*)(p.ws + OFF_P);
    LAS float* G = (LAS float*)lds; LAS float* KKs = G + 64 * 128;
    LAS bf16_t* KdT = (LAS bf16_t*)(lds + 65536); LAS bf16_t* Vt = (LAS bf16_t*)(lds + 65536 + 18432);
    LAS float* QS = (LAS float*)(lds + 65536 + 36864); LAS float* CAR = QS + 512; LAS bf16_t* Vs1 = (LAS bf16_t*)(lds + 106496);
    const int st = tid >> 3, kb = (tid & 7) * 16;
    const int sk = tid & 127, qr = tid >> 7;
    float lbv[16];
#pragma unroll
    for (int i = 0; i < 16; ++i) lbv[i] = hgrn_lb(p, l, h * 128 + kb + i);
    if (tid < 128) CAR[tid] = 0.f;
    f32x4 acc[8];
#pragma unroll
    for (int vt = 0; vt < 8; ++vt) acc[vt] = (f32x4){0.f, 0.f, 0.f, 0.f};
    __syncthreads();
    for (int c = SEGT / 64 - 1; c >= 0; --c) {
        {
            const bf16_t* rp = PB + (rowbase + c * 64 + st) * LDB_ + h * 128 + kb;
            float hf[16], hi[16];
            unpack8(*(const u32x4*)(rp + 1024), *(float(*)[8])&hf[0]); unpack8(*(const u32x4*)(rp + 1024 + 8), *(float(*)[8])&hf[8]);
            unpack8(*(const u32x4*)(rp + 2048), *(float(*)[8])&hi[0]); unpack8(*(const u32x4*)(rp + 2048 + 8), *(float(*)[8])&hi[8]);
#pragma unroll
            for (int i = 0; i < 16; ++i) { const float sg = sigm(hf[i]); const float f = fmaxf(lbv[i] + (1.f - lbv[i]) * sg, 1e-26f);
                G[st * 128 + kb + i] = __logf(f); KKs[st * 128 + kb + i] = 1.f - f; }
            *(LAS u32x4*)(Vs1 + st * 128 + kb) = pack8(*(float(*)[8])&hi[0]); *(LAS u32x4*)(Vs1 + st * 128 + kb + 8) = pack8(*(float(*)[8])&hi[8]);
        }
        __syncthreads();
        {
            float run = 0.f;
#pragma unroll
            for (int i = 15; i >= 0; --i) { const int t = qr * 16 + i; const float g = G[t * 128 + sk]; G[t * 128 + sk] = run; run += g; }
            QS[qr * 128 + sk] = run;
        }
        __syncthreads();
        {
            float add = CAR[sk];
#pragma unroll
            for (int q2 = 1; q2 < 4; ++q2) if (q2 > qr) add += QS[q2 * 128 + sk];
            float kd[16], vv[16];
#pragma unroll
            for (int i = 0; i < 16; ++i) { const int t = qr * 16 + i; const float e = G[t * 128 + sk] + add; kd[i] = KKs[t * 128 + sk] * __expf(e); vv[i] = bf2f(Vs1[t * 128 + sk]); }
            *(LAS u32x4*)(KdT + sk * 72 + qr * 16) = pack8(*(float(*)[8])&kd[0]); *(LAS u32x4*)(KdT + sk * 72 + qr * 16 + 8) = pack8(*(float(*)[8])&kd[8]);
            *(LAS u32x4*)(Vt + sk * 72 + qr * 16) = pack8(*(float(*)[8])&vv[0]); *(LAS u32x4*)(Vt + sk * 72 + qr * 16 + 8) = pack8(*(float(*)[8])&vv[8]);
        }
        __syncthreads();
        if (qr == 0) CAR[sk] += (QS[sk] + QS[128 + sk]) + (QS[256 + sk] + QS[384 + sk]);
#pragma unroll
        for (int s2 = 0; s2 < 2; ++s2) {
            const bf16x8 a = *(const LAS bf16x8*)(KdT + (wave * 16 + l15) * 72 + s2 * 32 + quad * 8);
#pragma unroll
            for (int vt = 0; vt < 8; ++vt) { const bf16x8 bfr = *(const LAS bf16x8*)(Vt + (vt * 16 + l15) * 72 + s2 * 32 + quad * 8);
                acc[vt] = __builtin_amdgcn_mfma_f32_16x16x32_bf16(a, bfr, acc[vt], 0, 0, 0); }
        }
        __syncthreads();
    }
#pragma unroll
    for (int vt = 0; vt < 8; ++vt)
#pragma unroll
        for (int r = 0; r < 4; ++r) Sout[(size_t)(wave * 16 + quad * 4 + r) * 128 + vt * 16 + l15] = acc[vt][r];
    if (tid < 128) Dout[tid] = __expf(CAR[tid]);
    __syncthreads();
}
__device__ __forceinline__ void ph_hgrn1(const Params& p, int l, LAS unsigned char* lds) {
    float* Sb = (float*)(p.ws + OFF_S); float* Db = (float*)(p.ws + OFF_D);
    constexpr int NI = NB * 8 * (NSEG - 1);
    for (int it = blockIdx.x; it < NI; it += gridDim.x) {
        const int seg = it % (NSEG - 1), bh = it / (NSEG - 1), b = bh >> 3, h = bh & 7;
        hgrn1_item_mfma(p, l, lds, (long)b * SEQ + seg * SEGT, h, Sb + ((size_t)bh * NSEG + seg + 1) * 16384, Db + ((size_t)bh * NSEG + seg) * 128);
    }
}
__device__ __forceinline__ void ph_hgrn2(const Params& p) {
    float* Sb = (float*)(p.ws + OFF_S); const float* Db = (const float*)(p.ws + OFF_D);
    const int nth = gridDim.x * 512;
    for (int e = blockIdx.x * 512 + tid_opaque(); e < NB * 8 * 16384; e += nth) {
        const int bh = e >> 14, kv = e & 16383, k = kv >> 7;
        float* base = Sb + (size_t)bh * NSEG * 16384 + kv; float carry = 0.f; base[0] = 0.f;
        for (int s = 1; s < NSEG; ++s) { const float d = Db[((size_t)bh * NSEG + (s - 1)) * 128 + k]; carry = d * carry + base[(size_t)s * 16384]; base[(size_t)s * 16384] = carry; }
    }
}
constexpr int H3_G = 0, H3_Q = 16384, H3_K = 32768, H3_QC = 49152, H3_KD = 57856, H3_VT = 78336, H3_S0 = 92672, H3_AT = 127488, H3_OS = 130048, H3_DS = 138240, H3_VS = 139264, H3_KC = 147456, H3_FL = 156160, H3_END = 156416;
template <bool SAMPLE>
__device__ __forceinline__ void hgrn3_item_mfma(const Params& p, int l, LAS unsigned char* lds, long rowbase, int h, const float* Sin, float* Sout, bool dry) {
    constexpr int NTOK = SAMPLE ? 16 : SEGT, NBLK = SAMPLE ? 1 : 2;
    const int tid = tid_opaque(), wave = tid >> 6, lane = tid & 63, l15 = lane & 15, quad = lane >> 4;
    bf16_t* PB = (bf16_t*)(p.ws + OFF_P);
    LAS float* G = (LAS float*)(lds + H3_G); LAS float* Qs = (LAS float*)(lds + H3_Q); LAS float* KKs = (LAS float*)(lds + H3_K);
    LAS bf16_t* QcS = (LAS bf16_t*)(lds + H3_QC); LAS bf16_t* KdTS = (LAS bf16_t*)(lds + H3_KD); LAS bf16_t* Vt = (LAS bf16_t*)(lds + H3_VT);
    LAS bf16_t* S0T = (LAS bf16_t*)(lds + H3_S0); LAS bf16_t* attS = (LAS bf16_t*)(lds + H3_AT);
    LAS float* Os = (LAS float*)(lds + H3_OS); LAS float* Ds = (LAS float*)(lds + H3_DS); LAS bf16_t* Vs2 = (LAS bf16_t*)(lds + H3_VS);
    LAS bf16_t* KcS = (LAS bf16_t*)(lds + H3_KC); LAS int* FLG = (LAS int*)(lds + H3_FL);
    for (int i = tid; i < (H3_S0 - H3_KD) / 16; i += 512) *(LAS u32x4*)(lds + H3_KD + i * 16) = (u32x4){0u, 0u, 0u, 0u};
    for (int i = tid; i < (H3_OS - H3_AT) / 16; i += 512) *(LAS u32x4*)(lds + H3_AT + i * 16) = (u32x4){0u, 0u, 0u, 0u};
    f32x4 acc[8];
#pragma unroll
    for (int vt = 0; vt < 8; ++vt) {
#pragma unroll
        for (int r = 0; r < 4; ++r) acc[vt][r] = Sin ? Sin[(size_t)(wave * 16 + quad * 4 + r) * 128 + vt * 16 + l15] : 0.f; }
    const int kc = tid & 15;
    int pt[5], pm[5];
#pragma unroll
    for (int pp = 0; pp < 5; ++pp) { const int pi = pp * 32 + (tid >> 4); int t = (int)((sqrtf(8.f * pi + 1.f) - 1.f) * 0.5f); if ((t + 1) * (t + 2) / 2 <= pi) ++t; if (t * (t + 1) / 2 > pi) --t;
        pt[pp] = pi < 136 ? t : -1; pm[pp] = pi - t * (t + 1) / 2; }
    const int st = tid >> 4, k8 = (tid & 15) * 8;
    float lbv[8];
#pragma unroll
    for (int i = 0; i < 8; ++i) lbv[i] = hgrn_lb(p, l, h * 128 + k8 + i);
    const int ptk = tid >> 5, pv4 = (tid & 31) * 4;
    const f32x4 gn4 = *(const f32x4*)(p.in[I_HON] + l * 128 + pv4);
    u32x4 r_hq = (u32x4){0u, 0u, 0u, 0u}, r_hf = r_hq, r_hi = r_hq; u32x2 r_hg[NBLK];
    if (st < NBLK * 16) { const bf16_t* rp = PB + (rowbase + st) * LDB_ + h * 128 + k8; r_hq = *(const u32x4*)rp; r_hf = *(const u32x4*)(rp + 1024); r_hi = *(const u32x4*)(rp + 2048); }
    __syncthreads();
    for (int c0 = 0; c0 < NTOK; c0 += 32) {
#pragma unroll
        for (int bq = 0; bq < NBLK; ++bq) r_hg[bq] = *(const u32x2*)(PB + (rowbase + c0 + bq * 16 + ptk) * LDB_ + 3072 + h * 128 + pv4);
        if (st < NBLK * 16) {
            float hq[8], hf[8], hi[8]; unpack8(r_hq, hq); unpack8(r_hf, hf); unpack8(r_hi, hi);
#pragma unroll
            for (int i = 0; i < 8; ++i) { const float sg = sigm(hf[i]); const float f = fmaxf(lbv[i] + (1.f - lbv[i]) * sg, 1e-26f);
                G[st * 128 + k8 + i] = __logf(f); KKs[st * 128 + k8 + i] = 1.f - f; Qs[st * 128 + k8 + i] = siluf(hq[i]); }
            *(LAS u32x4*)(Vs2 + st * 128 + k8) = r_hi;
        }
        if (tid < 2) FLG[tid] = 0;
        __syncthreads();
        if (c0 + 32 < NTOK && st < NBLK * 16) { const bf16_t* rp = PB + (rowbase + c0 + 32 + st) * LDB_ + h * 128 + k8; r_hq = *(const u32x4*)rp; r_hf = *(const u32x4*)(rp + 1024); r_hi = *(const u32x4*)(rp + 2048); }
        if (tid < 128 * NBLK) {
            const int k = tid & 127, blk = tid >> 7; float run = 0.f;
#pragma unroll
            for (int t = 0; t < 16; ++t) { const int o = (blk * 16 + t) * 128 + k; run += G[o]; G[o] = run; QcS[(blk * 16 + t) * 136 + k] = (bf16_t)f2bf(Qs[o] * __expf(run)); }
            Ds[blk * 128 + k] = __expf(run);
            if (run < -80.f) FLG[blk] = 1;
#pragma unroll
            for (int t = 0; t < 16; ++t) { const int o = (blk * 16 + t) * 128 + k; KcS[(blk * 16 + t) * 136 + k] = (bf16_t)f2bf(KKs[o] * __expf(fminf(-G[o], 85.f))); }
            float kd[16]; unsigned vw[8];
#pragma unroll
            for (int t = 0; t < 16; ++t) { const int o = (blk * 16 + t) * 128 + k; kd[t] = KKs[o] * __expf(run - G[o]); }
#pragma unroll
            for (int t = 0; t < 8; ++t) vw[t] = (unsigned)Vs2[(blk * 16 + 2 * t) * 128 + k] | ((unsigned)Vs2[(blk * 16 + 2 * t + 1) * 128 + k] << 16);
            *(LAS u32x4*)(KdTS + (blk * 128 + k) * 40) = pack8(*(float(*)[8])&kd[0]); *(LAS u32x4*)(KdTS + (blk * 128 + k) * 40 + 8) = pack8(*(float(*)[8])&kd[8]);
            *(LAS u32x4*)(Vt + k * 56 + blk * 16) = (u32x4){vw[0], vw[1], vw[2], vw[3]}; *(LAS u32x4*)(Vt + k * 56 + blk * 16 + 8) = (u32x4){vw[4], vw[5], vw[6], vw[7]};
        }
        __syncthreads();
#pragma unroll 1
        for (int blk = 0; blk < NBLK; ++blk) {
            const bool exact = FLG[blk] != 0;
            if (!exact) { if (wave == 0) { f32x4 C = (f32x4){0.f, 0.f, 0.f, 0.f};
#pragma unroll
                    for (int sl = 0; sl < 4; ++sl) { const bf16x8 a = *(const LAS bf16x8*)(QcS + (blk * 16 + l15) * 136 + sl * 32 + quad * 8); const bf16x8 bk = *(const LAS bf16x8*)(KcS + (blk * 16 + l15) * 136 + sl * 32 + quad * 8);
                        C = __builtin_amdgcn_mfma_f32_16x16x32_bf16(a, bk, C, 0, 0, 0); }
#pragma unroll
                    for (int r = 0; r < 4; ++r) { const int t = quad * 4 + r; attS[(blk * 16 + t) * 40 + l15] = (bf16_t)f2bf(l15 <= t ? C[r] : 0.f); } } }
            else
#pragma unroll
            for (int pp = 0; pp < 5; ++pp) if (pt[pp] >= 0) {
                const int ot = ((blk * 16 + pt[pp]) * 128 + kc * 8), om = ((blk * 16 + pm[pp]) * 128 + kc * 8);
                const f32x4 q0 = *(const LAS f32x4*)(Qs + ot), q1 = *(const LAS f32x4*)(Qs + ot + 4), k0 = *(const LAS f32x4*)(KKs + om), k1 = *(const LAS f32x4*)(KKs + om + 4);
                const f32x4 b0 = *(const LAS f32x4*)(G + ot), b1 = *(const LAS f32x4*)(G + ot + 4), c0v = *(const LAS f32x4*)(G + om), c1v = *(const LAS f32x4*)(G + om + 4);
                float sum = 0.f;
#pragma unroll
                for (int i = 0; i < 4; ++i) { sum += q0[i] * k0[i] * __expf(b0[i] - c0v[i]); sum += q1[i] * k1[i] * __expf(b1[i] - c1v[i]); }
                sum += row_ror<1>(sum); sum += row_ror<2>(sum); sum += row_ror<4>(sum); sum += row_ror<8>(sum);
                if (kc == 0) attS[(blk * 16 + pt[pp]) * 40 + pm[pp]] = (bf16_t)f2bf(sum);
            }
#pragma unroll
            for (int vt = 0; vt < 8; ++vt) { u32x2 w; w.x = pk2(acc[vt][0], acc[vt][1]); w.y = pk2(acc[vt][2], acc[vt][3]); *(LAS u32x2*)(S0T + (vt * 16 + l15) * 136 + wave * 16 + quad * 4) = w; }
            __syncthreads();
            {
                f32x4 C = (f32x4){0.f, 0.f, 0.f, 0.f};
#pragma unroll
                for (int sl = 0; sl < 4; ++sl) { const bf16x8 a = *(const LAS bf16x8*)(QcS + (blk * 16 + l15) * 136 + sl * 32 + quad * 8); const bf16x8 bq = *(const LAS bf16x8*)(S0T + (wave * 16 + l15) * 136 + sl * 32 + quad * 8);
                    C = __builtin_amdgcn_mfma_f32_16x16x32_bf16(a, bq, C, 0, 0, 0); }
                const bf16x8 a2 = *(const LAS bf16x8*)(attS + (blk * 16 + l15) * 40 + quad * 8); const bf16x8 b2 = *(const LAS bf16x8*)(Vt + (wave * 16 + l15) * 56 + blk * 16 + quad * 8);
                C = __builtin_amdgcn_mfma_f32_16x16x32_bf16(a2, b2, C, 0, 0, 0);
#pragma unroll
                for (int r = 0; r < 4; ++r) Os[(quad * 4 + r) * 128 + wave * 16 + l15] = C[r];
            }
            {
                const f32x4 d4 = *(const LAS f32x4*)(Ds + blk * 128 + wave * 16 + quad * 4);
                const bf16x8 a3 = *(const LAS bf16x8*)(KdTS + (blk * 128 + wave * 16 + l15) * 40 + quad * 8);
#pragma unroll
                for (int vt = 0; vt < 8; ++vt) { acc[vt] = acc[vt] * d4; const bf16x8 b3 = *(const LAS bf16x8*)(Vt + (vt * 16 + l15) * 56 + blk * 16 + quad * 8);
                    acc[vt] = __builtin_amdgcn_mfma_f32_16x16x32_bf16(a3, b3, acc[vt], 0, 0, 0); }
            }
            __syncthreads();
            {
                const f32x4 o4 = *(const LAS f32x4*)(Os + ptk * 128 + pv4);
                float ss = (o4[0] * o4[0] + o4[1] * o4[1]) + (o4[2] * o4[2] + o4[3] * o4[3]);
                ss += __shfl_xor(ss, 1); ss += __shfl_xor(ss, 2); ss += __shfl_xor(ss, 4); ss += __shfl_xor(ss, 8); ss += __shfl_xor(ss, 16);
                const float rstd = rsqrtf(ss * (1.f / 128.f) + EPS);
                bf16_t* gp = PB + (rowbase + c0 + blk * 16 + ptk) * LDB_ + 3072 + h * 128 + pv4;
                const u32x2 gw = NBLK == 1 ? r_hg[0] : (blk == 0 ? r_hg[0] : r_hg[NBLK - 1]);
                const float y0 = o4[0] * rstd * gn4[0] * siluf(bf2f(gw.x & 0xffffu)), y1 = o4[1] * rstd * gn4[1] * siluf(bf2f(gw.x >> 16)), y2 = o4[2] * rstd * gn4[2] * siluf(bf2f(gw.y & 0xffffu)), y3 = o4[3] * rstd * gn4[3] * siluf(bf2f(gw.y >> 16));
                u32x2 w; w.x = pk2(y0, y1); w.y = pk2(y2, y3);
                if (!dry) *(u32x2*)gp = w;
            }
        }
    }
    if (Sout) {
#pragma unroll
        for (int vt = 0; vt < 8; ++vt)
#pragma unroll
            for (int r = 0; r < 4; ++r) Sout[(size_t)(wave * 16 + quad * 4 + r) * 128 + vt * 16 + l15] = acc[vt][r];
    }
    __syncthreads();
}
__device__ __forceinline__ void ph_hgrn3(const Params& p, int l, LAS unsigned char* lds, bool dry) {
    float* Sb = (float*)(p.ws + OFF_S);
    constexpr int NPI = NB * 8 * NSEG, NSI = DB * 8;
    for (int it = blockIdx.x; it < NPI + NSI; it += gridDim.x) {
        if (it < NPI) { const int seg = it & (NSEG - 1), bh = it >> 4, b = bh >> 3, h = bh & 7;
            float* so = seg == NSEG - 1 ? p.out + O_NHP + (((size_t)l * NB + b) * 8 + h) * 16384 : nullptr;
            hgrn3_item_mfma<false>(p, l, lds, (long)b * SEQ + seg * SEGT, h, Sb + ((size_t)bh * NSEG + seg) * 16384, so, dry); }
        else { const int r = it - NPI, b = r >> 3, h = r & 7;
            hgrn3_item_mfma<true>(p, l, lds, (long)MP + b * DSQ, h, p.in[I_SH] + (((size_t)l * DB + b) * 8 + h) * 16384, p.out + O_NHS + (((size_t)l * DB + b) * 8 + h) * 16384, dry); }
    }
}

__device__ __forceinline__ void ph_conv(const Params& p, int l) {
    bf16_t* PC = (bf16_t*)(p.ws + OFF_P); bf16_t* XC = (bf16_t*)(p.ws + OFF_MG);
    const float* cw = p.in[I_CW] + (size_t)l * 4 * 1024; const float* cb = p.in[I_CB] + (size_t)l * 1024;
    const int nth = (gridDim.x * 512) & ~127;
    const int tid0 = blockIdx.x * 512 + tid_opaque(), c8 = (tid0 & 127) * 8;
    float wv[4][8], bv[8];
#pragma unroll
    for (int jj = 0; jj < 4; ++jj) { const f32x4 w0 = *(const f32x4*)(cw + jj * 1024 + c8), w1 = *(const f32x4*)(cw + jj * 1024 + c8 + 4);
#pragma unroll
        for (int i = 0; i < 4; ++i) { wv[jj][i] = w0[i]; wv[jj][4 + i] = w1[i]; } }
    { const f32x4 b0 = *(const f32x4*)(cb + c8), b1 = *(const f32x4*)(cb + c8 + 4);
#pragma unroll
      for (int i = 0; i < 4; ++i) { bv[i] = b0[i]; bv[4 + i] = b1[i]; } }
    if (tid0 < nth)
    for (int idx = tid0; idx < MT * 128; idx += nth) {
        const int row = idx >> 7;
        int t, bb;
        if (row < MP) { bb = row >> 12; t = row & 4095; } else { const int r = row - MP; bb = r >> 4; t = r & 15; }
        float acc[8];
#pragma unroll
        for (int i = 0; i < 8; ++i) acc[i] = bv[i];
        float xv[8];
#pragma unroll
        for (int jj = 0; jj < 4; ++jj) {
            const int ti = t - 3 + jj; bool have = true;
            if (ti >= 0) unpack8(*(const u32x4*)(PC + (size_t)(row - 3 + jj) * LDC_ + c8), xv);
            else if (row >= MP) { const float* sc = p.in[I_SC] + (((size_t)l * DB + bb) * 3 + (3 + ti)) * 1024 + c8; const f32x4 a0 = *(const f32x4*)sc, a1 = *(const f32x4*)(sc + 4);
#pragma unroll
                for (int i = 0; i < 4; ++i) { xv[i] = a0[i]; xv[4 + i] = a1[i]; } }
            else have = false;
            if (have) {
#pragma unroll
                for (int i = 0; i < 8; ++i) acc[i] += xv[i] * wv[jj][i]; }
        }
        *(u32x4*)(XC + (size_t)row * DM + c8) = pack8(acc);
        if (row < MP) { if (t >= SEQ - 3) { float* o = p.out + O_NCP + (((size_t)l * NB + bb) * 3 + (t - (SEQ - 3))) * 1024 + c8;
#pragma unroll
                for (int i = 0; i < 8; ++i) o[i] = xv[i]; } }
        else if (t >= DSQ - 3) { float* o = p.out + O_NCS + (((size_t)l * DB + bb) * 3 + (t - (DSQ - 3))) * 1024 + c8;
#pragma unroll
            for (int i = 0; i < 8; ++i) o[i] = xv[i]; }
    }
}
struct LruConst { float ba[4], bx[4], sp[4], w0[4], w1[4], w2[4], w3[4], cbv[4]; };
__device__ __forceinline__ void unpack4(u32x2 r, float (&o)[4]) { o[0] = bf2f(r.x & 0xffffu); o[1] = bf2f(r.x >> 16); o[2] = bf2f(r.y & 0xffffu); o[3] = bf2f(r.y >> 16); }
template <int SWEEP>
__device__ __forceinline__ void lru_scan_item(const Params& p, int l, LAS unsigned char* lds, int it, bool dry, const LruConst& K, int tid) {
    const int chl = tid & 63, sub = tid >> 6;
    bf16_t* PC = (bf16_t*)(p.ws + OFF_P);
    float* SUB = (float*)(p.ws + OFF_S); float* SEGB = SUB + (size_t)NB * 256 * 1024 * 2;
    const bool samp = it >= 512;
    int cg, seg = 0, b = 0, bb = 0; size_t row0;
    if (!samp) { cg = it & 3; seg = (it >> 2) & 31; b = it >> 7; row0 = (size_t)b * SEQ + seg * 128 + sub * 16; }
    else { const int r = it - 512; cg = r & 3; bb = (r >> 2) * 8 + sub; row0 = (size_t)MP + bb * DSQ; }
    const int ch = cg * 256 + chl * 4;
    float x1[4], x2[4], x3[4];
    if (SWEEP == 1) {
        if (!samp) { const int t0 = seg * 128 + sub * 16; const bf16_t* q = PC + row0 * LDC_ + ch;
            const u32x2 z = (u32x2){0u, 0u};
            unpack4(t0 >= 1 ? *(const u32x2*)(q - (size_t)LDC_) : z, x1); unpack4(t0 >= 2 ? *(const u32x2*)(q - (size_t)2 * LDC_) : z, x2); unpack4(t0 >= 3 ? *(const u32x2*)(q - (size_t)3 * LDC_) : z, x3); }
        else { const float* sc = p.in[I_SC] + ((size_t)l * DB + bb) * 3 * 1024 + ch; const f32x4 a1 = *(const f32x4*)(sc + 2048), a2 = *(const f32x4*)(sc + 1024), a3 = *(const f32x4*)sc;
#pragma unroll
            for (int i = 0; i < 4; ++i) { x1[i] = a1[i]; x2[i] = a2[i]; x3[i] = a3[i]; } }
    }
    float h[4] = {0.f, 0.f, 0.f, 0.f}, A[4] = {1.f, 1.f, 1.f, 1.f}, B[4] = {0.f, 0.f, 0.f, 0.f};
    if (SWEEP == 2) {
        if (!samp) {
            f32x4 su[8][2];
#pragma unroll
            for (int u = 0; u < 8; ++u) { su[u][0] = (f32x4){1.f, 0.f, 1.f, 0.f}; su[u][1] = su[u][0];
                if (u < sub) { const f32x4* q = (const f32x4*)(SUB + (((size_t)b * 256 + seg * 8 + u) * 1024 + ch) * 2); su[u][0] = q[0]; su[u][1] = q[1]; } }
#pragma unroll 1
            for (int hf = 0; hf * 4 < seg; ++hf) { f32x4 sg[4][2];
#pragma unroll
                for (int i = 0; i < 4; ++i) { const int sgi = hf * 4 + i; sg[i][0] = (f32x4){1.f, 0.f, 1.f, 0.f}; sg[i][1] = sg[i][0];
                    if (sgi < seg) { const f32x4* q = (const f32x4*)(SEGB + (((size_t)b * 32 + sgi) * 1024 + ch) * 2); sg[i][0] = q[0]; sg[i][1] = q[1]; } }
#pragma unroll
                for (int i = 0; i < 4; ++i) { h[0] = sg[i][0][0] * h[0] + sg[i][0][1]; h[1] = sg[i][0][2] * h[1] + sg[i][0][3]; h[2] = sg[i][1][0] * h[2] + sg[i][1][1]; h[3] = sg[i][1][2] * h[3] + sg[i][1][3]; } }
#pragma unroll
            for (int u = 0; u < 8; ++u) { h[0] = su[u][0][0] * h[0] + su[u][0][1]; h[1] = su[u][0][2] * h[1] + su[u][0][3]; h[2] = su[u][1][0] * h[2] + su[u][1][1]; h[3] = su[u][1][2] * h[3] + su[u][1][3]; }
        } else { const f32x4 h0 = *(const f32x4*)(p.in[I_SL] + ((size_t)l * DB + bb) * 1024 + ch);
#pragma unroll
            for (int i = 0; i < 4; ++i) h[i] = h0[i]; }
    }
    if (SWEEP == 1) {
#pragma unroll 8
        for (int t = 0; t < 16; ++t) {
            bf16_t* q = PC + (row0 + t) * LDC_ + ch;
            float x0[4], rp[4], ip[4]; unpack4(*(const u32x2*)q, x0); unpack4(*(const u32x2*)(q + 3072), rp); unpack4(*(const u32x2*)(q + 4096), ip);
            unsigned oa[4], ob[4];
#pragma unroll
            for (int i = 0; i < 4; ++i) {
                const float xc = K.cbv[i] + K.w3[i] * x0[i] + K.w2[i] * x1[i] + K.w1[i] * x2[i] + K.w0[i] * x3[i];
                x3[i] = x2[i]; x2[i] = x1[i]; x1[i] = x0[i];
                const float r = sigm(rp[i] + K.ba[i]), ig = sigm(ip[i] + K.bx[i]);
                const float la = -8.f * r * K.sp[i], a = __expf(la), x = 2.f * la;
                const float ser = -x * (1.f + x * (0.5f + x * (0.16666667f + x * (0.041666668f + x * 0.008333334f))));
                const float om = x > -0.3f ? ser : 1.f - a * a;
                const float bc = sqrtf(om) * (ig * xc);
                const float lser = -la * (1.f + la * (0.5f + la * (0.16666667f + la * (0.041666668f + la * 0.008333334f))));
                oa[i] = f2bf(la > -0.3f ? lser : 1.f - a); ob[i] = f2bf(bc);
                const float ar = 1.f - bf2f(oa[i]), br = bf2f(ob[i]);
                A[i] *= ar; B[i] = ar * B[i] + br;
            }
            u32x2 wa; wa.x = oa[0] | (oa[1] << 16); wa.y = oa[2] | (oa[3] << 16); u32x2 wb; wb.x = ob[0] | (ob[1] << 16); wb.y = ob[2] | (ob[3] << 16);
            *(u32x2*)(q + 3072) = wa; *(u32x2*)(q + 4096) = wb;
        }
    } else {
#pragma unroll 8
        for (int t = 0; t < 16; ++t) {
            bf16_t* q = PC + (row0 + t) * LDC_ + ch;
            float oa[4], ob[4], lg[4]; unpack4(*(const u32x2*)(q + 3072), oa); unpack4(*(const u32x2*)(q + 4096), ob); unpack4(*(const u32x2*)(q + 1024), lg);
            float yv[4];
#pragma unroll
            for (int i = 0; i < 4; ++i) { h[i] = (1.f - oa[i]) * h[i] + ob[i]; yv[i] = h[i] * gelu_tanh(lg[i]); }
            u32x2 w; w.x = pk2(yv[0], yv[1]); w.y = pk2(yv[2], yv[3]);
            if (!dry) *(u32x2*)(q + 1024) = w;
        }
    }
    if (SWEEP == 1 && !samp) {
        f32x4* qs = (f32x4*)(SUB + (((size_t)b * 256 + seg * 8 + sub) * 1024 + ch) * 2);
        qs[0] = (f32x4){A[0], B[0], A[1], B[1]}; qs[1] = (f32x4){A[2], B[2], A[3], B[3]};
        LAS f32x4* ex = (LAS f32x4*)lds;
        ex[(sub * 64 + chl) * 2] = (f32x4){A[0], B[0], A[1], B[1]}; ex[(sub * 64 + chl) * 2 + 1] = (f32x4){A[2], B[2], A[3], B[3]};
        __syncthreads();
        if (sub == 0) { float a[4] = {1.f, 1.f, 1.f, 1.f}, bs[4] = {0.f, 0.f, 0.f, 0.f};
#pragma unroll
            for (int u = 0; u < 8; ++u) { const f32x4 e0 = ex[(u * 64 + chl) * 2], e1 = ex[(u * 64 + chl) * 2 + 1];
                a[0] *= e0[0]; bs[0] = e0[0] * bs[0] + e0[1]; a[1] *= e0[2]; bs[1] = e0[2] * bs[1] + e0[3]; a[2] *= e1[0]; bs[2] = e1[0] * bs[2] + e1[1]; a[3] *= e1[2]; bs[3] = e1[2] * bs[3] + e1[3]; }
            f32x4* qg = (f32x4*)(SEGB + (((size_t)b * 32 + seg) * 1024 + ch) * 2);
            qg[0] = (f32x4){a[0], bs[0], a[1], bs[1]}; qg[1] = (f32x4){a[2], bs[2], a[3], bs[3]}; }
        __syncthreads();
    } else if (SWEEP == 2) {
        if (!samp) { if (seg == 31 && sub == 7) *(f32x4*)(p.out + O_NLP + ((size_t)l * NB + b) * 1024 + ch) = (f32x4){h[0], h[1], h[2], h[3]}; }
        else *(f32x4*)(p.out + O_NLS + ((size_t)l * DB + bb) * 1024 + ch) = (f32x4){h[0], h[1], h[2], h[3]};
    }
}
template <int SWEEP>
__device__ __forceinline__ void ph_lru_scan(const Params& p, int l, LAS unsigned char* lds, bool dry) {
    constexpr int NI = 512 + 16;
    const int tid = tid_opaque(), ch = (blockIdx.x & 3) * 256 + (tid & 63) * 4;
    LruConst K;
#pragma unroll
    for (int i = 0; i < 4; ++i) { K.ba[i] = p.in[I_LBA][l * 1024 + ch + i]; K.bx[i] = p.in[I_LBX][l * 1024 + ch + i]; K.sp[i] = log1pf(expf(-p.in[I_LAM][l * 1024 + ch + i]));
        const float* cw = p.in[I_CW] + (size_t)l * 4 * 1024 + ch + i; K.w0[i] = cw[0]; K.w1[i] = cw[1024]; K.w2[i] = cw[2048]; K.w3[i] = cw[3072]; K.cbv[i] = p.in[I_CB][l * 1024 + ch + i]; }
    const int G4 = (int)gridDim.x & ~3;
    if ((int)blockIdx.x < G4) for (int it = blockIdx.x; it < NI; it += G4) lru_scan_item<SWEEP>(p, l, lds, it, dry, K, tid);
}

#define XB_TMO      128
#define XB_XCNT(j)  (256  + 64 * (j))
#define XB_XSUB(j)  (1280 + 64 * (j))
#define XB_XGEN(j)  (2304 + 64 * (j))
#define XB_TOP      3328
#define XB_TOPGEN   3392
#define XCD_BAR_WORDS 3456
#define XB_SPIN_CAP (1u << 18)
__device__ __forceinline__ unsigned xb_ld(unsigned* p)              { return __hip_atomic_load(p, __ATOMIC_RELAXED, __HIP_MEMORY_SCOPE_AGENT); }
__device__ __forceinline__ unsigned xb_add(unsigned* p, unsigned v) { return __hip_atomic_fetch_add(p, v, __ATOMIC_RELAXED, __HIP_MEMORY_SCOPE_AGENT); }
__device__ __forceinline__ unsigned xb_xcc_id() { return (unsigned)__builtin_amdgcn_s_getreg((3 << 11) | 20) & 0xFu; }
#define XB_SPIN(cond, bar) do { unsigned _sp = 0; while (cond) { __builtin_amdgcn_s_sleep(1); \
    if ((++_sp & 255u) == 0u) { if (xb_ld(&(bar)[XB_TMO])) break; if (_sp > XB_SPIN_CAP) { atomicAdd(&(bar)[XB_TMO], 1u); break; } } } } while (0)
struct XcdBarrier { unsigned* bar; unsigned x; volatile LAS unsigned* st; };
__device__ __forceinline__ XcdBarrier xcd_barrier_post(unsigned* bar, volatile LAS unsigned* st) {
    XcdBarrier b; b.bar = bar; b.x = xb_xcc_id(); b.st = st;
    if (threadIdx.x == 0) (void)xb_add(&bar[XB_XCNT(b.x)], 1u);
    return b;
}
__device__ __forceinline__ void xcd_barrier_complete(unsigned* bar, unsigned x, unsigned& nloc, unsigned& nx) {
    const unsigned G = gridDim.x * gridDim.y * gridDim.z;
    unsigned sum, cnt, mine, sp = 0u;
    for (;;) {
        sum = 0u; cnt = 0u; mine = 0u;
#pragma unroll
        for (unsigned j = 0; j < 16; ++j) { const unsigned c = xb_ld(&bar[XB_XCNT(j)]); sum += c; cnt += (c > 0u) ? 1u : 0u; mine = (j == x) ? c : mine; }
        if (sum == G) break;
        __builtin_amdgcn_s_sleep(1);
        if ((++sp & 255u) == 0u) { if (xb_ld(&bar[XB_TMO])) break; if (sp > XB_SPIN_CAP) { atomicAdd(&bar[XB_TMO], 1u); break; } }
    }
    nloc = mine > 0u ? mine : 1u; nx = cnt > 0u ? cnt : 1u;
}
__device__ __forceinline__ void xcd_barrier(const XcdBarrier& b) {
    asm volatile("s_waitcnt vmcnt(0)" ::: "memory");
    __syncthreads();
    if (threadIdx.x == 0) {
        unsigned* bar = b.bar;
        __builtin_amdgcn_s_waitcnt(0);
        unsigned nloc = b.st[0], nx = b.st[1];
        if (nloc == 0u) { xcd_barrier_complete(bar, b.x, nloc, nx); b.st[0] = nloc; b.st[1] = nx; }
        const unsigned old = xb_add(&bar[XB_XSUB(b.x)], 1u);
        const unsigned gen = old / nloc;
        if (old + 1u == (gen + 1u) * nloc) {
            __builtin_amdgcn_fence(__ATOMIC_RELEASE, "agent");
            asm volatile("s_waitcnt vmcnt(0)" ::: "memory");
            const unsigned og = xb_add(&bar[XB_TOP], 1u);
            const unsigned tg = og / nx;
            if (og + 1u == (tg + 1u) * nx) xb_add(&bar[XB_TOPGEN], 1u);
            else XB_SPIN(xb_ld(&bar[XB_TOPGEN]) == tg, bar);
            __builtin_amdgcn_fence(__ATOMIC_ACQUIRE, "agent");
            xb_add(&bar[XB_XGEN(b.x)], 1u);
            asm volatile("s_waitcnt vmcnt(0)" ::: "memory");
        } else {
            XB_SPIN(xb_ld(&bar[XB_XGEN(b.x)]) == gen, bar);
            __builtin_amdgcn_fence(__ATOMIC_ACQUIRE, "agent");
            asm volatile("s_waitcnt vmcnt(0)" ::: "memory");
        }
    }
    __syncthreads();
}

constexpr int NPL = 22, NPH = DEPTH * NPL + 1;
template <int K>
__device__ __forceinline__ void run_phase(const Params& p, int l, LAS unsigned char* lds, bool dry) {
    bf16_t* Wb = (bf16_t*)(p.ws + OFF_W); bf16_t* H = (bf16_t*)(p.ws + OFF_H); bf16_t* MG = (bf16_t*)(p.ws + OFF_MG); bf16_t* P = (bf16_t*)(p.ws + OFF_P);
    float* X = p.out;
    if constexpr (K == 0) { ph_convert(p, l, lds); ph_norm<11>(p, p.in[I_NF1] + l * DM, l == 0); }
    else if constexpr (K == 1) { EpiSwiGLU e; e.G = P; run_gemm(lds, H, DM, Wb + W_UP1, 2 * DFF, DM, e); }
    else if constexpr (K == 2) run_gemm_resid(lds, P, DFF, Wb + W_DN1, DFF, X, 0.5f, (float*)(p.ws + OFF_S));
    else if constexpr (K == 3) ph_norm<11>(p, p.in[I_NMIX] + l * DM, false);
    else if constexpr (K == 4) { EpiStore e; e.O = P; e.ldc = LDC_; run_gemm(lds, H, DM, Wb + W_IN + (size_t)2560 * 1024, 3072, DM, e); }
    else if constexpr (K == 5) ph_conv(p, l);
    else if constexpr (K == 6) { EpiStoreLru e; e.O = P; e.ldc = LDC_; run_gemm_lru(lds, MG, Wb + W_LRU, e); }
    else if constexpr (K == 7) ph_lru_scan<1>(p, l, lds, false);
    else if constexpr (K == 8) ph_lru_scan<2>(p, l, lds, dry);
    else if constexpr (K == 9) { EpiGate e; e.MG = MG; e.gate = P + 2048; e.ldg = LDC_; e.accum = 0; run_gemm(lds, P + 1024, LDC_, Wb + W_LO, DM, DM, e); }
    else if constexpr (K == 10) { EpiStore e; e.O = P; e.ldc = LDA_; run_gemm(lds, H, DM, Wb + W_IN, 2560, DM, e); }
    else if constexpr (K == 11) ph_attn(p, l, lds, dry);
    else if constexpr (K == 12) { EpiGate e; e.MG = MG; e.gate = P + 1536; e.ldg = LDA_; e.accum = 1; run_gemm(lds, P, LDA_, Wb + W_AO, DM, DM, e); }
    else if constexpr (K == 13) { EpiStore e; e.O = P; e.ldc = LDB_; run_gemm(lds, H, DM, Wb + W_IN + (size_t)5632 * 1024, 5120, DM, e, MP); }
    else if constexpr (K == 14) {
        if ((int)gridDim.x >= 64) { pg8::TailOrder S; S.c = (int)blockIdx.x - ((int)gridDim.x - 40);
            if (S.c >= 0) { EpiStore e; e.O = P; e.ldc = LDB_; pg8::Gemm g; g.A = H; g.Bt = Wb + W_IN + (size_t)5632 * 1024; g.M = MT; g.N = 5120; g.K = DM; g.lda = DM; g.ldb = DM;
                pg8::gemm_phase<EpiStore, pg8::TailOrder>(lds, g, S, e); } }
        else { EpiStore e; e.O = P; e.ldc = LDB_; pg8::Gemm g; g.A = H + (size_t)MP * DM; g.Bt = Wb + W_IN + (size_t)5632 * 1024; g.M = MS; g.N = 5120; g.K = DM; g.lda = DM; g.ldb = DM;
            EpiStore e2 = e; e2.O = P + (size_t)MP * LDB_; pg8::StaticOrder S; S.init(MS, 5120, (int)gridDim.x, (int)blockIdx.x); pg8::gemm_phase<EpiStore, pg8::StaticOrder>(lds, g, S, e2); }
        ph_hgrn1(p, l, lds); }
    else if constexpr (K == 15) ph_hgrn2(p);
    else if constexpr (K == 16) ph_hgrn3(p, l, lds, dry);
    else if constexpr (K == 17) { EpiGate e; e.MG = MG; e.gate = P + 4096; e.ldg = LDB_; e.accum = 1; run_gemm(lds, P + 3072, LDB_, Wb + W_HO, DM, DM, e); }
    else if constexpr (K == 18) run_gemm_resid(lds, MG, DM, Wb + W_OUT, DM, X, 1.f, (float*)(p.ws + OFF_S));
    else if constexpr (K == 19) ph_norm<4>(p, p.in[I_NF2] + l * DM, false);
    else if constexpr (K == 20) { EpiSwiGLU e; e.G = P; run_gemm(lds, H, DM, Wb + W_UP2, 2 * DFF, DM, e); }
    else if constexpr (K == 21) run_gemm_resid(lds, P, DFF, Wb + W_DN2, DFF, X, 0.5f, (float*)(p.ws + OFF_S));
    else {
        const float* part = (const float*)(p.ws + OFF_S);
        for (int i = blockIdx.x * 512 + tid_opaque(); i < MS * DM / 4; i += gridDim.x * 512) { f32x4 v = ((f32x4*)(X + (size_t)MP * DM))[i];
#pragma unroll
            for (int c = 0; c < 11; ++c) v += ((const f32x4*)(part + (size_t)c * MS * DM))[i];
            ((f32x4*)(X + (size_t)MP * DM))[i] = v; }
    }
}

__global__ void __launch_bounds__(512, 2) mega(Params p, int ph_lo, int ph_hi) {
    extern __shared__ __attribute__((aligned(16))) unsigned char shm[];
    LAS unsigned char* lds = (LAS unsigned char*)shm;
    cg::grid_group grid = cg::this_grid();
    volatile LAS unsigned* st = (volatile LAS unsigned*)(lds + LDS_MAIN);
    if (threadIdx.x < 4) st[threadIdx.x] = 0u;
    __syncthreads();
    const XcdBarrier xb = xcd_barrier_post(p.bar, st);
    if (ph_hi < 0) grid.sync();
#define SEAM(ph) { xcd_barrier(xb); }
#define PHASE(L, K) { constexpr int ph = (L) * NPL + (K); if (ph >= ph_lo && ph < ph_hi) { if constexpr ((DUP_MASK >> (K)) & 1) { run_phase<K>(p, L, lds, p.one != 0); SEAM(1) } run_phase<K>(p, L, lds, false); if (ph + 1 < ph_hi) SEAM(ph) } }
#define LAYER(L) PHASE(L, 0) PHASE(L, 1) PHASE(L, 2) PHASE(L, 3) PHASE(L, 4) PHASE(L, 5) PHASE(L, 6) PHASE(L, 7) PHASE(L, 8) PHASE(L, 9) \
    PHASE(L, 10) PHASE(L, 11) PHASE(L, 12) PHASE(L, 13) PHASE(L, 14) PHASE(L, 15) PHASE(L, 16) PHASE(L, 17) PHASE(L, 18) PHASE(L, 19) PHASE(L, 20) PHASE(L, 21)
    LAYER(0)
    LAYER(1)
    PHASE(1, 22)
#undef LAYER
#undef PHASE
}

extern "C" void kernel_launch(void* const* d_in, const int* in_sizes, int n_in, void* d_out, int out_size, void* d_ws, size_t ws_size, hipStream_t stream) {
    static int grid = 0;
    if (grid == 0) {
        if (n_in != 31 || ws_size < WS_NEED) { fprintf(stderr, "kernel_launch: unexpected n_in %d or ws %zu < %zu\n", n_in, ws_size, (size_t)WS_END); grid = -1; return; }
        int dev = 0, cus = 0, per_cu = 0;
        (void)hipGetDevice(&dev); (void)hipDeviceGetAttribute(&cus, hipDeviceAttributeMultiprocessorCount, dev);
        if (hipFuncSetAttribute((const void*)mega, hipFuncAttributeMaxDynamicSharedMemorySize, LDS_BYTES) != hipSuccess) { fprintf(stderr, "hipFuncSetAttribute failed\n"); grid = -1; return; }
        if (hipOccupancyMaxActiveBlocksPerMultiprocessor(&per_cu, (const void*)mega, 512, LDS_BYTES) != hipSuccess || per_cu < 1) { fprintf(stderr, "occupancy query: %d\n", per_cu); per_cu = 1; }
        (void)hipGetLastError();
        grid = cus * 1;
    }
    if (grid < 0) return;
    Params p{};
    for (int i = 0; i < 31; ++i) p.in[i] = (const float*)d_in[i];
    p.out = (float*)d_out; p.ws = (unsigned char*)d_ws; p.one = 1; p.bar = (unsigned*)((unsigned char*)d_ws + OFF_BAR);
    (void)hipMemsetAsync((unsigned char*)d_ws + OFF_BAR, 0, 3456 * 4, stream);
#if ONE_LAUNCH
    int lo = 0, hi = NPH;
    void* args[] = {&p, &lo, &hi};
    hipError_t e = hipLaunchCooperativeKernel((const void*)mega, dim3(grid), dim3(512), args, LDS_BYTES, stream);
    if (e != hipSuccess) fprintf(stderr, "cooperative launch failed: %s (grid %d)\n", hipGetErrorString(e), grid);
#else
    for (int ph = 0; ph < NPH; ++ph) mega<<<dim3(grid), dim3(512), LDS_BYTES, stream>>>(p, ph, ph + 1);
#endif
}
```

```cpp
#include <hip/hip_runtime.h>
#include <hip/hip_cooperative_groups.h>
#include <cstdio>
#include <cstdint>
namespace cg = cooperative_groups;

#ifndef ONE_LAUNCH
#define ONE_LAUNCH 1
#endif

#ifndef DUP_MASK
#define DUP_MASK 0
#endif
#define LAS __attribute__((address_space(3)))
typedef unsigned short bf16_t;
typedef short bf16x8 __attribute__((ext_vector_type(8)));
typedef short bf16x4 __attribute__((ext_vector_type(4)));
typedef float f32x4 __attribute__((ext_vector_type(4)));
typedef unsigned u32x4 __attribute__((ext_vector_type(4)));
typedef unsigned u32x2 __attribute__((ext_vector_type(2)));

constexpr int DM = 1024, NB = 4, SEQ = 4096, DEPTH = 2, DB = 32, DSQ = 16, DFF = 2816;
constexpr int MP = NB * SEQ, MS = DB * DSQ, MT = MP + MS;
constexpr int INC = 10752;
constexpr int LDA_ = 2560, LDC_ = 5120, LDB_ = 5120;
constexpr float EPS = 1e-6f;
constexpr int NSEG = 16, SEGT = 256;

constexpr size_t W_UP1 = 0, W_DN1 = W_UP1 + (size_t)5632 * 1024, W_IN = W_DN1 + (size_t)1024 * 2816, W_AO = W_IN + (size_t)INC * 1024,
                 W_HO = W_AO + 1048576, W_LO = W_HO + 1048576, W_OUT = W_LO + 1048576, W_UP2 = W_OUT + 1048576, W_DN2 = W_UP2 + (size_t)5632 * 1024,
                 W_LRU = W_DN2 + (size_t)1024 * 2816, W_END = W_LRU + (size_t)2048 * 256;
constexpr size_t OFF_W = 0, OFF_H = OFF_W + W_END * 2, OFF_MG = OFF_H + (size_t)MT * 1024 * 2, OFF_P = OFF_MG + (size_t)MT * 1024 * 2,
                 OFF_S = OFF_P + (size_t)MT * 5120 * 2, OFF_D = OFF_S + (size_t)NB * 8 * NSEG * 16384 * 4, WS_END = OFF_D + (size_t)NB * 8 * NSEG * 128 * 4;
constexpr size_t O_NKP = 17301504, O_NVP = 17563648, O_NHP = 17825792, O_NCP = 18874368, O_NLP = 18898944, O_NKS = 18907136, O_NVS = 19169280,
                 O_NHS = 19431424, O_NCS = 27820032, O_NLS = 28016640;

constexpr int LDS_MAIN = 156416, LDS_BYTES = LDS_MAIN + 16;
constexpr size_t OFF_BAR = (WS_END + 255) / 256 * 256, WS_NEED = OFF_BAR + 3456 * 4;

struct Params { const float* in[31]; float* out; unsigned char* ws; unsigned* bar; long one; };
enum { I_XP = 0, I_XS, I_CK, I_CV, I_SH, I_SC, I_SL, I_NF1, I_UP1, I_DN1, I_NMIX, I_WIN, I_QN, I_KN, I_SINK, I_WAO, I_LBL, I_HON, I_WHO, I_CW, I_CB,
       I_LWA, I_LBA, I_LWX, I_LBX, I_LAM, I_WLO, I_WOUT, I_NF2, I_UP2, I_DN2 };

__device__ __forceinline__ float bf2f(unsigned v) { return __uint_as_float(v << 16); }
__device__ __forceinline__ unsigned f2bf(float f) { unsigned u = __float_as_uint(f); u += 0x7FFFu + ((u >> 16) & 1u); return u >> 16; }
__device__ __forceinline__ unsigned pk2(float lo, float hi) { return f2bf(lo) | (f2bf(hi) << 16); }
__device__ __forceinline__ float sigm(float x) { return 1.f / (1.f + __expf(-x)); }
__device__ __forceinline__ float siluf(float x) { return x / (1.f + __expf(-x)); }
__device__ __forceinline__ float gelu_tanh(float x) { const float u = 0.7978845608028654f * (x + 0.044715f * x * x * x); const float e = __expf(2.f * u); const float th = 1.f - 2.f / (e + 1.f); return 0.5f * x * (1.f + th); }
__device__ __forceinline__ void unpack8(u32x4 r, float (&o)[8]) {
    o[0] = bf2f(r.x & 0xffffu); o[1] = bf2f(r.x >> 16); o[2] = bf2f(r.y & 0xffffu); o[3] = bf2f(r.y >> 16);
    o[4] = bf2f(r.z & 0xffffu); o[5] = bf2f(r.z >> 16); o[6] = bf2f(r.w & 0xffffu); o[7] = bf2f(r.w >> 16);
}
__device__ __forceinline__ u32x4 pack8(const float (&v)[8]) { u32x4 r; r.x = pk2(v[0], v[1]); r.y = pk2(v[2], v[3]); r.z = pk2(v[4], v[5]); r.w = pk2(v[6], v[7]); return r; }
__device__ __forceinline__ int tid_opaque() { int t = (int)__builtin_amdgcn_workitem_id_x(); asm volatile("" : "+v"(t)); return t; }
typedef float f32x2 __attribute__((ext_vector_type(2)));
template <int N> __device__ __forceinline__ float row_ror(float x) { return __builtin_bit_cast(float, __builtin_amdgcn_update_dpp(0, __builtin_bit_cast(int, x), 0x120 + N, 0xf, 0xf, false)); }
#define LDS_WAIT() asm volatile("s_waitcnt lgkmcnt(0)" ::: "memory")

namespace pg8 {
constexpr int BM = 256, BK = 64, HALF = 128, HTB = HALF * BK * 2, STAGE_BYTES = 8 * HTB, NXCD = 8, WGM = 8;
__device__ __forceinline__ int lds_byte(int r, int c) { const int st = (r >> 4) * 2 + (c >> 5), rr = r & 15, cc = c & 31, ob = rr * 64 + cc * 2; return st * 1024 + (ob ^ (((ob >> 9) & 1) << 5)); }
__device__ __forceinline__ void stage_rc(int b, int& R, int& C) { const int st = b / 1024, sb = b % 1024, swz = sb ^ (((sb >> 9) & 1) << 5); R = (st >> 1) * 16 + swz / 64; C = (st & 1) * 32 + (swz % 64) / 2; }
struct Unit { int pm, pn, aoff, boff; };
struct Gemm { const bf16_t* A; const bf16_t* Bt; int M, N, K, lda, ldb; };
struct StaticOrder {
    int nM, nN, nwg, G, c;
    __device__ void init(int M, int N, int G_, int c_) { nM = M / BM; nN = N / BM; nwg = nM * nN; G = G_; c = c_; }
    __device__ bool next(int i, Unit& u) const {
        const long L = (long)i * G + c; if (L >= nwg) return false;
        int wgid = (int)L; { const int q = nwg / NXCD, r = nwg % NXCD, xcd = wgid % NXCD, off = wgid / NXCD; wgid = (xcd < r ? xcd * (q + 1) : r * (q + 1) + (xcd - r) * q) + off; }
        const int nig = WGM * nN, gid = wgid / nig, fm = gid * WGM, gsz = (nM - fm) < WGM ? (nM - fm) : WGM;
        u.pm = fm + ((wgid % nig) % gsz); u.pn = (wgid % nig) / gsz; u.aoff = 0; u.boff = 0; return true;
    }
};
struct LruOrder : StaticOrder {
    __device__ bool next(int i, Unit& u) const { if (!StaticOrder::next(i, u)) return false; u.aoff = (u.pn >> 1) * 512; return true; }
};
struct SplitOrder {
    int nchunk, total, c;
    __device__ void init(int nunits, int nchunk_, int c_) { nchunk = nchunk_; total = nunits * nchunk_; c = c_; }
    __device__ bool next(int i, Unit& u) const { if (i != 0 || c >= total) return false; const int unit = c / nchunk, ch = c % nchunk; u.pm = unit >> 2; u.pn = unit & 3; u.aoff = ch * 512; u.boff = ch * 512; return true; }
};
struct TailOrder {
    int c;
    __device__ bool next(int i, Unit& u) const { if (c < 0 || i > 0 || c >= 40) return false; u.pm = 64 + c / 20; u.pn = c % 20; u.aoff = 0; u.boff = 0; return true; }
};
template <class Epi, class Sched>
__device__ __forceinline__ void gemm_phase(LAS unsigned char* lds, const Gemm g, const Sched& S, const Epi& E) {
    const int tid = tid_opaque(), wid = __builtin_amdgcn_readfirstlane(tid >> 6), lane = tid & 63, wr = wid >> 2, wc = wid & 3, fr = lane & 15, fq = lane >> 4;
    const int K = g.K, nt = K / BK, lda = g.lda, ldb = g.ldb;
    unsigned voffA[2], voffB[2];
#pragma unroll
    for (int i = 0; i < 2; ++i) { int R, C; stage_rc(tid * 16 + i * 8192, R, C); voffA[i] = (unsigned)(R * lda + C) * 2u; voffB[i] = (unsigned)(R * ldb + C) * 2u; }
    const size_t kstep = (size_t)(BK * 2);
    const size_t hstepA = (size_t)HALF * lda * 2, tstepA = 2 * hstepA;
    const size_t hstepB = (size_t)HALF * ldb * 2, tstepB = 2 * hstepB;
    const unsigned ldsw = (unsigned)wid * 1024u;
    const int aoff = lds_byte(wr * 64 + fr, fq * 8), boff = lds_byte(wc * 32 + fr, fq * 8);
#define PG8_SA(b, h) (((b) * 2 + (h)) * HTB)
#define PG8_SB(b, h) ((4 + (b) * 2 + (h)) * HTB)
#define PG8_STAGE(bufoff, gbase, voff) do { _Pragma("unroll") for (int _i = 0; _i < 2; ++_i) \
        __builtin_amdgcn_global_load_lds((const unsigned*)((const char*)(gbase) + (voff)[_i]), (LAS unsigned*)(lds + (bufoff) + ldsw + _i * 8192), 16, 0, 0); } while (0)
#define PG8_LDA(dst, b, h) do { _Pragma("unroll") for (int m = 0; m < 4; ++m) _Pragma("unroll") for (int k = 0; k < 2; ++k) dst[m][k] = *(const LAS bf16x8*)(lds + PG8_SA(b, h) + aoff + m * 2048 + k * 1024); } while (0)
#define PG8_LDB(dst, b, h) do { _Pragma("unroll") for (int n = 0; n < 2; ++n) _Pragma("unroll") for (int k = 0; k < 2; ++k) dst[n][k] = *(const LAS bf16x8*)(lds + PG8_SB(b, h) + boff + n * 2048 + k * 1024); } while (0)
#define PG8_MMA(ai, bj, At, Bt) do { __builtin_amdgcn_s_setprio(1); _Pragma("unroll") for (int m = 0; m < 4; ++m) _Pragma("unroll") for (int n = 0; n < 2; ++n) _Pragma("unroll") for (int k = 0; k < 2; ++k) \
        acc[ai][bj][m][n] = __builtin_amdgcn_mfma_f32_16x16x32_bf16(Bt[n][k], At[m][k], acc[ai][bj][m][n], 0, 0, 0); __builtin_amdgcn_s_setprio(0); } while (0)
#define PG8_WAIT_V(n) asm volatile("s_waitcnt vmcnt(" #n ")" ::: "memory")
#define PG8_WAIT_L(n) asm volatile("s_waitcnt lgkmcnt(" #n ")" ::: "memory")
#define PG8_BAR __builtin_amdgcn_s_barrier()
#define PG8_SCHED __builtin_amdgcn_sched_barrier(0)
    Unit cur, nxt; int ui = 0;
    if (!S.next(0, cur)) return;
    f32x4 acc[2][2][4][2];
#pragma unroll
    for (int a = 0; a < 2; ++a)
#pragma unroll
        for (int b = 0; b < 2; ++b)
#pragma unroll
            for (int m = 0; m < 4; ++m)
#pragma unroll
                for (int n = 0; n < 2; ++n) acc[a][b][m][n] = (f32x4){0.f, 0.f, 0.f, 0.f};
    bf16x8 At[4][2], B0[2][2], B1[2][2];
    const char* cA = (const char*)g.A + (size_t)cur.pm * tstepA + cur.aoff; const char* cB = (const char*)g.Bt + (size_t)cur.pn * tstepB + cur.boff;
    PG8_STAGE(PG8_SB(0, 0), cB, voffB); PG8_STAGE(PG8_SA(0, 0), cA, voffA); PG8_STAGE(PG8_SB(0, 1), cB + hstepB, voffB); PG8_STAGE(PG8_SA(0, 1), cA + hstepA, voffA);
    if (wr == 1) PG8_BAR;
    PG8_WAIT_V(4); PG8_BAR;
    PG8_STAGE(PG8_SB(1, 0), cB + kstep, voffB); PG8_STAGE(PG8_SA(1, 0), cA + kstep, voffA); PG8_STAGE(PG8_SB(1, 1), cB + hstepB + kstep, voffB);
    PG8_WAIT_V(6); PG8_BAR;
    for (;;) {
        const bool has_next = S.next(ui + 1, nxt);
        const char* nA = has_next ? (const char*)g.A + (size_t)nxt.pm * tstepA + nxt.aoff : cA; const char* nB = has_next ? (const char*)g.Bt + (size_t)nxt.pn * tstepB + nxt.boff : cB;
        for (int t = 0; t < nt; t += 2) {
            const bool last = (t == nt - 2);
            const char* a1 = cA + (size_t)(t + 1) * kstep;
            const char* a2 = last ? nA : cA + (size_t)(t + 2) * kstep; const char* b2 = last ? nB : cB + (size_t)(t + 2) * kstep;
            const char* a3 = a2 + kstep; const char* b3 = b2 + kstep;
            PG8_LDB(B0, 0, 0); PG8_SCHED; PG8_LDA(At, 0, 0); PG8_STAGE(PG8_SA(1, 1), a1 + hstepA, voffA);
            PG8_WAIT_L(8); PG8_BAR; PG8_WAIT_L(0); PG8_MMA(0, 0, At, B0); PG8_BAR; PG8_SCHED;
            PG8_LDB(B1, 0, 1); PG8_STAGE(PG8_SB(0, 0), b2, voffB);
            PG8_BAR; PG8_WAIT_L(0); PG8_MMA(0, 1, At, B1); PG8_BAR;
            PG8_LDA(At, 0, 1); PG8_STAGE(PG8_SA(0, 0), a2, voffA);
            PG8_BAR; PG8_WAIT_L(0); PG8_MMA(1, 0, At, B0); PG8_BAR; PG8_SCHED;
            PG8_STAGE(PG8_SB(0, 1), b2 + hstepB, voffB);
            PG8_WAIT_V(6); PG8_BAR; PG8_MMA(1, 1, At, B1); PG8_BAR;
            PG8_LDB(B0, 1, 0); PG8_SCHED; PG8_LDA(At, 1, 0); PG8_STAGE(PG8_SA(0, 1), a2 + hstepA, voffA);
            PG8_WAIT_L(8); PG8_BAR; PG8_WAIT_L(0); PG8_MMA(0, 0, At, B0); PG8_BAR; PG8_SCHED;
            PG8_LDB(B1, 1, 1); PG8_STAGE(PG8_SB(1, 0), b3, voffB);
            PG8_BAR; PG8_WAIT_L(0); PG8_MMA(0, 1, At, B1); PG8_BAR;
            PG8_LDA(At, 1, 1); PG8_STAGE(PG8_SA(1, 0), a3, voffA);
            PG8_BAR; PG8_WAIT_L(0); PG8_MMA(1, 0, At, B0); PG8_BAR; PG8_SCHED;
            PG8_STAGE(PG8_SB(1, 1), b3 + hstepB, voffB);
            PG8_WAIT_V(6); PG8_BAR; PG8_MMA(1, 1, At, B1); PG8_BAR;
        }
        E(acc, cur, wr, wc, fr, fq);
        if (!has_next) break;
#pragma unroll
        for (int a = 0; a < 2; ++a)
#pragma unroll
            for (int b = 0; b < 2; ++b)
#pragma unroll
                for (int m = 0; m < 4; ++m)
#pragma unroll
                    for (int n = 0; n < 2; ++n) acc[a][b][m][n] = (f32x4){0.f, 0.f, 0.f, 0.f};
        cur = nxt; cA = nA; cB = nB; ++ui;
    }
    PG8_WAIT_V(0);
    if (wr == 0) PG8_BAR;
    PG8_BAR;
#undef PG8_SA
#undef PG8_SB
#undef PG8_STAGE
#undef PG8_LDA
#undef PG8_LDB
#undef PG8_MMA
#undef PG8_WAIT_V
#undef PG8_WAIT_L
#undef PG8_BAR
#undef PG8_SCHED
}
}
using pg8::Unit;

template <int LRU> struct EpiStoreT {
    bf16_t* O; int ldc;
    __device__ __forceinline__ void operator()(const f32x4 (&acc)[2][2][4][2], const Unit& u, int wr, int wc, int fr, int fq) const {
        if (LRU) {
            const int row0 = u.pm * 256 + wr * 64 + fr, col0 = 3072 + (u.pn & 1) * 1024 + (u.pn >> 1) * 256 + wc * 32 + 4 * fq;
#pragma unroll
            for (int ai = 0; ai < 2; ++ai)
#pragma unroll
                for (int m = 0; m < 4; ++m) { bf16_t* rowp = O + (size_t)(row0 + ai * 128 + m * 16) * ldc + col0;
#pragma unroll
                    for (int bj = 0; bj < 2; ++bj)
#pragma unroll
                        for (int n = 0; n < 2; ++n) { const f32x4 v = acc[ai][bj][m][n]; u32x2 w; w.x = pk2(v[0], v[1]); w.y = pk2(v[2], v[3]); *(u32x2*)(rowp + bj * 128 + n * 16) = w; } }
        } else {
            const int row0 = u.pm * 256 + wr * 64 + fr, col0 = u.pn * 256 + wc * 32 + 8 * fq;
#pragma unroll
            for (int ai = 0; ai < 2; ++ai)
#pragma unroll
                for (int m = 0; m < 4; ++m) { bf16_t* rowp = O + (size_t)(row0 + ai * 128 + m * 16) * ldc + col0;
#pragma unroll
                    for (int bj = 0; bj < 2; ++bj) { const f32x4 v0 = acc[ai][bj][m][0], v1 = acc[ai][bj][m][1];
                        u32x4 w; w.x = pk2(v0[0], v0[1]); w.y = pk2(v0[2], v0[3]); w.z = pk2(v1[0], v1[1]); w.w = pk2(v1[2], v1[3]); *(u32x4*)(rowp + bj * 128) = w; } }
        }
    }
};
struct EpiSwiGLU {
    bf16_t* G;
    __device__ __forceinline__ void operator()(const f32x4 (&acc)[2][2][4][2], const Unit& u, int wr, int wc, int fr, int fq) const {
        const int row0 = u.pm * 256 + wr * 64 + fr, col0 = (u.pn * 256 + wc * 32) / 2 + 4 * fq;
#pragma unroll
        for (int ai = 0; ai < 2; ++ai)
#pragma unroll
            for (int m = 0; m < 4; ++m) { bf16_t* rowp = G + (size_t)(row0 + ai * 128 + m * 16) * DFF + col0;
#pragma unroll
                for (int bj = 0; bj < 2; ++bj) { const f32x4 gt = acc[ai][bj][m][0], vl = acc[ai][bj][m][1]; u32x2 w;
                    w.x = pk2(siluf(gt[0]) * vl[0], siluf(gt[1]) * vl[1]); w.y = pk2(siluf(gt[2]) * vl[2], siluf(gt[3]) * vl[3]); *(u32x2*)(rowp + bj * 64) = w; } }
    }
};
struct EpiResid {
    float* X; float scale;
    __device__ __forceinline__ void operator()(const f32x4 (&acc)[2][2][4][2], const Unit& u, int wr, int wc, int fr, int fq) const {
        const int row0 = u.pm * 256 + wr * 64 + fr, col0 = u.pn * 256 + wc * 32 + 4 * fq;
#pragma unroll
        for (int ai = 0; ai < 2; ++ai)
#pragma unroll
            for (int m = 0; m < 4; ++m) { float* rowp = X + (size_t)(row0 + ai * 128 + m * 16) * DM + col0;
#pragma unroll
                for (int bj = 0; bj < 2; ++bj)
#pragma unroll
                    for (int n = 0; n < 2; ++n) { f32x4* q = (f32x4*)(rowp + bj * 128 + n * 16); const f32x4 o = *q; *q = o + acc[ai][bj][m][n] * scale; } }
    }
};
struct EpiPart {
    float* PART; float scale;
    __device__ __forceinline__ void operator()(const f32x4 (&acc)[2][2][4][2], const Unit& u, int wr, int wc, int fr, int fq) const {
        const int row0 = u.pm * 256 + wr * 64 + fr, col0 = u.pn * 256 + wc * 32 + 4 * fq;
        float* base = PART + (size_t)(u.aoff >> 9) * MS * DM;
#pragma unroll
        for (int ai = 0; ai < 2; ++ai)
#pragma unroll
            for (int m = 0; m < 4; ++m) { float* rowp = base + (size_t)(row0 + ai * 128 + m * 16) * DM + col0;
#pragma unroll
                for (int bj = 0; bj < 2; ++bj)
#pragma unroll
                    for (int n = 0; n < 2; ++n) *(f32x4*)(rowp + bj * 128 + n * 16) = acc[ai][bj][m][n] * scale; }
    }
};
struct EpiGate {
    bf16_t* MG; const bf16_t* gate; int ldg; int accum;
    __device__ __forceinline__ void operator()(const f32x4 (&acc)[2][2][4][2], const Unit& u, int wr, int wc, int fr, int fq) const {
        const int row0 = u.pm * 256 + wr * 64 + fr, col0 = u.pn * 256 + wc * 32 + 4 * fq;
#pragma unroll
        for (int ai = 0; ai < 2; ++ai)
#pragma unroll
            for (int m = 0; m < 4; ++m) { const size_t r = (size_t)(row0 + ai * 128 + m * 16); bf16_t* rowp = MG + r * DM + col0; const bf16_t* gp = gate + r * ldg + col0;
#pragma unroll
                for (int bj = 0; bj < 2; ++bj)
#pragma unroll
                    for (int n = 0; n < 2; ++n) { const f32x4 v = acc[ai][bj][m][n]; const u32x2 gw = *(const u32x2*)(gp + bj * 128 + n * 16);
                        float o0 = sigm(bf2f(gw.x & 0xffffu)) * v[0], o1 = sigm(bf2f(gw.x >> 16)) * v[1], o2 = sigm(bf2f(gw.y & 0xffffu)) * v[2], o3 = sigm(bf2f(gw.y >> 16)) * v[3];
                        u32x2* q = (u32x2*)(rowp + bj * 128 + n * 16);
                        if (accum) { const u32x2 old = *q; o0 += bf2f(old.x & 0xffffu); o1 += bf2f(old.x >> 16); o2 += bf2f(old.y & 0xffffu); o3 += bf2f(old.y >> 16); }
                        u32x2 w; w.x = pk2(o0, o1); w.y = pk2(o2, o3); *q = w; } }
    }
};
template <class Epi> __device__ __forceinline__ void run_gemm(LAS unsigned char* lds, const bf16_t* A, int lda, const bf16_t* Bt, int N, int K, const Epi& E, int Mrows = MT) {
    pg8::Gemm g; g.A = A; g.Bt = Bt; g.M = Mrows; g.N = N; g.K = K; g.lda = lda; g.ldb = K;
    pg8::StaticOrder S; S.init(Mrows, N, (int)gridDim.x, (int)blockIdx.x);
    pg8::gemm_phase<Epi, pg8::StaticOrder>(lds, g, S, E);
}
__device__ __forceinline__ void run_gemm_resid(LAS unsigned char* lds, const bf16_t* A, int lda, const bf16_t* Bt, int K, float* X, float scale, float* PART) {
    EpiResid e; e.X = X; e.scale = scale;
    run_gemm(lds, A, lda, Bt, DM, K, e, MP);
    EpiPart ea; ea.PART = PART; ea.scale = scale;
    pg8::Gemm g; g.A = A + (size_t)MP * lda; g.Bt = Bt; g.M = MS; g.N = DM; g.K = 256; g.lda = lda; g.ldb = K;
    pg8::SplitOrder S; S.init(8, K / 256, (int)blockIdx.x);
    pg8::gemm_phase<EpiPart, pg8::SplitOrder>(lds, g, S, ea);
}
typedef EpiStoreT<0> EpiStore; typedef EpiStoreT<1> EpiStoreLru;
__device__ __forceinline__ void run_gemm_lru(LAS unsigned char* lds, const bf16_t* A, const bf16_t* Bt, const EpiStoreLru& E) {
    pg8::Gemm g; g.A = A; g.Bt = Bt; g.M = MT; g.N = 2048; g.K = 256; g.lda = DM; g.ldb = 256;
    pg8::LruOrder S; S.init(MT, 2048, (int)gridDim.x, (int)blockIdx.x);
    pg8::gemm_phase<EpiStoreLru, pg8::LruOrder>(lds, g, S, E);
}

__device__ __forceinline__ int srccol(int kind, int j) {
    if (kind == 0) return j;
    if (kind == 1) { const int grp = j >> 5, w = j & 31; return w < 16 ? grp * 16 + w : DFF + grp * 16 + (w - 16); }
    if (j < 1536) return j;
    if (j < 2560) return 7680 + (j - 1536);
    if (j < 4608) return 5632 + (j - 2560);
    if (j < 5632) return 9728 + (j - 4608);
    if (j < 9728) return 1536 + (j - 5632);
    return 8704 + (j - 9728);
}
__device__ __forceinline__ void conv_item(const float* W, int K, int N, bf16_t* WT, int kind, LAS float* scr, int item, int lane) {
    const int nblk = N / 32, kb = item / nblk, nb = item % nblk, k0 = 64 * kb, n0 = 32 * nb;
    const int rho = lane & 31, prm = 8 * ((rho & 15) >> 2) + 4 * (rho >> 4) + (rho & 3);
    const int sc = srccol(kind, n0 + (kind == 2 ? prm : rho));
    float wv[32];
#pragma unroll
    for (int i = 0; i < 32; ++i) { const int kk = 2 * i + (lane >> 5); wv[i] = W[(size_t)(k0 + kk) * N + sc]; }
#pragma unroll
    for (int i = 0; i < 32; ++i) { const int kk = 2 * i + (lane >> 5); scr[kk * 33 + (lane & 31)] = wv[i]; }
    LDS_WAIT();
    const int c = lane & 7;
#pragma unroll
    for (int j = 0; j < 4; ++j) { const int n = (lane >> 3) + 8 * j; const LAS float* s = scr + (8 * c) * 33 + n;
        u32x4 o; o.x = pk2(s[0 * 33], s[1 * 33]); o.y = pk2(s[2 * 33], s[3 * 33]); o.z = pk2(s[4 * 33], s[5 * 33]); o.w = pk2(s[6 * 33], s[7 * 33]);
        *(u32x4*)(WT + (size_t)(n0 + n) * K + k0 + 8 * c) = o; }
    LDS_WAIT();
}
__device__ __forceinline__ void ph_convert(const Params& p, int l, LAS unsigned char* lds) {
    const int wave = tid_opaque() >> 6, lane = tid_opaque() & 63;
    LAS float* scr = (LAS float*)(lds + wave * 8704);
    bf16_t* Wb = (bf16_t*)(p.ws + OFF_W);
    const int gw = blockIdx.x * 8 + wave, NGW = gridDim.x * 8;
    constexpr int I_UP = (1024 / 64) * (5632 / 32), I_DN = (2816 / 64) * (1024 / 32), I_IN = (1024 / 64) * (INC / 32), I_SQ = (1024 / 64) * (1024 / 32);
    constexpr int NIT = 2 * I_UP + 2 * I_DN + I_IN + 4 * I_SQ;
    for (int it = gw; it < NIT; it += NGW) {
        int r = it;
        if (r < I_UP) { conv_item(p.in[I_UP1] + (size_t)l * 1024 * 5632, 1024, 5632, Wb + W_UP1, 1, scr, r, lane); continue; } r -= I_UP;
        if (r < I_DN) { conv_item(p.in[I_DN1] + (size_t)l * 2816 * 1024, 2816, 1024, Wb + W_DN1, 0, scr, r, lane); continue; } r -= I_DN;
        if (r < I_IN) { conv_item(p.in[I_WIN] + (size_t)l * 1024 * INC, 1024, INC, Wb + W_IN, 2, scr, r, lane); continue; } r -= I_IN;
        if (r < I_SQ) { conv_item(p.in[I_WAO] + (size_t)l * 1048576, 1024, 1024, Wb + W_AO, 0, scr, r, lane); continue; } r -= I_SQ;
        if (r < I_SQ) { conv_item(p.in[I_WHO] + (size_t)l * 1048576, 1024, 1024, Wb + W_HO, 0, scr, r, lane); continue; } r -= I_SQ;
        if (r < I_SQ) { conv_item(p.in[I_WLO] + (size_t)l * 1048576, 1024, 1024, Wb + W_LO, 0, scr, r, lane); continue; } r -= I_SQ;
        if (r < I_SQ) { conv_item(p.in[I_WOUT] + (size_t)l * 1048576, 1024, 1024, Wb + W_OUT, 0, scr, r, lane); continue; } r -= I_SQ;
        if (r < I_UP) { conv_item(p.in[I_UP2] + (size_t)l * 1024 * 5632, 1024, 5632, Wb + W_UP2, 1, scr, r, lane); continue; } r -= I_UP;
        conv_item(p.in[I_DN2] + (size_t)l * 2816 * 1024, 2816, 1024, Wb + W_DN2, 0, scr, r, lane);
    }
    for (int idx = blockIdx.x * 512 + tid_opaque(); idx < 2048 * 256; idx += gridDim.x * 512) {
        const int j = idx >> 8, k = idx & 255, pn = j >> 8, i = j & 255, g = pn >> 1, typ = pn & 1;
        const int blk = g * 4 + (i >> 6), dd = i & 63, blk_in = g * 4 + (k >> 6), cc = k & 63;
        float v = 0.f;
        if (blk == blk_in) v = p.in[typ ? I_LWX : I_LWA][(((size_t)l * 16 + blk) * 64 + cc) * 64 + dd];
        Wb[W_LRU + idx] = (bf16_t)f2bf(v);
    }
}

__device__ __forceinline__ float wave_sum(float v) {
#pragma unroll
    for (int o = 1; o < 64; o <<= 1) v += __shfl_xor(v, o);
    return v;
}
__device__ __forceinline__ void ph_norm(const Params& p, const float* g, bool init, int nchunk) {
    const int wave = tid_opaque() >> 6, lane = tid_opaque() & 63;
    const int gw = blockIdx.x * 8 + wave, NGW = gridDim.x * 8;
    float* X = p.out; bf16_t* H = (bf16_t*)(p.ws + OFF_H);
    f32x4 gv[4];
#pragma unroll
    for (int j = 0; j < 4; ++j) gv[j] = ((const f32x4*)g)[lane + 64 * j];
    for (int row = gw; row < MT; row += NGW) {
        const float* src = init ? (row < MP ? p.in[I_XP] + (size_t)row * DM : p.in[I_XS] + (size_t)(row - MP) * DM) : X + (size_t)row * DM;
        f32x4 v[4]; float s = 0.f;
#pragma unroll
        for (int j = 0; j < 4; ++j) v[j] = ((const f32x4*)src)[lane + 64 * j];
        const bool fold = !init && row >= MP && nchunk > 0;
        if (fold) { const float* part = (const float*)(p.ws + OFF_S) + (size_t)(row - MP) * DM;
            for (int c = 0; c < nchunk; ++c)
#pragma unroll
                for (int j = 0; j < 4; ++j) v[j] += ((const f32x4*)(part + (size_t)c * MS * DM))[lane + 64 * j]; }
#pragma unroll
        for (int j = 0; j < 4; ++j) s += (v[j][0] * v[j][0] + v[j][1] * v[j][1]) + (v[j][2] * v[j][2] + v[j][3] * v[j][3]);
        s = wave_sum(s);
        const float rstd = rsqrtf(s * (1.f / DM) + EPS);
#pragma unroll
        for (int j = 0; j < 4; ++j) { u32x2 w; w.x = pk2(v[j][0] * rstd * gv[j][0], v[j][1] * rstd * gv[j][1]); w.y = pk2(v[j][2] * rstd * gv[j][2], v[j][3] * rstd * gv[j][3]);
            *(u32x2*)(H + (size_t)row * DM + (lane + 64 * j) * 4) = w;
            if (init || fold) ((f32x4*)(X + (size_t)row * DM))[lane + 64 * j] = v[j]; }
    }
}

constexpr int KS_LD = 72, VT_LD = 200;
constexpr int KS_OFF = 0, VT_OFF = 192 * KS_LD * 2;
template <bool SAMPLE>
__device__ __forceinline__ void attn_item(const Params& p, int l, LAS unsigned char* lds, int b, int c, int kvh, bool dry) {
    const int tid = tid_opaque(), wave = tid >> 6, lane = tid & 63, l15 = lane & 15, quad = lane >> 4;
    bf16_t* PA = (bf16_t*)(p.ws + OFF_P);
    LAS bf16_t* Ks = (LAS bf16_t*)(lds + KS_OFF); LAS bf16_t* Vt = (LAS bf16_t*)(lds + VT_OFF);
    const float* kg = p.in[I_KN] + l * 64; const float* qg = p.in[I_QN] + l * 64;
    constexpr int NQT = SAMPLE ? 1 : 2, NKT = SAMPLE ? 10 : 12;
    const bool active = SAMPLE ? (wave < 4) : true;
    const int g = SAMPLE ? (wave & 3) : (wave >> 1), tokbase = SAMPLE ? 0 : (wave & 1) * 32;
    const int hq = kvh * 4 + g;
    u32x4 qraw[NQT][2]; long qrow[NQT];
#pragma unroll
    for (int qt = 0; qt < NQT; ++qt) {
        const int tok = tokbase + qt * 16 + l15;
        qrow[qt] = SAMPLE ? ((long)MP + b * DSQ + tok) : ((long)b * SEQ + c * 64 + tok);
        const bf16_t* qp = PA + qrow[qt] * LDA_ + hq * 64;
        qraw[qt][0] = *(const u32x4*)(qp + quad * 8); qraw[qt][1] = *(const u32x4*)(qp + 32 + quad * 8);
    }
    {
        const int d8 = (tid & 7) * 8;
        float kgv[8];
#pragma unroll
        for (int i = 0; i < 8; ++i) kgv[i] = kg[d8 + i];
#pragma unroll
        for (int pass = 0; pass < 3; ++pass) {
            const int j = pass * 64 + (tid >> 3);
            float kf[8], vf[8]; bool valid, need_norm; long row = 0;
            if (!SAMPLE) { const int tk = (c - 2) * 64 + j; valid = tk >= 0; need_norm = true; row = (long)b * SEQ + tk; }
            else { valid = j < 144; need_norm = j >= 128; row = (long)MP + b * DSQ + (j - 128); }
            if (valid && need_norm) {
                const u32x4 kr = *(const u32x4*)(PA + row * LDA_ + 1024 + kvh * 64 + d8); const u32x4 vr = *(const u32x4*)(PA + row * LDA_ + 1280 + kvh * 64 + d8);
                unpack8(kr, kf); unpack8(vr, vf);
            } else if (valid) {
                const float* ck = p.in[I_CK] + ((((size_t)l * DB + b) * 128 + j) * 4 + kvh) * 64 + d8; const float* cv = p.in[I_CV] + ((((size_t)l * DB + b) * 128 + j) * 4 + kvh) * 64 + d8;
                const f32x4 a0 = *(const f32x4*)ck, a1 = *(const f32x4*)(ck + 4), b0 = *(const f32x4*)cv, b1 = *(const f32x4*)(cv + 4);
#pragma unroll
                for (int i = 0; i < 4; ++i) { kf[i] = a0[i]; kf[4 + i] = a1[i]; vf[i] = b0[i]; vf[4 + i] = b1[i]; }
            } else {
#pragma unroll
                for (int i = 0; i < 8; ++i) { kf[i] = 0.f; vf[i] = 0.f; }
            }
            float ss = 0.f;
#pragma unroll
            for (int i = 0; i < 8; ++i) ss += kf[i] * kf[i];
            ss += __shfl_xor(ss, 1); ss += __shfl_xor(ss, 2); ss += __shfl_xor(ss, 4);
            if (need_norm) { const float rstd = rsqrtf(ss * (1.f / 64.f) + EPS);
#pragma unroll
                for (int i = 0; i < 8; ++i) kf[i] = kf[i] * rstd * kgv[i]; }
            *(LAS u32x4*)(Ks + j * KS_LD + d8) = pack8(kf);
#pragma unroll
            for (int i = 0; i < 8; ++i) Vt[(d8 + i) * VT_LD + j] = (bf16_t)f2bf(vf[i]);
            if (!SAMPLE) { const int tk = (c - 2) * 64 + j;
                if (j >= 128 && tk >= SEQ - 128) { const size_t o = ((((size_t)l * NB + b) * 128 + (tk - (SEQ - 128))) * 4 + kvh) * 64 + d8;
#pragma unroll
                    for (int i = 0; i < 8; ++i) { p.out[O_NKP + o + i] = kf[i]; p.out[O_NVP + o + i] = vf[i]; } } }
            else if (j >= 128 && j < 144) { const size_t o = ((((size_t)l * DB + b) * DSQ + (j - 128)) * 4 + kvh) * 64 + d8;
#pragma unroll
                for (int i = 0; i < 8; ++i) { p.out[O_NKS + o + i] = kf[i]; p.out[O_NVS + o + i] = vf[i]; } }
        }
    }
    __syncthreads();
    if (active) {
        const float sink = p.in[I_SINK][l * 16 + hq];
        const int kmin = SAMPLE ? 0 : (c >= 2 ? 0 : (2 - c) * 64), kmax = SAMPLE ? 144 : 192;
        bf16x8 qf[NQT][2];
#pragma unroll
        for (int qt = 0; qt < NQT; ++qt) {
            float q0[8], q1[8]; unpack8(qraw[qt][0], q0); unpack8(qraw[qt][1], q1);
            float ss = 0.f;
#pragma unroll
            for (int i = 0; i < 8; ++i) ss += q0[i] * q0[i] + q1[i] * q1[i];
            ss += __shfl_xor(ss, 16); ss += __shfl_xor(ss, 32);
            const float sc = rsqrtf(ss * (1.f / 64.f) + EPS) * 0.125f;
#pragma unroll
            for (int i = 0; i < 8; ++i) { q0[i] = q0[i] * sc * qg[quad * 8 + i]; q1[i] = q1[i] * sc * qg[32 + quad * 8 + i]; }
            const u32x4 w0 = pack8(q0), w1 = pack8(q1);
            qf[qt][0] = __builtin_bit_cast(bf16x8, w0); qf[qt][1] = __builtin_bit_cast(bf16x8, w1);
        }
        f32x4 st[NKT][NQT];
#pragma unroll
        for (int kt = 0; kt < NKT; ++kt) {
#pragma unroll
            for (int qt = 0; qt < NQT; ++qt) st[kt][qt] = (f32x4){0.f, 0.f, 0.f, 0.f};
#pragma unroll
            for (int ds = 0; ds < 2; ++ds) {
                const bf16x8 kfr = *(const LAS bf16x8*)(Ks + (kt * 16 + l15) * KS_LD + ds * 32 + quad * 8);
#pragma unroll
                for (int qt = 0; qt < NQT; ++qt) st[kt][qt] = __builtin_amdgcn_mfma_f32_16x16x32_bf16(kfr, qf[qt][ds], st[kt][qt], 0, 0, 0);
            }
        }
        float inv[NQT];
#pragma unroll
        for (int qt = 0; qt < NQT; ++qt) {
            float m = -1e30f;
#pragma unroll
            for (int kt = 0; kt < NKT; ++kt)
#pragma unroll
                for (int j = 0; j < 4; ++j) { const int key = kt * 16 + quad * 4 + j; const bool ok = key >= kmin && key < kmax; if (ok) m = fmaxf(m, st[kt][qt][j]); }
            m = fmaxf(m, __shfl_xor(m, 16)); m = fmaxf(m, __shfl_xor(m, 32));
            m = fmaxf(m, sink);
            float sum = 0.f;
#pragma unroll
            for (int kt = 0; kt < NKT; ++kt)
#pragma unroll
                for (int j = 0; j < 4; ++j) { const int key = kt * 16 + quad * 4 + j; const bool ok = key >= kmin && key < kmax; const float e = ok ? __expf(st[kt][qt][j] - m) : 0.f; st[kt][qt][j] = e; sum += e; }
            sum += __shfl_xor(sum, 16); sum += __shfl_xor(sum, 32);
            inv[qt] = 1.f / (sum + __expf(sink - m));
        }
        f32x4 ot[4][NQT];
#pragma unroll
        for (int dt = 0; dt < 4; ++dt)
#pragma unroll
            for (int qt = 0; qt < NQT; ++qt) ot[dt][qt] = (f32x4){0.f, 0.f, 0.f, 0.f};
#pragma unroll
        for (int s = 0; s < NKT / 2; ++s) {
            bf16x8 pf[NQT];
#pragma unroll
            for (int qt = 0; qt < NQT; ++qt) { u32x4 w; w.x = pk2(st[2 * s][qt][0], st[2 * s][qt][1]); w.y = pk2(st[2 * s][qt][2], st[2 * s][qt][3]);
                w.z = pk2(st[2 * s + 1][qt][0], st[2 * s + 1][qt][1]); w.w = pk2(st[2 * s + 1][qt][2], st[2 * s + 1][qt][3]); pf[qt] = __builtin_bit_cast(bf16x8, w); }
#pragma unroll
            for (int dt = 0; dt < 4; ++dt) {
                const LAS bf16_t* vp = Vt + (dt * 16 + l15) * VT_LD + 32 * s + quad * 4;
                const u32x2 lo = *(const LAS u32x2*)vp, hi = *(const LAS u32x2*)(vp + 16);
                u32x4 w; w.x = lo.x; w.y = lo.y; w.z = hi.x; w.w = hi.y;
                const bf16x8 vfr = __builtin_bit_cast(bf16x8, w);
#pragma unroll
                for (int qt = 0; qt < NQT; ++qt) ot[dt][qt] = __builtin_amdgcn_mfma_f32_16x16x32_bf16(vfr, pf[qt], ot[dt][qt], 0, 0, 0);
            }
        }
#pragma unroll
        for (int qt = 0; qt < NQT; ++qt) {
            bf16_t* op = PA + qrow[qt] * LDA_ + hq * 64 + quad * 4;
#pragma unroll
            for (int dt = 0; dt < 4; ++dt) { u32x2 w; w.x = pk2(ot[dt][qt][0] * inv[qt], ot[dt][qt][1] * inv[qt]); w.y = pk2(ot[dt][qt][2] * inv[qt], ot[dt][qt][3] * inv[qt]); if (!dry) *(u32x2*)(op + dt * 16) = w; }
        }
    }
    __syncthreads();
}
__device__ __forceinline__ void ph_attn(const Params& p, int l, LAS unsigned char* lds, bool dry) {
    constexpr int NPI = NB * 64 * 4, NSI = DB * 4;
    for (int it = blockIdx.x; it < NPI + NSI; it += gridDim.x) {
        if (it < NPI) { const int kvh = it & 3, c = (it >> 2) & 63, b = it >> 8; attn_item<false>(p, l, lds, b, c, kvh, dry); }
        else { const int r = it - NPI; attn_item<true>(p, l, lds, r >> 2, 0, r & 3, dry); }
    }
}

__device__ __forceinline__ float hgrn_lb(const Params& p, int l, int idx) {
    if (l == 0) return 0.f;
    const float a = p.in[I_LBL][idx], b = p.in[I_LBL][1024 + idx]; const float m = fmaxf(a, b); const float ea = __expf(a - m), eb = __expf(b - m);
    const float p0 = ea / (ea + eb), p1 = eb / (ea + eb); return (p0 + p1) - p0;
}
template <int MODE>
__device__ __forceinline__ void hgrn_item(const Params& p, int l, LAS unsigned char* lds, long rowbase, int ntok, int h, const float* Sin, float* Sout, float* Dout, bool dry) {
    const int tid = tid_opaque(), wave = tid >> 6, lane = tid & 63, kgi = lane & 15, vs = lane >> 4, vcol = wave * 16 + vs * 4;
    bf16_t* PB = (bf16_t*)(p.ws + OFF_P);
    LAS float* Fs = (LAS float*)lds; LAS float* Kk = Fs + 4096; LAS float* Qs = Kk + 4096; LAS float* Vs = Qs + 4096; LAS float* Os = Vs + 4096;
    f32x2 Sa[8], Sb[8];
#pragma unroll
    for (int i = 0; i < 8; ++i) { f32x4 v = (f32x4){0.f, 0.f, 0.f, 0.f}; if (Sin) v = *(const f32x4*)(Sin + (size_t)(kgi * 8 + i) * 128 + vcol);
        Sa[i] = (f32x2){v[0], v[1]}; Sb[i] = (f32x2){v[2], v[3]}; }
    float Dp[8];
#pragma unroll
    for (int i = 0; i < 8; ++i) Dp[i] = 1.f;
    const int st = tid >> 4, k8 = (tid & 15) * 8;
    float lbv[8], gnv[8];
#pragma unroll
    for (int i = 0; i < 8; ++i) { lbv[i] = hgrn_lb(p, l, h * 128 + k8 + i); gnv[i] = p.in[I_HON][l * 128 + k8 + i]; }
    u32x4 r_hq = (u32x4){0u, 0u, 0u, 0u}, r_hf = r_hq, r_hi = r_hq, r_hg = r_hq;
    { const int nb0 = ntok < 32 ? ntok : 32;
      if (st < nb0) { const bf16_t* rp = PB + (rowbase + st) * LDB_ + h * 128 + k8; r_hf = *(const u32x4*)(rp + 1024); r_hi = *(const u32x4*)(rp + 2048); if (MODE == 1) r_hq = *(const u32x4*)rp; } }
    for (int t0 = 0; t0 < ntok; t0 += 32) {
        const int nb = (ntok - t0) < 32 ? (ntok - t0) : 32;
        if (st < nb) {
            float hf[8], hi[8]; unpack8(r_hf, hf); unpack8(r_hi, hi);
            float fv[8];
#pragma unroll
            for (int i = 0; i < 8; ++i) { const float sg = sigm(hf[i]); const float f = lbv[i] + (1.f - lbv[i]) * sg; fv[i] = fmaxf(f, 1e-26f); }
            *(LAS f32x4*)(Fs + st * 128 + k8) = (f32x4){fv[0], fv[1], fv[2], fv[3]}; *(LAS f32x4*)(Fs + st * 128 + k8 + 4) = (f32x4){fv[4], fv[5], fv[6], fv[7]};
            *(LAS f32x4*)(Vs + st * 128 + k8) = (f32x4){hi[0], hi[1], hi[2], hi[3]}; *(LAS f32x4*)(Vs + st * 128 + k8 + 4) = (f32x4){hi[4], hi[5], hi[6], hi[7]};
            if (MODE == 1) { float hq[8]; unpack8(r_hq, hq);
                *(LAS f32x4*)(Qs + st * 128 + k8) = (f32x4){siluf(hq[0]), siluf(hq[1]), siluf(hq[2]), siluf(hq[3])}; *(LAS f32x4*)(Qs + st * 128 + k8 + 4) = (f32x4){siluf(hq[4]), siluf(hq[5]), siluf(hq[6]), siluf(hq[7])}; }
        }
        __syncthreads();
        { const int t1 = t0 + 32; const int nb1 = (ntok - t1) < 32 ? (ntok - t1) : 32;
          if (t1 < ntok && st < nb1) { const bf16_t* rp = PB + (rowbase + t1 + st) * LDB_ + h * 128 + k8; r_hf = *(const u32x4*)(rp + 1024); r_hi = *(const u32x4*)(rp + 2048); if (MODE == 1) r_hq = *(const u32x4*)rp; }
          if (MODE == 1 && st < nb) r_hg = *(const u32x4*)(PB + (rowbase + t0 + st) * LDB_ + 3072 + h * 128 + k8); }
#pragma unroll 4
        for (int t = 0; t < nb; ++t) {
            const f32x4 f0 = *(const LAS f32x4*)(Fs + t * 128 + kgi * 8), f1 = *(const LAS f32x4*)(Fs + t * 128 + kgi * 8 + 4);
            const f32x4 v4 = *(const LAS f32x4*)(Vs + t * 128 + vcol);
            f32x4 q0 = (f32x4){0.f, 0.f, 0.f, 0.f}, q1 = q0;
            if (MODE == 1) { q0 = *(const LAS f32x4*)(Qs + t * 128 + kgi * 8); q1 = *(const LAS f32x4*)(Qs + t * 128 + kgi * 8 + 4); }
            f32x2 oa = (f32x2){0.f, 0.f}, ob = oa; const f32x2 va = (f32x2){v4[0], v4[1]}, vb = (f32x2){v4[2], v4[3]};
#pragma unroll
            for (int i = 0; i < 8; ++i) { const float fi = i < 4 ? f0[i & 3] : f1[i & 3], qi = i < 4 ? q0[i & 3] : q1[i & 3];
                if (MODE == 0) Dp[i] *= fi;
                const f32x2 f2 = (f32x2){fi, fi}, q2 = (f32x2){qi, qi};
                Sa[i] = va + f2 * (Sa[i] - va); Sb[i] = vb + f2 * (Sb[i] - vb);
                if (MODE == 1) { oa += Sa[i] * q2; ob += Sb[i] * q2; } }
            if (MODE == 1) {
                float o[4] = {oa[0], oa[1], ob[0], ob[1]};
#pragma unroll
                for (int j = 0; j < 4; ++j) { o[j] += row_ror<1>(o[j]); o[j] += row_ror<2>(o[j]); o[j] += row_ror<4>(o[j]); o[j] += row_ror<8>(o[j]); }
                if (kgi == 0) *(LAS f32x4*)(Os + t * 128 + vcol) = (f32x4){o[0], o[1], o[2], o[3]};
            }
        }
        __syncthreads();
        if (MODE == 1 && st < nb) {
            const f32x4 o0 = *(const LAS f32x4*)(Os + st * 128 + k8), o1 = *(const LAS f32x4*)(Os + st * 128 + k8 + 4);
            float ov[8] = {o0[0], o0[1], o0[2], o0[3], o1[0], o1[1], o1[2], o1[3]};
            float ss = 0.f;
#pragma unroll
            for (int i = 0; i < 8; ++i) ss += ov[i] * ov[i];
            ss += __shfl_xor(ss, 1); ss += __shfl_xor(ss, 2); ss += __shfl_xor(ss, 4); ss += __shfl_xor(ss, 8);
            const float rstd = rsqrtf(ss * (1.f / 128.f) + EPS);
            bf16_t* gp = PB + (rowbase + t0 + st) * LDB_ + 3072 + h * 128 + k8;
            float hg[8]; unpack8(r_hg, hg);
#pragma unroll
            for (int i = 0; i < 8; ++i) ov[i] = ov[i] * rstd * gnv[i] * siluf(hg[i]);
            if (!dry) *(u32x4*)gp = pack8(ov);
        }
    }
    if (Sout) {
#pragma unroll
        for (int i = 0; i < 8; ++i) *(f32x4*)(Sout + (size_t)(kgi * 8 + i) * 128 + vcol) = (f32x4){Sa[i][0], Sa[i][1], Sb[i][0], Sb[i][1]};
    }
    if (MODE == 0 && wave == 0 && vs == 0) {
#pragma unroll
        for (int i = 0; i < 8; ++i) Dout[kgi * 8 + i] = Dp[i];
    }
    __syncthreads();
}
__device__ __forceinline__ void hgrn1_item_mfma(const Params& p, int l, LAS unsigned char* lds, long rowbase, int h, float* Sout, float* Dout) {
    const int tid = tid_opaque(), wave = tid >> 6, lane = tid & 63, l15 = lane & 15, quad = lane >> 4;
    const bf16_t* PB = (const bf16_t*)(p.ws + OFF_P);
    LAS float* G = (LAS float*)lds; LAS float* KKs = G + 64 * 128;
    LAS bf16_t* KdT = (LAS bf16_t*)(lds + 65536); LAS bf16_t* Vt = (LAS bf16_t*)(lds + 65536 + 18432);
    LAS float* QS = (LAS float*)(lds + 65536 + 36864); LAS float* CAR = QS + 512; LAS bf16_t* Vs1 = (LAS bf16_t*)(lds + 106496);
    const int st = tid >> 3, kb = (tid & 7) * 16;
    const int sk = tid & 127, qr = tid >> 7;
    float lbv[16];
#pragma unroll
    for (int i = 0; i < 16; ++i) lbv[i] = hgrn_lb(p, l, h * 128 + kb + i);
    if (tid < 128) CAR[tid] = 0.f;
    f32x4 acc[8];
#pragma unroll
    for (int vt = 0; vt < 8; ++vt) acc[vt] = (f32x4){0.f, 0.f, 0.f, 0.f};
    __syncthreads();
    for (int c = SEGT / 64 - 1; c >= 0; --c) {
        {
            const bf16_t* rp = PB + (rowbase + c * 64 + st) * LDB_ + h * 128 + kb;
            float hf[16], hi[16];
            unpack8(*(const u32x4*)(rp + 1024), *(float(*)[8])&hf[0]); unpack8(*(const u32x4*)(rp + 1024 + 8), *(float(*)[8])&hf[8]);
            unpack8(*(const u32x4*)(rp + 2048), *(float(*)[8])&hi[0]); unpack8(*(const u32x4*)(rp + 2048 + 8), *(float(*)[8])&hi[8]);
#pragma unroll
            for (int i = 0; i < 16; ++i) { const float sg = sigm(hf[i]); const float f = fmaxf(lbv[i] + (1.f - lbv[i]) * sg, 1e-26f);
                G[st * 128 + kb + i] = __logf(f); KKs[st * 128 + kb + i] = 1.f - f; }
            *(LAS u32x4*)(Vs1 + st * 128 + kb) = pack8(*(float(*)[8])&hi[0]); *(LAS u32x4*)(Vs1 + st * 128 + kb + 8) = pack8(*(float(*)[8])&hi[8]);
        }
        __syncthreads();
        {
            float run = 0.f;
#pragma unroll
            for (int i = 15; i >= 0; --i) { const int t = qr * 16 + i; const float g = G[t * 128 + sk]; G[t * 128 + sk] = run; run += g; }
            QS[qr * 128 + sk] = run;
        }
        __syncthreads();
        {
            float add = CAR[sk];
#pragma unroll
            for (int q2 = 1; q2 < 4; ++q2) if (q2 > qr) add += QS[q2 * 128 + sk];
            float kd[16], vv[16];
#pragma unroll
            for (int i = 0; i < 16; ++i) { const int t = qr * 16 + i; const float e = G[t * 128 + sk] + add; kd[i] = KKs[t * 128 + sk] * __expf(e); vv[i] = bf2f(Vs1[t * 128 + sk]); }
            *(LAS u32x4*)(KdT + sk * 72 + qr * 16) = pack8(*(float(*)[8])&kd[0]); *(LAS u32x4*)(KdT + sk * 72 + qr * 16 + 8) = pack8(*(float(*)[8])&kd[8]);
            *(LAS u32x4*)(Vt + sk * 72 + qr * 16) = pack8(*(float(*)[8])&vv[0]); *(LAS u32x4*)(Vt + sk * 72 + qr * 16 + 8) = pack8(*(float(*)[8])&vv[8]);
        }
        __syncthreads();
        if (qr == 0) CAR[sk] += (QS[sk] + QS[128 + sk]) + (QS[256 + sk] + QS[384 + sk]);
#pragma unroll
        for (int s2 = 0; s2 < 2; ++s2) {
            const bf16x8 a = *(const LAS bf16x8*)(KdT + (wave * 16 + l15) * 72 + s2 * 32 + quad * 8);
#pragma unroll
            for (int vt = 0; vt < 8; ++vt) { const bf16x8 bfr = *(const LAS bf16x8*)(Vt + (vt * 16 + l15) * 72 + s2 * 32 + quad * 8);
                acc[vt] = __builtin_amdgcn_mfma_f32_16x16x32_bf16(a, bfr, acc[vt], 0, 0, 0); }
        }
        __syncthreads();
    }
#pragma unroll
    for (int vt = 0; vt < 8; ++vt)
#pragma unroll
        for (int r = 0; r < 4; ++r) Sout[(size_t)(wave * 16 + quad * 4 + r) * 128 + vt * 16 + l15] = acc[vt][r];
    if (tid < 128) Dout[tid] = __expf(CAR[tid]);
    __syncthreads();
}
__device__ __forceinline__ void ph_hgrn1(const Params& p, int l, LAS unsigned char* lds) {
    float* Sb = (float*)(p.ws + OFF_S); float* Db = (float*)(p.ws + OFF_D);
    constexpr int NI = NB * 8 * (NSEG - 1);
    for (int it = blockIdx.x; it < NI; it += gridDim.x) {
        const int seg = it % (NSEG - 1), bh = it / (NSEG - 1), b = bh >> 3, h = bh & 7;
        hgrn1_item_mfma(p, l, lds, (long)b * SEQ + seg * SEGT, h, Sb + ((size_t)bh * NSEG + seg + 1) * 16384, Db + ((size_t)bh * NSEG + seg) * 128);
    }
}
__device__ __forceinline__ void ph_hgrn2(const Params& p) {
    float* Sb = (float*)(p.ws + OFF_S); const float* Db = (const float*)(p.ws + OFF_D);
    const int nth = gridDim.x * 512;
    for (int e = blockIdx.x * 512 + tid_opaque(); e < NB * 8 * 16384; e += nth) {
        const int bh = e >> 14, kv = e & 16383, k = kv >> 7;
        float* base = Sb + (size_t)bh * NSEG * 16384 + kv; float carry = 0.f; base[0] = 0.f;
        for (int s = 1; s < NSEG; ++s) { const float d = Db[((size_t)bh * NSEG + (s - 1)) * 128 + k]; carry = d * carry + base[(size_t)s * 16384]; base[(size_t)s * 16384] = carry; }
    }
}
constexpr int H3_G = 0, H3_Q = 16384, H3_K = 32768, H3_QC = 49152, H3_KD = 57856, H3_VT = 78336, H3_S0 = 92672, H3_AT = 127488, H3_OS = 130048, H3_DS = 138240, H3_VS = 139264, H3_KC = 147456, H3_FL = 156160, H3_END = 156416;
template <bool SAMPLE>
__device__ __forceinline__ void hgrn3_item_mfma(const Params& p, int l, LAS unsigned char* lds, long rowbase, int h, const float* Sin, float* Sout, bool dry) {
    constexpr int NTOK = SAMPLE ? 16 : SEGT, NBLK = SAMPLE ? 1 : 2;
    const int tid = tid_opaque(), wave = tid >> 6, lane = tid & 63, l15 = lane & 15, quad = lane >> 4;
    bf16_t* PB = (bf16_t*)(p.ws + OFF_P);
    LAS float* G = (LAS float*)(lds + H3_G); LAS float* Qs = (LAS float*)(lds + H3_Q); LAS float* KKs = (LAS float*)(lds + H3_K);
    LAS bf16_t* QcS = (LAS bf16_t*)(lds + H3_QC); LAS bf16_t* KdTS = (LAS bf16_t*)(lds + H3_KD); LAS bf16_t* Vt = (LAS bf16_t*)(lds + H3_VT);
    LAS bf16_t* S0T = (LAS bf16_t*)(lds + H3_S0); LAS bf16_t* attS = (LAS bf16_t*)(lds + H3_AT);
    LAS float* Os = (LAS float*)(lds + H3_OS); LAS float* Ds = (LAS float*)(lds + H3_DS); LAS bf16_t* Vs2 = (LAS bf16_t*)(lds + H3_VS);
    LAS bf16_t* KcS = (LAS bf16_t*)(lds + H3_KC); LAS int* FLG = (LAS int*)(lds + H3_FL);
    for (int i = tid; i < (H3_S0 - H3_KD) / 16; i += 512) *(LAS u32x4*)(lds + H3_KD + i * 16) = (u32x4){0u, 0u, 0u, 0u};
    for (int i = tid; i < (H3_OS - H3_AT) / 16; i += 512) *(LAS u32x4*)(lds + H3_AT + i * 16) = (u32x4){0u, 0u, 0u, 0u};
    f32x4 acc[8];
#pragma unroll
    for (int vt = 0; vt < 8; ++vt) {
#pragma unroll
        for (int r = 0; r < 4; ++r) acc[vt][r] = Sin ? Sin[(size_t)(wave * 16 + quad * 4 + r) * 128 + vt * 16 + l15] : 0.f; }
    const int kc = tid & 15;
    int pt[5], pm[5];
#pragma unroll
    for (int pp = 0; pp < 5; ++pp) { const int pi = pp * 32 + (tid >> 4); int t = (int)((sqrtf(8.f * pi + 1.f) - 1.f) * 0.5f); if ((t + 1) * (t + 2) / 2 <= pi) ++t; if (t * (t + 1) / 2 > pi) --t;
        pt[pp] = pi < 136 ? t : -1; pm[pp] = pi - t * (t + 1) / 2; }
    const int st = tid >> 4, k8 = (tid & 15) * 8;
    float lbv[8];
#pragma unroll
    for (int i = 0; i < 8; ++i) lbv[i] = hgrn_lb(p, l, h * 128 + k8 + i);
    const int ptk = tid >> 5, pv4 = (tid & 31) * 4;
    const f32x4 gn4 = *(const f32x4*)(p.in[I_HON] + l * 128 + pv4);
    u32x4 r_hq = (u32x4){0u, 0u, 0u, 0u}, r_hf = r_hq, r_hi = r_hq; u32x2 r_hg[NBLK];
    if (st < NBLK * 16) { const bf16_t* rp = PB + (rowbase + st) * LDB_ + h * 128 + k8; r_hq = *(const u32x4*)rp; r_hf = *(const u32x4*)(rp + 1024); r_hi = *(const u32x4*)(rp + 2048); }
    __syncthreads();
    for (int c0 = 0; c0 < NTOK; c0 += 32) {
#pragma unroll
        for (int bq = 0; bq < NBLK; ++bq) r_hg[bq] = *(const u32x2*)(PB + (rowbase + c0 + bq * 16 + ptk) * LDB_ + 3072 + h * 128 + pv4);
        if (st < NBLK * 16) {
            float hq[8], hf[8], hi[8]; unpack8(r_hq, hq); unpack8(r_hf, hf); unpack8(r_hi, hi);
#pragma unroll
            for (int i = 0; i < 8; ++i) { const float sg = sigm(hf[i]); const float f = fmaxf(lbv[i] + (1.f - lbv[i]) * sg, 1e-26f);
                G[st * 128 + k8 + i] = __logf(f); KKs[st * 128 + k8 + i] = 1.f - f; Qs[st * 128 + k8 + i] = siluf(hq[i]); }
            *(LAS u32x4*)(Vs2 + st * 128 + k8) = r_hi;
        }
        if (tid < 2) FLG[tid] = 0;
        __syncthreads();
        if (c0 + 32 < NTOK && st < NBLK * 16) { const bf16_t* rp = PB + (rowbase + c0 + 32 + st) * LDB_ + h * 128 + k8; r_hq = *(const u32x4*)rp; r_hf = *(const u32x4*)(rp + 1024); r_hi = *(const u32x4*)(rp + 2048); }
        if (tid < 128 * NBLK) {
            const int k = tid & 127, blk = tid >> 7; float run = 0.f;
#pragma unroll
            for (int t = 0; t < 16; ++t) { const int o = (blk * 16 + t) * 128 + k; run += G[o]; G[o] = run; QcS[(blk * 16 + t) * 136 + k] = (bf16_t)f2bf(Qs[o] * __expf(run)); }
            Ds[blk * 128 + k] = __expf(run);
            if (run < -80.f) FLG[blk] = 1;
#pragma unroll
            for (int t = 0; t < 16; ++t) { const int o = (blk * 16 + t) * 128 + k; KcS[(blk * 16 + t) * 136 + k] = (bf16_t)f2bf(KKs[o] * __expf(fminf(-G[o], 85.f))); }
            float kd[16]; unsigned vw[8];
#pragma unroll
            for (int t = 0; t < 16; ++t) { const int o = (blk * 16 + t) * 128 + k; kd[t] = KKs[o] * __expf(run - G[o]); }
#pragma unroll
            for (int t = 0; t < 8; ++t) vw[t] = (unsigned)Vs2[(blk * 16 + 2 * t) * 128 + k] | ((unsigned)Vs2[(blk * 16 + 2 * t + 1) * 128 + k] << 16);
            *(LAS u32x4*)(KdTS + (blk * 128 + k) * 40) = pack8(*(float(*)[8])&kd[0]); *(LAS u32x4*)(KdTS + (blk * 128 + k) * 40 + 8) = pack8(*(float(*)[8])&kd[8]);
            *(LAS u32x4*)(Vt + k * 56 + blk * 16) = (u32x4){vw[0], vw[1], vw[2], vw[3]}; *(LAS u32x4*)(Vt + k * 56 + blk * 16 + 8) = (u32x4){vw[4], vw[5], vw[6], vw[7]};
        }
        __syncthreads();
#pragma unroll 1
        for (int blk = 0; blk < NBLK; ++blk) {
            const bool exact = FLG[blk] != 0;
            if (!exact) { if (wave == 0) { f32x4 C = (f32x4){0.f, 0.f, 0.f, 0.f};
#pragma unroll
                    for (int sl = 0; sl < 4; ++sl) { const bf16x8 a = *(const LAS bf16x8*)(QcS + (blk * 16 + l15) * 136 + sl * 32 + quad * 8); const bf16x8 bk = *(const LAS bf16x8*)(KcS + (blk * 16 + l15) * 136 + sl * 32 + quad * 8);
                        C = __builtin_amdgcn_mfma_f32_16x16x32_bf16(a, bk, C, 0, 0, 0); }
#pragma unroll
                    for (int r = 0; r < 4; ++r) { const int t = quad * 4 + r; attS[(blk * 16 + t) * 40 + l15] = (bf16_t)f2bf(l15 <= t ? C[r] : 0.f); } } }
            else
#pragma unroll
            for (int pp = 0; pp < 5; ++pp) if (pt[pp] >= 0) {
                const int ot = ((blk * 16 + pt[pp]) * 128 + kc * 8), om = ((blk * 16 + pm[pp]) * 128 + kc * 8);
                const f32x4 q0 = *(const LAS f32x4*)(Qs + ot), q1 = *(const LAS f32x4*)(Qs + ot + 4), k0 = *(const LAS f32x4*)(KKs + om), k1 = *(const LAS f32x4*)(KKs + om + 4);
                const f32x4 b0 = *(const LAS f32x4*)(G + ot), b1 = *(const LAS f32x4*)(G + ot + 4), c0v = *(const LAS f32x4*)(G + om), c1v = *(const LAS f32x4*)(G + om + 4);
                float sum = 0.f;
#pragma unroll
                for (int i = 0; i < 4; ++i) { sum += q0[i] * k0[i] * __expf(b0[i] - c0v[i]); sum += q1[i] * k1[i] * __expf(b1[i] - c1v[i]); }
                sum += row_ror<1>(sum); sum += row_ror<2>(sum); sum += row_ror<4>(sum); sum += row_ror<8>(sum);
                if (kc == 0) attS[(blk * 16 + pt[pp]) * 40 + pm[pp]] = (bf16_t)f2bf(sum);
            }
#pragma unroll
            for (int vt = 0; vt < 8; ++vt) { u32x2 w; w.x = pk2(acc[vt][0], acc[vt][1]); w.y = pk2(acc[vt][2], acc[vt][3]); *(LAS u32x2*)(S0T + (vt * 16 + l15) * 136 + wave * 16 + quad * 4) = w; }
            __syncthreads();
            {
                f32x4 C = (f32x4){0.f, 0.f, 0.f, 0.f};
#pragma unroll
                for (int sl = 0; sl < 4; ++sl) { const bf16x8 a = *(const LAS bf16x8*)(QcS + (blk * 16 + l15) * 136 + sl * 32 + quad * 8); const bf16x8 bq = *(const LAS bf16x8*)(S0T + (wave * 16 + l15) * 136 + sl * 32 + quad * 8);
                    C = __builtin_amdgcn_mfma_f32_16x16x32_bf16(a, bq, C, 0, 0, 0); }
                const bf16x8 a2 = *(const LAS bf16x8*)(attS + (blk * 16 + l15) * 40 + quad * 8); const bf16x8 b2 = *(const LAS bf16x8*)(Vt + (wave * 16 + l15) * 56 + blk * 16 + quad * 8);
                C = __builtin_amdgcn_mfma_f32_16x16x32_bf16(a2, b2, C, 0, 0, 0);
#pragma unroll
                for (int r = 0; r < 4; ++r) Os[(quad * 4 + r) * 128 + wave * 16 + l15] = C[r];
            }
            {
                const f32x4 d4 = *(const LAS f32x4*)(Ds + blk * 128 + wave * 16 + quad * 4);
                const bf16x8 a3 = *(const LAS bf16x8*)(KdTS + (blk * 128 + wave * 16 + l15) * 40 + quad * 8);
#pragma unroll
                for (int vt = 0; vt < 8; ++vt) { acc[vt] = acc[vt] * d4; const bf16x8 b3 = *(const LAS bf16x8*)(Vt + (vt * 16 + l15) * 56 + blk * 16 + quad * 8);
                    acc[vt] = __builtin_amdgcn_mfma_f32_16x16x32_bf16(a3, b3, acc[vt], 0, 0, 0); }
            }
            __syncthreads();
            {
                const f32x4 o4 = *(const LAS f32x4*)(Os + ptk * 128 + pv4);
                float ss = (o4[0] * o4[0] + o4[1] * o4[1]) + (o4[2] * o4[2] + o4[3] * o4[3]);
                ss += __shfl_xor(ss, 1); ss += __shfl_xor(ss, 2); ss += __shfl_xor(ss, 4); ss += __shfl_xor(ss, 8); ss += __shfl_xor(ss, 16);
                const float rstd = rsqrtf(ss * (1.f / 128.f) + EPS);
                bf16_t* gp = PB + (rowbase + c0 + blk * 16 + ptk) * LDB_ + 3072 + h * 128 + pv4;
                const u32x2 gw = NBLK == 1 ? r_hg[0] : (blk == 0 ? r_hg[0] : r_hg[NBLK - 1]);
                const float y0 = o4[0] * rstd * gn4[0] * siluf(bf2f(gw.x & 0xffffu)), y1 = o4[1] * rstd * gn4[1] * siluf(bf2f(gw.x >> 16)), y2 = o4[2] * rstd * gn4[2] * siluf(bf2f(gw.y & 0xffffu)), y3 = o4[3] * rstd * gn4[3] * siluf(bf2f(gw.y >> 16));
                u32x2 w; w.x = pk2(y0, y1); w.y = pk2(y2, y3);
                if (!dry) *(u32x2*)gp = w;
            }
        }
    }
    if (Sout) {
#pragma unroll
        for (int vt = 0; vt < 8; ++vt)
#pragma unroll
            for (int r = 0; r < 4; ++r) Sout[(size_t)(wave * 16 + quad * 4 + r) * 128 + vt * 16 + l15] = acc[vt][r];
    }
    __syncthreads();
}
__device__ __forceinline__ void ph_hgrn3(const Params& p, int l, LAS unsigned char* lds, bool dry) {
    float* Sb = (float*)(p.ws + OFF_S);
    constexpr int NPI = NB * 8 * NSEG, NSI = DB * 8;
    for (int it = blockIdx.x; it < NPI + NSI; it += gridDim.x) {
        if (it < NPI) { const int seg = it & (NSEG - 1), bh = it >> 4, b = bh >> 3, h = bh & 7;
            float* so = seg == NSEG - 1 ? p.out + O_NHP + (((size_t)l * NB + b) * 8 + h) * 16384 : nullptr;
            hgrn3_item_mfma<false>(p, l, lds, (long)b * SEQ + seg * SEGT, h, Sb + ((size_t)bh * NSEG + seg) * 16384, so, dry); }
        else { const int r = it - NPI, b = r >> 3, h = r & 7;
            hgrn3_item_mfma<true>(p, l, lds, (long)MP + b * DSQ, h, p.in[I_SH] + (((size_t)l * DB + b) * 8 + h) * 16384, p.out + O_NHS + (((size_t)l * DB + b) * 8 + h) * 16384, dry); }
    }
}

__device__ __forceinline__ void ph_conv(const Params& p, int l) {
    bf16_t* PC = (bf16_t*)(p.ws + OFF_P); bf16_t* XC = (bf16_t*)(p.ws + OFF_MG);
    const float* cw = p.in[I_CW] + (size_t)l * 4 * 1024; const float* cb = p.in[I_CB] + (size_t)l * 1024;
    const int nth = (gridDim.x * 512) & ~127;
    const int tid0 = blockIdx.x * 512 + tid_opaque(), c8 = (tid0 & 127) * 8;
    float wv[4][8], bv[8];
#pragma unroll
    for (int jj = 0; jj < 4; ++jj) { const f32x4 w0 = *(const f32x4*)(cw + jj * 1024 + c8), w1 = *(const f32x4*)(cw + jj * 1024 + c8 + 4);
#pragma unroll
        for (int i = 0; i < 4; ++i) { wv[jj][i] = w0[i]; wv[jj][4 + i] = w1[i]; } }
    { const f32x4 b0 = *(const f32x4*)(cb + c8), b1 = *(const f32x4*)(cb + c8 + 4);
#pragma unroll
      for (int i = 0; i < 4; ++i) { bv[i] = b0[i]; bv[4 + i] = b1[i]; } }
    if (tid0 < nth)
    for (int idx = tid0; idx < MT * 128; idx += nth) {
        const int row = idx >> 7;
        int t, bb;
        if (row < MP) { bb = row >> 12; t = row & 4095; } else { const int r = row - MP; bb = r >> 4; t = r & 15; }
        float acc[8];
#pragma unroll
        for (int i = 0; i < 8; ++i) acc[i] = bv[i];
        float xv[8];
#pragma unroll
        for (int jj = 0; jj < 4; ++jj) {
            const int ti = t - 3 + jj; bool have = true;
            if (ti >= 0) unpack8(*(const u32x4*)(PC + (size_t)(row - 3 + jj) * LDC_ + c8), xv);
            else if (row >= MP) { const float* sc = p.in[I_SC] + (((size_t)l * DB + bb) * 3 + (3 + ti)) * 1024 + c8; const f32x4 a0 = *(const f32x4*)sc, a1 = *(const f32x4*)(sc + 4);
#pragma unroll
                for (int i = 0; i < 4; ++i) { xv[i] = a0[i]; xv[4 + i] = a1[i]; } }
            else have = false;
            if (have) {
#pragma unroll
                for (int i = 0; i < 8; ++i) acc[i] += xv[i] * wv[jj][i]; }
        }
        *(u32x4*)(XC + (size_t)row * DM + c8) = pack8(acc);
        if (row < MP) { if (t >= SEQ - 3) { float* o = p.out + O_NCP + (((size_t)l * NB + bb) * 3 + (t - (SEQ - 3))) * 1024 + c8;
#pragma unroll
                for (int i = 0; i < 8; ++i) o[i] = xv[i]; } }
        else if (t >= DSQ - 3) { float* o = p.out + O_NCS + (((size_t)l * DB + bb) * 3 + (t - (DSQ - 3))) * 1024 + c8;
#pragma unroll
            for (int i = 0; i < 8; ++i) o[i] = xv[i]; }
    }
}
struct LruConst { float ba[4], bx[4], sp[4], w0[4], w1[4], w2[4], w3[4], cbv[4]; };
__device__ __forceinline__ void unpack4(u32x2 r, float (&o)[4]) { o[0] = bf2f(r.x & 0xffffu); o[1] = bf2f(r.x >> 16); o[2] = bf2f(r.y & 0xffffu); o[3] = bf2f(r.y >> 16); }
template <int SWEEP>
__device__ __forceinline__ void lru_scan_item(const Params& p, int l, LAS unsigned char* lds, int it, bool dry, const LruConst& K, int tid) {
    const int chl = tid & 63, sub = tid >> 6;
    bf16_t* PC = (bf16_t*)(p.ws + OFF_P);
    float* SUB = (float*)(p.ws + OFF_S); float* SEGB = SUB + (size_t)NB * 256 * 1024 * 2;
    const bool samp = it >= 512;
    int cg, seg = 0, b = 0, bb = 0; size_t row0;
    if (!samp) { cg = it & 3; seg = (it >> 2) & 31; b = it >> 7; row0 = (size_t)b * SEQ + seg * 128 + sub * 16; }
    else { const int r = it - 512; cg = r & 3; bb = (r >> 2) * 8 + sub; row0 = (size_t)MP + bb * DSQ; }
    const int ch = cg * 256 + chl * 4;
    float x1[4], x2[4], x3[4];
    if (SWEEP == 1) {
        if (!samp) { const int t0 = seg * 128 + sub * 16; const bf16_t* q = PC + row0 * LDC_ + ch;
            const u32x2 z = (u32x2){0u, 0u};
            unpack4(t0 >= 1 ? *(const u32x2*)(q - (size_t)LDC_) : z, x1); unpack4(t0 >= 2 ? *(const u32x2*)(q - (size_t)2 * LDC_) : z, x2); unpack4(t0 >= 3 ? *(const u32x2*)(q - (size_t)3 * LDC_) : z, x3); }
        else { const float* sc = p.in[I_SC] + ((size_t)l * DB + bb) * 3 * 1024 + ch; const f32x4 a1 = *(const f32x4*)(sc + 2048), a2 = *(const f32x4*)(sc + 1024), a3 = *(const f32x4*)sc;
#pragma unroll
            for (int i = 0; i < 4; ++i) { x1[i] = a1[i]; x2[i] = a2[i]; x3[i] = a3[i]; } }
    }
    float h[4] = {0.f, 0.f, 0.f, 0.f}, A[4] = {1.f, 1.f, 1.f, 1.f}, B[4] = {0.f, 0.f, 0.f, 0.f};
    if (SWEEP == 2) {
        if (!samp) {
            f32x4 su[8][2];
#pragma unroll
            for (int u = 0; u < 8; ++u) { su[u][0] = (f32x4){1.f, 0.f, 1.f, 0.f}; su[u][1] = su[u][0];
                if (u < sub) { const f32x4* q = (const f32x4*)(SUB + (((size_t)b * 256 + seg * 8 + u) * 1024 + ch) * 2); su[u][0] = q[0]; su[u][1] = q[1]; } }
#pragma unroll 1
            for (int hf = 0; hf * 4 < seg; ++hf) { f32x4 sg[4][2];
#pragma unroll
                for (int i = 0; i < 4; ++i) { const int sgi = hf * 4 + i; sg[i][0] = (f32x4){1.f, 0.f, 1.f, 0.f}; sg[i][1] = sg[i][0];
                    if (sgi < seg) { const f32x4* q = (const f32x4*)(SEGB + (((size_t)b * 32 + sgi) * 1024 + ch) * 2); sg[i][0] = q[0]; sg[i][1] = q[1]; } }
#pragma unroll
                for (int i = 0; i < 4; ++i) { h[0] = sg[i][0][0] * h[0] + sg[i][0][1]; h[1] = sg[i][0][2] * h[1] + sg[i][0][3]; h[2] = sg[i][1][0] * h[2] + sg[i][1][1]; h[3] = sg[i][1][2] * h[3] + sg[i][1][3]; } }
#pragma unroll
            for (int u = 0; u < 8; ++u) { h[0] = su[u][0][0] * h[0] + su[u][0][1]; h[1] = su[u][0][2] * h[1] + su[u][0][3]; h[2] = su[u][1][0] * h[2] + su[u][1][1]; h[3] = su[u][1][2] * h[3] + su[u][1][3]; }
        } else { const f32x4 h0 = *(const f32x4*)(p.in[I_SL] + ((size_t)l * DB + bb) * 1024 + ch);
#pragma unroll
            for (int i = 0; i < 4; ++i) h[i] = h0[i]; }
    }
    if (SWEEP == 1) {
#pragma unroll 8
        for (int t = 0; t < 16; ++t) {
            bf16_t* q = PC + (row0 + t) * LDC_ + ch;
            float x0[4], rp[4], ip[4]; unpack4(*(const u32x2*)q, x0); unpack4(*(const u32x2*)(q + 3072), rp); unpack4(*(const u32x2*)(q + 4096), ip);
            unsigned oa[4], ob[4];
#pragma unroll
            for (int i = 0; i < 4; ++i) {
                const float xc = K.cbv[i] + K.w3[i] * x0[i] + K.w2[i] * x1[i] + K.w1[i] * x2[i] + K.w0[i] * x3[i];
                x3[i] = x2[i]; x2[i] = x1[i]; x1[i] = x0[i];
                const float r = sigm(rp[i] + K.ba[i]), ig = sigm(ip[i] + K.bx[i]);
                const float la = -8.f * r * K.sp[i], a = __expf(la), x = 2.f * la;
                const float ser = -x * (1.f + x * (0.5f + x * (0.16666667f + x * (0.041666668f + x * 0.008333334f))));
                const float om = x > -0.3f ? ser : 1.f - a * a;
                const float bc = sqrtf(om) * (ig * xc);
                const float lser = -la * (1.f + la * (0.5f + la * (0.16666667f + la * (0.041666668f + la * 0.008333334f))));
                oa[i] = f2bf(la > -0.3f ? lser : 1.f - a); ob[i] = f2bf(bc);
                const float ar = 1.f - bf2f(oa[i]), br = bf2f(ob[i]);
                A[i] *= ar; B[i] = ar * B[i] + br;
            }
            u32x2 wa; wa.x = oa[0] | (oa[1] << 16); wa.y = oa[2] | (oa[3] << 16); u32x2 wb; wb.x = ob[0] | (ob[1] << 16); wb.y = ob[2] | (ob[3] << 16);
            *(u32x2*)(q + 3072) = wa; *(u32x2*)(q + 4096) = wb;
        }
    } else {
#pragma unroll 8
        for (int t = 0; t < 16; ++t) {
            bf16_t* q = PC + (row0 + t) * LDC_ + ch;
            float oa[4], ob[4], lg[4]; unpack4(*(const u32x2*)(q + 3072), oa); unpack4(*(const u32x2*)(q + 4096), ob); unpack4(*(const u32x2*)(q + 1024), lg);
            float yv[4];
#pragma unroll
            for (int i = 0; i < 4; ++i) { h[i] = (1.f - oa[i]) * h[i] + ob[i]; yv[i] = h[i] * gelu_tanh(lg[i]); }
            u32x2 w; w.x = pk2(yv[0], yv[1]); w.y = pk2(yv[2], yv[3]);
            if (!dry) *(u32x2*)(q + 1024) = w;
        }
    }
    if (SWEEP == 1 && !samp) {
        f32x4* qs = (f32x4*)(SUB + (((size_t)b * 256 + seg * 8 + sub) * 1024 + ch) * 2);
        qs[0] = (f32x4){A[0], B[0], A[1], B[1]}; qs[1] = (f32x4){A[2], B[2], A[3], B[3]};
        LAS f32x4* ex = (LAS f32x4*)lds;
        ex[(sub * 64 + chl) * 2] = (f32x4){A[0], B[0], A[1], B[1]}; ex[(sub * 64 + chl) * 2 + 1] = (f32x4){A[2], B[2], A[3], B[3]};
        __syncthreads();
        if (sub == 0) { float a[4] = {1.f, 1.f, 1.f, 1.f}, bs[4] = {0.f, 0.f, 0.f, 0.f};
#pragma unroll
            for (int u = 0; u < 8; ++u) { const f32x4 e0 = ex[(u * 64 + chl) * 2], e1 = ex[(u * 64 + chl) * 2 + 1];
                a[0] *= e0[0]; bs[0] = e0[0] * bs[0] + e0[1]; a[1] *= e0[2]; bs[1] = e0[2] * bs[1] + e0[3]; a[2] *= e1[0]; bs[2] = e1[0] * bs[2] + e1[1]; a[3] *= e1[2]; bs[3] = e1[2] * bs[3] + e1[3]; }
            f32x4* qg = (f32x4*)(SEGB + (((size_t)b * 32 + seg) * 1024 + ch) * 2);
            qg[0] = (f32x4){a[0], bs[0], a[1], bs[1]}; qg[1] = (f32x4){a[2], bs[2], a[3], bs[3]}; }
        __syncthreads();
    } else if (SWEEP == 2) {
        if (!samp) { if (seg == 31 && sub == 7) *(f32x4*)(p.out + O_NLP + ((size_t)l * NB + b) * 1024 + ch) = (f32x4){h[0], h[1], h[2], h[3]}; }
        else *(f32x4*)(p.out + O_NLS + ((size_t)l * DB + bb) * 1024 + ch) = (f32x4){h[0], h[1], h[2], h[3]};
    }
}
template <int SWEEP>
__device__ __forceinline__ void ph_lru_scan(const Params& p, int l, LAS unsigned char* lds, bool dry) {
    constexpr int NI = 512 + 16;
    const int tid = tid_opaque(), ch = (blockIdx.x & 3) * 256 + (tid & 63) * 4;
    LruConst K;
#pragma unroll
    for (int i = 0; i < 4; ++i) { K.ba[i] = p.in[I_LBA][l * 1024 + ch + i]; K.bx[i] = p.in[I_LBX][l * 1024 + ch + i]; K.sp[i] = log1pf(expf(-p.in[I_LAM][l * 1024 + ch + i]));
        const float* cw = p.in[I_CW] + (size_t)l * 4 * 1024 + ch + i; K.w0[i] = cw[0]; K.w1[i] = cw[1024]; K.w2[i] = cw[2048]; K.w3[i] = cw[3072]; K.cbv[i] = p.in[I_CB][l * 1024 + ch + i]; }
    const int G4 = (int)gridDim.x & ~3;
    if ((int)blockIdx.x < G4) for (int it = blockIdx.x; it < NI; it += G4) lru_scan_item<SWEEP>(p, l, lds, it, dry, K, tid);
}

#define XB_TMO      128
#define XB_XCNT(j)  (256  + 64 * (j))
#define XB_XSUB(j)  (1280 + 64 * (j))
#define XB_XGEN(j)  (2304 + 64 * (j))
#define XB_TOP      3328
#define XB_TOPGEN   3392
#define XCD_BAR_WORDS 3456
#define XB_SPIN_CAP (1u << 18)
__device__ __forceinline__ unsigned xb_ld(unsigned* p)              { return __hip_atomic_load(p, __ATOMIC_RELAXED, __HIP_MEMORY_SCOPE_AGENT); }
__device__ __forceinline__ unsigned xb_add(unsigned* p, unsigned v) { return __hip_atomic_fetch_add(p, v, __ATOMIC_RELAXED, __HIP_MEMORY_SCOPE_AGENT); }
__device__ __forceinline__ unsigned xb_xcc_id() { return (unsigned)__builtin_amdgcn_s_getreg((3 << 11) | 20) & 0xFu; }
#define XB_SPIN(cond, bar) do { unsigned _sp = 0; while (cond) { __builtin_amdgcn_s_sleep(1); \
    if ((++_sp & 255u) == 0u) { if (xb_ld(&(bar)[XB_TMO])) break; if (_sp > XB_SPIN_CAP) { atomicAdd(&(bar)[XB_TMO], 1u); break; } } } } while (0)
struct XcdBarrier { unsigned* bar; unsigned x; volatile LAS unsigned* st; };
__device__ __forceinline__ XcdBarrier xcd_barrier_post(unsigned* bar, volatile LAS unsigned* st) {
    XcdBarrier b; b.bar = bar; b.x = xb_xcc_id(); b.st = st;
    if (threadIdx.x == 0) (void)xb_add(&bar[XB_XCNT(b.x)], 1u);
    return b;
}
__device__ __forceinline__ void xcd_barrier_complete(unsigned* bar, unsigned x, unsigned& nloc, unsigned& nx) {
    const unsigned G = gridDim.x * gridDim.y * gridDim.z;
    unsigned sum, cnt, mine, sp = 0u;
    for (;;) {
        sum = 0u; cnt = 0u; mine = 0u;
#pragma unroll
        for (unsigned j = 0; j < 16; ++j) { const unsigned c = xb_ld(&bar[XB_XCNT(j)]); sum += c; cnt += (c > 0u) ? 1u : 0u; mine = (j == x) ? c : mine; }
        if (sum == G) break;
        __builtin_amdgcn_s_sleep(1);
        if ((++sp & 255u) == 0u) { if (xb_ld(&bar[XB_TMO])) break; if (sp > XB_SPIN_CAP) { atomicAdd(&bar[XB_TMO], 1u); break; } }
    }
    nloc = mine > 0u ? mine : 1u; nx = cnt > 0u ? cnt : 1u;
}
__device__ __forceinline__ void xcd_barrier(const XcdBarrier& b) {
    asm volatile("s_waitcnt vmcnt(0)" ::: "memory");
    __syncthreads();
    if (threadIdx.x == 0) {
        unsigned* bar = b.bar;
        __builtin_amdgcn_s_waitcnt(0);
        unsigned nloc = b.st[0], nx = b.st[1];
        if (nloc == 0u) { xcd_barrier_complete(bar, b.x, nloc, nx); b.st[0] = nloc; b.st[1] = nx; }
        const unsigned old = xb_add(&bar[XB_XSUB(b.x)], 1u);
        const unsigned gen = old / nloc;
        if (old + 1u == (gen + 1u) * nloc) {
            __builtin_amdgcn_fence(__ATOMIC_RELEASE, "agent");
            asm volatile("s_waitcnt vmcnt(0)" ::: "memory");
            const unsigned og = xb_add(&bar[XB_TOP], 1u);
            const unsigned tg = og / nx;
            if (og + 1u == (tg + 1u) * nx) xb_add(&bar[XB_TOPGEN], 1u);
            else XB_SPIN(xb_ld(&bar[XB_TOPGEN]) == tg, bar);
            __builtin_amdgcn_fence(__ATOMIC_ACQUIRE, "agent");
            xb_add(&bar[XB_XGEN(b.x)], 1u);
            asm volatile("s_waitcnt vmcnt(0)" ::: "memory");
        } else {
            XB_SPIN(xb_ld(&bar[XB_XGEN(b.x)]) == gen, bar);
            __builtin_amdgcn_fence(__ATOMIC_ACQUIRE, "agent");
            asm volatile("s_waitcnt vmcnt(0)" ::: "memory");
        }
    }
    __syncthreads();
}

constexpr int NPL = 22, NPH = DEPTH * NPL + 1;
template <int K>
__device__ __forceinline__ void run_phase(const Params& p, int l, LAS unsigned char* lds, bool dry) {
    bf16_t* Wb = (bf16_t*)(p.ws + OFF_W); bf16_t* H = (bf16_t*)(p.ws + OFF_H); bf16_t* MG = (bf16_t*)(p.ws + OFF_MG); bf16_t* P = (bf16_t*)(p.ws + OFF_P);
    float* X = p.out;
    if constexpr (K == 0) { ph_convert(p, l, lds); ph_norm(p, p.in[I_NF1] + l * DM, l == 0, 11); }
    else if constexpr (K == 1) { EpiSwiGLU e; e.G = P; run_gemm(lds, H, DM, Wb + W_UP1, 2 * DFF, DM, e); }
    else if constexpr (K == 2) run_gemm_resid(lds, P, DFF, Wb + W_DN1, DFF, X, 0.5f, (float*)(p.ws + OFF_S));
    else if constexpr (K == 3) ph_norm(p, p.in[I_NMIX] + l * DM, false, 11);
    else if constexpr (K == 4) { EpiStore e; e.O = P; e.ldc = LDC_; run_gemm(lds, H, DM, Wb + W_IN + (size_t)2560 * 1024, 3072, DM, e); }
    else if constexpr (K == 5) ph_conv(p, l);
    else if constexpr (K == 6) { EpiStoreLru e; e.O = P; e.ldc = LDC_; run_gemm_lru(lds, MG, Wb + W_LRU, e); }
    else if constexpr (K == 7) ph_lru_scan<1>(p, l, lds, false);
    else if constexpr (K == 8) ph_lru_scan<2>(p, l, lds, dry);
    else if constexpr (K == 9) { EpiGate e; e.MG = MG; e.gate = P + 2048; e.ldg = LDC_; e.accum = 0; run_gemm(lds, P + 1024, LDC_, Wb + W_LO, DM, DM, e); }
    else if constexpr (K == 10) { EpiStore e; e.O = P; e.ldc = LDA_; run_gemm(lds, H, DM, Wb + W_IN, 2560, DM, e); }
    else if constexpr (K == 11) ph_attn(p, l, lds, dry);
    else if constexpr (K == 12) { EpiGate e; e.MG = MG; e.gate = P + 1536; e.ldg = LDA_; e.accum = 1; run_gemm(lds, P, LDA_, Wb + W_AO, DM, DM, e); }
    else if constexpr (K == 13) { EpiStore e; e.O = P; e.ldc = LDB_; run_gemm(lds, H, DM, Wb + W_IN + (size_t)5632 * 1024, 5120, DM, e, MP); }
    else if constexpr (K == 14) {
        if ((int)gridDim.x >= 64) { pg8::TailOrder S; S.c = (int)blockIdx.x - ((int)gridDim.x - 40);
            if (S.c >= 0) { EpiStore e; e.O = P; e.ldc = LDB_; pg8::Gemm g; g.A = H; g.Bt = Wb + W_IN + (size_t)5632 * 1024; g.M = MT; g.N = 5120; g.K = DM; g.lda = DM; g.ldb = DM;
                pg8::gemm_phase<EpiStore, pg8::TailOrder>(lds, g, S, e); } }
        else { EpiStore e; e.O = P; e.ldc = LDB_; pg8::Gemm g; g.A = H + (size_t)MP * DM; g.Bt = Wb + W_IN + (size_t)5632 * 1024; g.M = MS; g.N = 5120; g.K = DM; g.lda = DM; g.ldb = DM;
            EpiStore e2 = e; e2.O = P + (size_t)MP * LDB_; pg8::StaticOrder S; S.init(MS, 5120, (int)gridDim.x, (int)blockIdx.x); pg8::gemm_phase<EpiStore, pg8::StaticOrder>(lds, g, S, e2); }
        ph_hgrn1(p, l, lds); }
    else if constexpr (K == 15) ph_hgrn2(p);
    else if constexpr (K == 16) ph_hgrn3(p, l, lds, dry);
    else if constexpr (K == 17) { EpiGate e; e.MG = MG; e.gate = P + 4096; e.ldg = LDB_; e.accum = 1; run_gemm(lds, P + 3072, LDB_, Wb + W_HO, DM, DM, e); }
    else if constexpr (K == 18) run_gemm_resid(lds, MG, DM, Wb + W_OUT, DM, X, 1.f, (float*)(p.ws + OFF_S));
    else if constexpr (K == 19) ph_norm(p, p.in[I_NF2] + l * DM, false, 4);
    else if constexpr (K == 20) { EpiSwiGLU e; e.G = P; run_gemm(lds, H, DM, Wb + W_UP2, 2 * DFF, DM, e); }
    else if constexpr (K == 21) run_gemm_resid(lds, P, DFF, Wb + W_DN2, DFF, X, 0.5f, (float*)(p.ws + OFF_S));
    else {
        const float* part = (const float*)(p.ws + OFF_S);
        for (int i = blockIdx.x * 512 + tid_opaque(); i < MS * DM / 4; i += gridDim.x * 512) { f32x4 v = ((f32x4*)(X + (size_t)MP * DM))[i];
            for (int c = 0; c < 11; ++c) v += ((const f32x4*)(part + (size_t)c * MS * DM))[i];
            ((f32x4*)(X + (size_t)MP * DM))[i] = v; }
    }
}

__global__ void __launch_bounds__(512, 2) mega(Params p, int ph_lo, int ph_hi) {
    extern __shared__ __attribute__((aligned(16))) unsigned char shm[];
    LAS unsigned char* lds = (LAS unsigned char*)shm;
    cg::grid_group grid = cg::this_grid();
    volatile LAS unsigned* st = (volatile LAS unsigned*)(lds + LDS_MAIN);
    if (threadIdx.x < 4) st[threadIdx.x] = 0u;
    __syncthreads();
    const XcdBarrier xb = xcd_barrier_post(p.bar, st);
    if (ph_hi < 0) grid.sync();
#define SEAM(ph) { xcd_barrier(xb); }
#define PHASE(L, K) { constexpr int ph = (L) * NPL + (K); if (ph >= ph_lo && ph < ph_hi) { if constexpr ((DUP_MASK >> (K)) & 1) { run_phase<K>(p, L, lds, p.one != 0); SEAM(1) } run_phase<K>(p, L, lds, false); if (ph + 1 < ph_hi) SEAM(ph) } }
#define LAYER(L) PHASE(L, 0) PHASE(L, 1) PHASE(L, 2) PHASE(L, 3) PHASE(L, 4) PHASE(L, 5) PHASE(L, 6) PHASE(L, 7) PHASE(L, 8) PHASE(L, 9) \
    PHASE(L, 10) PHASE(L, 11) PHASE(L, 12) PHASE(L, 13) PHASE(L, 14) PHASE(L, 15) PHASE(L, 16) PHASE(L, 17) PHASE(L, 18) PHASE(L, 19) PHASE(L, 20) PHASE(L, 21)
    LAYER(0)
    LAYER(1)
    PHASE(1, 22)
#undef LAYER
#undef PHASE
}

extern "C" void kernel_launch(void* const* d_in, const int* in_sizes, int n_in, void* d_out, int out_size, void* d_ws, size_t ws_size, hipStream_t stream) {
    static int grid = 0;
    if (grid == 0) {
        if (n_in != 31 || ws_size < WS_NEED) { fprintf(stderr, "kernel_launch: unexpected n_in %d or ws %zu < %zu\n", n_in, ws_size, (size_t)WS_END); grid = -1; return; }
        int dev = 0, cus = 0, per_cu = 0;
        (void)hipGetDevice(&dev); (void)hipDeviceGetAttribute(&cus, hipDeviceAttributeMultiprocessorCount, dev);
        if (hipFuncSetAttribute((const void*)mega, hipFuncAttributeMaxDynamicSharedMemorySize, LDS_BYTES) != hipSuccess) { fprintf(stderr, "hipFuncSetAttribute failed\n"); grid = -1; return; }
        if (hipOccupancyMaxActiveBlocksPerMultiprocessor(&per_cu, (const void*)mega, 512, LDS_BYTES) != hipSuccess || per_cu < 1) { fprintf(stderr, "occupancy query: %d\n", per_cu); per_cu = 1; }
        (void)hipGetLastError();
        grid = cus * 1;
    }
    if (grid < 0) return;
    Params p{};
    for (int i = 0; i < 31; ++i) p.in[i] = (const float*)d_in[i];
    p.out = (float*)d_out; p.ws = (unsigned char*)d_ws; p.one = 1; p.bar = (unsigned*)((unsigned char*)d_ws + OFF_BAR);
    (void)hipMemsetAsync((unsigned char*)d_ws + OFF_BAR, 0, 3456 * 4, stream);
#if ONE_LAUNCH
    int lo = 0, hi = NPH;
    void* args[] = {&p, &lo, &hi};
    hipError_t e = hipLaunchCooperativeKernel((const void*)mega, dim3(grid), dim3(512), args, LDS_BYTES, stream);
    if (e != hipSuccess) fprintf(stderr, "cooperative launch failed: %s (grid %d)\n", hipGetErrorString(e), grid);
#else
    for (int ph = 0; ph < NPH; ++ph) mega<<<dim3(grid), dim3(512), LDS_BYTES, stream>>>(p, ph, ph + 1);
#endif
}
```

```cpp
#include <hip/hip_runtime.h>
#include <hip/hip_cooperative_groups.h>
#include <cstdio>
#include <cstdint>
namespace cg = cooperative_groups;

#ifndef ONE_LAUNCH
#define ONE_LAUNCH 1
#endif

#ifndef DUP_MASK
#define DUP_MASK 0
#endif
#define LAS __attribute__((address_space(3)))
typedef unsigned short bf16_t;
typedef short bf16x8 __attribute__((ext_vector_type(8)));
typedef short bf16x4 __attribute__((ext_vector_type(4)));
typedef float f32x4 __attribute__((ext_vector_type(4)));
typedef unsigned u32x4 __attribute__((ext_vector_type(4)));
typedef unsigned u32x2 __attribute__((ext_vector_type(2)));

constexpr int DM = 1024, NB = 4, SEQ = 4096, DEPTH = 2, DB = 32, DSQ = 16, DFF = 2816;
constexpr int MP = NB * SEQ, MS = DB * DSQ, MT = MP + MS;
constexpr int INC = 10752;
constexpr int LDA_ = 2560, LDC_ = 5120, LDB_ = 5120;
constexpr float EPS = 1e-6f;
constexpr int NSEG = 16, SEGT = 256;

constexpr size_t W_UP1 = 0, W_DN1 = W_UP1 + (size_t)5632 * 1024, W_IN = W_DN1 + (size_t)1024 * 2816, W_AO = W_IN + (size_t)INC * 1024,
                 W_HO = W_AO + 1048576, W_LO = W_HO + 1048576, W_OUT = W_LO + 1048576, W_UP2 = W_OUT + 1048576, W_DN2 = W_UP2 + (size_t)5632 * 1024,
                 W_LRU = W_DN2 + (size_t)1024 * 2816, W_END = W_LRU + (size_t)2048 * 256;
constexpr size_t OFF_W = 0, OFF_H = OFF_W + W_END * 2, OFF_MG = OFF_H + (size_t)MT * 1024 * 2, OFF_P = OFF_MG + (size_t)MT * 1024 * 2,
                 OFF_S = OFF_P + (size_t)MT * 5120 * 2, OFF_D = OFF_S + (size_t)NB * 8 * NSEG * 16384 * 4, WS_END = OFF_D + (size_t)NB * 8 * NSEG * 128 * 4;
constexpr size_t O_NKP = 17301504, O_NVP = 17563648, O_NHP = 17825792, O_NCP = 18874368, O_NLP = 18898944, O_NKS = 18907136, O_NVS = 19169280,
                 O_NHS = 19431424, O_NCS = 27820032, O_NLS = 28016640;

constexpr int LDS_MAIN = 156416, LDS_BYTES = LDS_MAIN + 16;
constexpr size_t OFF_BAR = (WS_END + 255) / 256 * 256, WS_NEED = OFF_BAR + 3456 * 4;

struct Params { const float* in[31]; float* out; unsigned char* ws; unsigned* bar; long one; };
enum { I_XP = 0, I_XS, I_CK, I_CV, I_SH, I_SC, I_SL, I_NF1, I_UP1, I_DN1, I_NMIX, I_WIN, I_QN, I_KN, I_SINK, I_WAO, I_LBL, I_HON, I_WHO, I_CW, I_CB,
       I_LWA, I_LBA, I_LWX, I_LBX, I_LAM, I_WLO, I_WOUT, I_NF2, I_UP2, I_DN2 };

__device__ __forceinline__ float bf2f(unsigned v) { return __uint_as_float(v << 16); }
__device__ __forceinline__ unsigned f2bf(float f) { unsigned u = __float_as_uint(f); u += 0x7FFFu + ((u >> 16) & 1u); return u >> 16; }
__device__ __forceinline__ unsigned pk2(float lo, float hi) { return f2bf(lo) | (f2bf(hi) << 16); }
__device__ __forceinline__ float sigm(float x) { return 1.f / (1.f + __expf(-x)); }
__device__ __forceinline__ float siluf(float x) { return x / (1.f + __expf(-x)); }
__device__ __forceinline__ float gelu_tanh(float x) { const float u = 0.7978845608028654f * (x + 0.044715f * x * x * x); const float e = __expf(2.f * u); const float th = 1.f - 2.f / (e + 1.f); return 0.5f * x * (1.f + th); }
__device__ __forceinline__ void unpack8(u32x4 r, float (&o)[8]) {
    o[0] = bf2f(r.x & 0xffffu); o[1] = bf2f(r.x >> 16); o[2] = bf2f(r.y & 0xffffu); o[3] = bf2f(r.y >> 16);
    o[4] = bf2f(r.z & 0xffffu); o[5] = bf2f(r.z >> 16); o[6] = bf2f(r.w & 0xffffu); o[7] = bf2f(r.w >> 16);
}
__device__ __forceinline__ u32x4 pack8(const float (&v)[8]) { u32x4 r; r.x = pk2(v[0], v[1]); r.y = pk2(v[2], v[3]); r.z = pk2(v[4], v[5]); r.w = pk2(v[6], v[7]); return r; }
__device__ __forceinline__ int tid_opaque() { int t = (int)__builtin_amdgcn_workitem_id_x(); asm volatile("" : "+v"(t)); return t; }
typedef float f32x2 __attribute__((ext_vector_type(2)));
template <int N> __device__ __forceinline__ float row_ror(float x) { return __builtin_bit_cast(float, __builtin_amdgcn_update_dpp(0, __builtin_bit_cast(int, x), 0x120 + N, 0xf, 0xf, false)); }
#define LDS_WAIT() asm volatile("s_waitcnt lgkmcnt(0)" ::: "memory")

namespace pg8 {
constexpr int BM = 256, BK = 64, HALF = 128, HTB = HALF * BK * 2, STAGE_BYTES = 8 * HTB, NXCD = 8, WGM = 8;
__device__ __forceinline__ int lds_byte(int r, int c) { const int st = (r >> 4) * 2 + (c >> 5), rr = r & 15, cc = c & 31, ob = rr * 64 + cc * 2; return st * 1024 + (ob ^ (((ob >> 9) & 1) << 5)); }
__device__ __forceinline__ void stage_rc(int b, int& R, int& C) { const int st = b / 1024, sb = b % 1024, swz = sb ^ (((sb >> 9) & 1) << 5); R = (st >> 1) * 16 + swz / 64; C = (st & 1) * 32 + (swz % 64) / 2; }
struct Unit { int pm, pn, aoff, boff; };
struct Gemm { const bf16_t* A; const bf16_t* Bt; int M, N, K, lda, ldb; };
struct StaticOrder {
    int nM, nN, nwg, G, c;
    __device__ void init(int M, int N, int G_, int c_) { nM = M / BM; nN = N / BM; nwg = nM * nN; G = G_; c = c_; }
    __device__ bool next(int i, Unit& u) const {
        const long L = (long)i * G + c; if (L >= nwg) return false;
        int wgid = (int)L; { const int q = nwg / NXCD, r = nwg % NXCD, xcd = wgid % NXCD, off = wgid / NXCD; wgid = (xcd < r ? xcd * (q + 1) : r * (q + 1) + (xcd - r) * q) + off; }
        const int nig = WGM * nN, gid = wgid / nig, fm = gid * WGM, gsz = (nM - fm) < WGM ? (nM - fm) : WGM;
        u.pm = fm + ((wgid % nig) % gsz); u.pn = (wgid % nig) / gsz; u.aoff = 0; u.boff = 0; return true;
    }
};
struct LruOrder : StaticOrder {
    __device__ bool next(int i, Unit& u) const { if (!StaticOrder::next(i, u)) return false; u.aoff = (u.pn >> 1) * 512; return true; }
};
struct SplitOrder {
    int nchunk, total, c;
    __device__ void init(int nunits, int nchunk_, int c_) { nchunk = nchunk_; total = nunits * nchunk_; c = c_; }
    __device__ bool next(int i, Unit& u) const { if (i != 0 || c >= total) return false; const int unit = c / nchunk, ch = c % nchunk; u.pm = unit >> 2; u.pn = unit & 3; u.aoff = ch * 512; u.boff = ch * 512; return true; }
};
struct TailOrder {
    int c;
    __device__ bool next(int i, Unit& u) const { if (c < 0 || i > 0 || c >= 40) return false; u.pm = 64 + c / 20; u.pn = c % 20; u.aoff = 0; u.boff = 0; return true; }
};
template <class Epi, class Sched>
__device__ __forceinline__ void gemm_phase(LAS unsigned char* lds, const Gemm g, const Sched& S, const Epi& E) {
    const int tid = tid_opaque(), wid = __builtin_amdgcn_readfirstlane(tid >> 6), lane = tid & 63, wr = wid >> 2, wc = wid & 3, fr = lane & 15, fq = lane >> 4;
    const int K = g.K, nt = K / BK, lda = g.lda, ldb = g.ldb;
    unsigned voffA[2], voffB[2];
#pragma unroll
    for (int i = 0; i < 2; ++i) { int R, C; stage_rc(tid * 16 + i * 8192, R, C); voffA[i] = (unsigned)(R * lda + C) * 2u; voffB[i] = (unsigned)(R * ldb + C) * 2u; }
    const size_t kstep = (size_t)(BK * 2);
    const size_t hstepA = (size_t)HALF * lda * 2, tstepA = 2 * hstepA;
    const size_t hstepB = (size_t)HALF * ldb * 2, tstepB = 2 * hstepB;
    const unsigned ldsw = (unsigned)wid * 1024u;
    const int aoff = lds_byte(wr * 64 + fr, fq * 8), boff = lds_byte(wc * 32 + fr, fq * 8);
#define PG8_SA(b, h) (((b) * 2 + (h)) * HTB)
#define PG8_SB(b, h) ((4 + (b) * 2 + (h)) * HTB)
#define PG8_STAGE(bufoff, gbase, voff) do { _Pragma("unroll") for (int _i = 0; _i < 2; ++_i) \
        __builtin_amdgcn_global_load_lds((const unsigned*)((const char*)(gbase) + (voff)[_i]), (LAS unsigned*)(lds + (bufoff) + ldsw + _i * 8192), 16, 0, 0); } while (0)
#define PG8_LDA(dst, b, h) do { _Pragma("unroll") for (int m = 0; m < 4; ++m) _Pragma("unroll") for (int k = 0; k < 2; ++k) dst[m][k] = *(const LAS bf16x8*)(lds + PG8_SA(b, h) + aoff + m * 2048 + k * 1024); } while (0)
#define PG8_LDB(dst, b, h) do { _Pragma("unroll") for (int n = 0; n < 2; ++n) _Pragma("unroll") for (int k = 0; k < 2; ++k) dst[n][k] = *(const LAS bf16x8*)(lds + PG8_SB(b, h) + boff + n * 2048 + k * 1024); } while (0)
#define PG8_MMA(ai, bj, At, Bt) do { __builtin_amdgcn_s_setprio(1); _Pragma("unroll") for (int m = 0; m < 4; ++m) _Pragma("unroll") for (int n = 0; n < 2; ++n) _Pragma("unroll") for (int k = 0; k < 2; ++k) \
        acc[ai][bj][m][n] = __builtin_amdgcn_mfma_f32_16x16x32_bf16(Bt[n][k], At[m][k], acc[ai][bj][m][n], 0, 0, 0); __builtin_amdgcn_s_setprio(0); } while (0)
#define PG8_WAIT_V(n) asm volatile("s_waitcnt vmcnt(" #n ")" ::: "memory")
#define PG8_WAIT_L(n) asm volatile("s_waitcnt lgkmcnt(" #n ")" ::: "memory")
#define PG8_BAR __builtin_amdgcn_s_barrier()
#define PG8_SCHED __builtin_amdgcn_sched_barrier(0)
    Unit cur, nxt; int ui = 0;
    if (!S.next(0, cur)) return;
    f32x4 acc[2][2][4][2];
#pragma unroll
    for (int a = 0; a < 2; ++a)
#pragma unroll
        for (int b = 0; b < 2; ++b)
#pragma unroll
            for (int m = 0; m < 4; ++m)
#pragma unroll
                for (int n = 0; n < 2; ++n) acc[a][b][m][n] = (f32x4){0.f, 0.f, 0.f, 0.f};
    bf16x8 At[4][2], B0[2][2], B1[2][2];
    const char* cA = (const char*)g.A + (size_t)cur.pm * tstepA + cur.aoff; const char* cB = (const char*)g.Bt + (size_t)cur.pn * tstepB + cur.boff;
    PG8_STAGE(PG8_SB(0, 0), cB, voffB); PG8_STAGE(PG8_SA(0, 0), cA, voffA); PG8_STAGE(PG8_SB(0, 1), cB + hstepB, voffB); PG8_STAGE(PG8_SA(0, 1), cA + hstepA, voffA);
    if (wr == 1) PG8_BAR;
    PG8_WAIT_V(4); PG8_BAR;
    PG8_STAGE(PG8_SB(1, 0), cB + kstep, voffB); PG8_STAGE(PG8_SA(1, 0), cA + kstep, voffA); PG8_STAGE(PG8_SB(1, 1), cB + hstepB + kstep, voffB);
    PG8_WAIT_V(6); PG8_BAR;
    for (;;) {
        const bool has_next = S.next(ui + 1, nxt);
        const char* nA = has_next ? (const char*)g.A + (size_t)nxt.pm * tstepA + nxt.aoff : cA; const char* nB = has_next ? (const char*)g.Bt + (size_t)nxt.pn * tstepB + nxt.boff : cB;
        for (int t = 0; t < nt; t += 2) {
            const bool last = (t == nt - 2);
            const char* a1 = cA + (size_t)(t + 1) * kstep;
            const char* a2 = last ? nA : cA + (size_t)(t + 2) * kstep; const char* b2 = last ? nB : cB + (size_t)(t + 2) * kstep;
            const char* a3 = a2 + kstep; const char* b3 = b2 + kstep;
            PG8_LDB(B0, 0, 0); PG8_SCHED; PG8_LDA(At, 0, 0); PG8_STAGE(PG8_SA(1, 1), a1 + hstepA, voffA);
            PG8_WAIT_L(8); PG8_BAR; PG8_WAIT_L(0); PG8_MMA(0, 0, At, B0); PG8_BAR; PG8_SCHED;
            PG8_LDB(B1, 0, 1); PG8_STAGE(PG8_SB(0, 0), b2, voffB);
            PG8_BAR; PG8_WAIT_L(0); PG8_MMA(0, 1, At, B1); PG8_BAR;
            PG8_LDA(At, 0, 1); PG8_STAGE(PG8_SA(0, 0), a2, voffA);
            PG8_BAR; PG8_WAIT_L(0); PG8_MMA(1, 0, At, B0); PG8_BAR; PG8_SCHED;
            PG8_STAGE(PG8_SB(0, 1), b2 + hstepB, voffB);
            PG8_WAIT_V(6); PG8_BAR; PG8_MMA(1, 1, At, B1); PG8_BAR;
            PG8_LDB(B0, 1, 0); PG8_SCHED; PG8_LDA(At, 1, 0); PG8_STAGE(PG8_SA(0, 1), a2 + hstepA, voffA);
            PG8_WAIT_L(8); PG8_BAR; PG8_WAIT_L(0); PG8_MMA(0, 0, At, B0); PG8_BAR; PG8_SCHED;
            PG8_LDB(B1, 1, 1); PG8_STAGE(PG8_SB(1, 0), b3, voffB);
            PG8_BAR; PG8_WAIT_L(0); PG8_MMA(0, 1, At, B1); PG8_BAR;
            PG8_LDA(At, 1, 1); PG8_STAGE(PG8_SA(1, 0), a3, voffA);
            PG8_BAR; PG8_WAIT_L(0); PG8_MMA(1, 0, At, B0); PG8_BAR; PG8_SCHED;
            PG8_STAGE(PG8_SB(1, 1), b3 + hstepB, voffB);
            PG8_WAIT_V(6); PG8_BAR; PG8_MMA(1, 1, At, B1); PG8_BAR;
        }
        E(acc, cur, wr, wc, fr, fq);
        if (!has_next) break;
#pragma unroll
        for (int a = 0; a < 2; ++a)
#pragma unroll
            for (int b = 0; b < 2; ++b)
#pragma unroll
                for (int m = 0; m < 4; ++m)
#pragma unroll
                    for (int n = 0; n < 2; ++n) acc[a][b][m][n] = (f32x4){0.f, 0.f, 0.f, 0.f};
        cur = nxt; cA = nA; cB = nB; ++ui;
    }
    PG8_WAIT_V(0);
    if (wr == 0) PG8_BAR;
    PG8_BAR;
#undef PG8_SA
#undef PG8_SB
#undef PG8_STAGE
#undef PG8_LDA
#undef PG8_LDB
#undef PG8_MMA
#undef PG8_WAIT_V
#undef PG8_WAIT_L
#undef PG8_BAR
#undef PG8_SCHED
}
}
using pg8::Unit;

template <int LRU> struct EpiStoreT {
    bf16_t* O; int ldc;
    __device__ __forceinline__ void operator()(const f32x4 (&acc)[2][2][4][2], const Unit& u, int wr, int wc, int fr, int fq) const {
        if (LRU) {
            const int row0 = u.pm * 256 + wr * 64 + fr, col0 = 3072 + (u.pn & 1) * 1024 + (u.pn >> 1) * 256 + wc * 32 + 4 * fq;
#pragma unroll
            for (int ai = 0; ai < 2; ++ai)
#pragma unroll
                for (int m = 0; m < 4; ++m) { bf16_t* rowp = O + (size_t)(row0 + ai * 128 + m * 16) * ldc + col0;
#pragma unroll
                    for (int bj = 0; bj < 2; ++bj)
#pragma unroll
                        for (int n = 0; n < 2; ++n) { const f32x4 v = acc[ai][bj][m][n]; u32x2 w; w.x = pk2(v[0], v[1]); w.y = pk2(v[2], v[3]); *(u32x2*)(rowp + bj * 128 + n * 16) = w; } }
        } else {
            const int row0 = u.pm * 256 + wr * 64 + fr, col0 = u.pn * 256 + wc * 32 + 8 * fq;
#pragma unroll
            for (int ai = 0; ai < 2; ++ai)
#pragma unroll
                for (int m = 0; m < 4; ++m) { bf16_t* rowp = O + (size_t)(row0 + ai * 128 + m * 16) * ldc + col0;
#pragma unroll
                    for (int bj = 0; bj < 2; ++bj) { const f32x4 v0 = acc[ai][bj][m][0], v1 = acc[ai][bj][m][1];
                        u32x4 w; w.x = pk2(v0[0], v0[1]); w.y = pk2(v0[2], v0[3]); w.z = pk2(v1[0], v1[1]); w.w = pk2(v1[2], v1[3]); *(u32x4*)(rowp + bj * 128) = w; } }
        }
    }
};
struct EpiSwiGLU {
    bf16_t* G;
    __device__ __forceinline__ void operator()(const f32x4 (&acc)[2][2][4][2], const Unit& u, int wr, int wc, int fr, int fq) const {
        const int row0 = u.pm * 256 + wr * 64 + fr, col0 = (u.pn * 256 + wc * 32) / 2 + 4 * fq;
#pragma unroll
        for (int ai = 0; ai < 2; ++ai)
#pragma unroll
            for (int m = 0; m < 4; ++m) { bf16_t* rowp = G + (size_t)(row0 + ai * 128 + m * 16) * DFF + col0;
#pragma unroll
                for (int bj = 0; bj < 2; ++bj) { const f32x4 gt = acc[ai][bj][m][0], vl = acc[ai][bj][m][1]; u32x2 w;
                    w.x = pk2(siluf(gt[0]) * vl[0], siluf(gt[1]) * vl[1]); w.y = pk2(siluf(gt[2]) * vl[2], siluf(gt[3]) * vl[3]); *(u32x2*)(rowp + bj * 64) = w; } }
    }
};
struct EpiResid {
    float* X; float scale;
    __device__ __forceinline__ void operator()(const f32x4 (&acc)[2][2][4][2], const Unit& u, int wr, int wc, int fr, int fq) const {
        const int row0 = u.pm * 256 + wr * 64 + fr, col0 = u.pn * 256 + wc * 32 + 4 * fq;
#pragma unroll
        for (int ai = 0; ai < 2; ++ai)
#pragma unroll
            for (int m = 0; m < 4; ++m) { float* rowp = X + (size_t)(row0 + ai * 128 + m * 16) * DM + col0;
#pragma unroll
                for (int bj = 0; bj < 2; ++bj)
#pragma unroll
                    for (int n = 0; n < 2; ++n) { f32x4* q = (f32x4*)(rowp + bj * 128 + n * 16); const f32x4 o = *q; *q = o + acc[ai][bj][m][n] * scale; } }
    }
};
struct EpiPart {
    float* PART; float scale;
    __device__ __forceinline__ void operator()(const f32x4 (&acc)[2][2][4][2], const Unit& u, int wr, int wc, int fr, int fq) const {
        const int row0 = u.pm * 256 + wr * 64 + fr, col0 = u.pn * 256 + wc * 32 + 4 * fq;
        float* base = PART + (size_t)(u.aoff >> 9) * MS * DM;
#pragma unroll
        for (int ai = 0; ai < 2; ++ai)
#pragma unroll
            for (int m = 0; m < 4; ++m) { float* rowp = base + (size_t)(row0 + ai * 128 + m * 16) * DM + col0;
#pragma unroll
                for (int bj = 0; bj < 2; ++bj)
#pragma unroll
                    for (int n = 0; n < 2; ++n) *(f32x4*)(rowp + bj * 128 + n * 16) = acc[ai][bj][m][n] * scale; }
    }
};
struct EpiGate {
    bf16_t* MG; const bf16_t* gate; int ldg; int accum;
    __device__ __forceinline__ void operator()(const f32x4 (&acc)[2][2][4][2], const Unit& u, int wr, int wc, int fr, int fq) const {
        const int row0 = u.pm * 256 + wr * 64 + fr, col0 = u.pn * 256 + wc * 32 + 4 * fq;
#pragma unroll
        for (int ai = 0; ai < 2; ++ai)
#pragma unroll
            for (int m = 0; m < 4; ++m) { const size_t r = (size_t)(row0 + ai * 128 + m * 16); bf16_t* rowp = MG + r * DM + col0; const bf16_t* gp = gate + r * ldg + col0;
#pragma unroll
                for (int bj = 0; bj < 2; ++bj)
#pragma unroll
                    for (int n = 0; n < 2; ++n) { const f32x4 v = acc[ai][bj][m][n]; const u32x2 gw = *(const u32x2*)(gp + bj * 128 + n * 16);
                        float o0 = sigm(bf2f(gw.x & 0xffffu)) * v[0], o1 = sigm(bf2f(gw.x >> 16)) * v[1], o2 = sigm(bf2f(gw.y & 0xffffu)) * v[2], o3 = sigm(bf2f(gw.y >> 16)) * v[3];
                        u32x2* q = (u32x2*)(rowp + bj * 128 + n * 16);
                        if (accum) { const u32x2 old = *q; o0 += bf2f(old.x & 0xffffu); o1 += bf2f(old.x >> 16); o2 += bf2f(old.y & 0xffffu); o3 += bf2f(old.y >> 16); }
                        u32x2 w; w.x = pk2(o0, o1); w.y = pk2(o2, o3); *q = w; } }
    }
};
template <class Epi> __device__ __forceinline__ void run_gemm(LAS unsigned char* lds, const bf16_t* A, int lda, const bf16_t* Bt, int N, int K, const Epi& E, int Mrows = MT) {
    pg8::Gemm g; g.A = A; g.Bt = Bt; g.M = Mrows; g.N = N; g.K = K; g.lda = lda; g.ldb = K;
    pg8::StaticOrder S; S.init(Mrows, N, (int)gridDim.x, (int)blockIdx.x);
    pg8::gemm_phase<Epi, pg8::StaticOrder>(lds, g, S, E);
}
__device__ __forceinline__ void run_gemm_resid(LAS unsigned char* lds, const bf16_t* A, int lda, const bf16_t* Bt, int K, float* X, float scale, float* PART) {
    EpiResid e; e.X = X; e.scale = scale;
    run_gemm(lds, A, lda, Bt, DM, K, e, MP);
    EpiPart ea; ea.PART = PART; ea.scale = scale;
    pg8::Gemm g; g.A = A + (size_t)MP * lda; g.Bt = Bt; g.M = MS; g.N = DM; g.K = 256; g.lda = lda; g.ldb = K;
    pg8::SplitOrder S; S.init(8, K / 256, (int)blockIdx.x);
    pg8::gemm_phase<EpiPart, pg8::SplitOrder>(lds, g, S, ea);
}
typedef EpiStoreT<0> EpiStore; typedef EpiStoreT<1> EpiStoreLru;
__device__ __forceinline__ void run_gemm_lru(LAS unsigned char* lds, const bf16_t* A, const bf16_t* Bt, const EpiStoreLru& E) {
    pg8::Gemm g; g.A = A; g.Bt = Bt; g.M = MT; g.N = 2048; g.K = 256; g.lda = DM; g.ldb = 256;
    pg8::LruOrder S; S.init(MT, 2048, (int)gridDim.x, (int)blockIdx.x);
    pg8::gemm_phase<EpiStoreLru, pg8::LruOrder>(lds, g, S, E);
}

__device__ __forceinline__ int srccol(int kind, int j) {
    if (kind == 0) return j;
    if (kind == 1) { const int grp = j >> 5, w = j & 31; return w < 16 ? grp * 16 + w : DFF + grp * 16 + (w - 16); }
    if (j < 1536) return j;
    if (j < 2560) return 7680 + (j - 1536);
    if (j < 4608) return 5632 + (j - 2560);
    if (j < 5632) return 9728 + (j - 4608);
    if (j < 9728) return 1536 + (j - 5632);
    return 8704 + (j - 9728);
}
__device__ __forceinline__ void conv_item(const float* W, int K, int N, bf16_t* WT, int kind, LAS float* scr, int item, int lane) {
    const int nblk = N / 32, kb = item / nblk, nb = item % nblk, k0 = 64 * kb, n0 = 32 * nb;
    const int rho = lane & 31, prm = 8 * ((rho & 15) >> 2) + 4 * (rho >> 4) + (rho & 3);
    const int sc = srccol(kind, n0 + (kind == 2 ? prm : rho));
    float wv[32];
#pragma unroll
    for (int i = 0; i < 32; ++i) { const int kk = 2 * i + (lane >> 5); wv[i] = W[(size_t)(k0 + kk) * N + sc]; }
#pragma unroll
    for (int i = 0; i < 32; ++i) { const int kk = 2 * i + (lane >> 5); scr[kk * 33 + (lane & 31)] = wv[i]; }
    LDS_WAIT();
    const int c = lane & 7;
#pragma unroll
    for (int j = 0; j < 4; ++j) { const int n = (lane >> 3) + 8 * j; const LAS float* s = scr + (8 * c) * 33 + n;
        u32x4 o; o.x = pk2(s[0 * 33], s[1 * 33]); o.y = pk2(s[2 * 33], s[3 * 33]); o.z = pk2(s[4 * 33], s[5 * 33]); o.w = pk2(s[6 * 33], s[7 * 33]);
        *(u32x4*)(WT + (size_t)(n0 + n) * K + k0 + 8 * c) = o; }
    LDS_WAIT();
}
__device__ __forceinline__ void ph_convert(const Params& p, int l, LAS unsigned char* lds) {
    const int wave = tid_opaque() >> 6, lane = tid_opaque() & 63;
    LAS float* scr = (LAS float*)(lds + wave * 8704);
    bf16_t* Wb = (bf16_t*)(p.ws + OFF_W);
    const int gw = blockIdx.x * 8 + wave, NGW = gridDim.x * 8;
    constexpr int I_UP = (1024 / 64) * (5632 / 32), I_DN = (2816 / 64) * (1024 / 32), I_IN = (1024 / 64) * (INC / 32), I_SQ = (1024 / 64) * (1024 / 32);
    constexpr int NIT = 2 * I_UP + 2 * I_DN + I_IN + 4 * I_SQ;
    for (int it = gw; it < NIT; it += NGW) {
        int r = it;
        if (r < I_UP) { conv_item(p.in[I_UP1] + (size_t)l * 1024 * 5632, 1024, 5632, Wb + W_UP1, 1, scr, r, lane); continue; } r -= I_UP;
        if (r < I_DN) { conv_item(p.in[I_DN1] + (size_t)l * 2816 * 1024, 2816, 1024, Wb + W_DN1, 0, scr, r, lane); continue; } r -= I_DN;
        if (r < I_IN) { conv_item(p.in[I_WIN] + (size_t)l * 1024 * INC, 1024, INC, Wb + W_IN, 2, scr, r, lane); continue; } r -= I_IN;
        if (r < I_SQ) { conv_item(p.in[I_WAO] + (size_t)l * 1048576, 1024, 1024, Wb + W_AO, 0, scr, r, lane); continue; } r -= I_SQ;
        if (r < I_SQ) { conv_item(p.in[I_WHO] + (size_t)l * 1048576, 1024, 1024, Wb + W_HO, 0, scr, r, lane); continue; } r -= I_SQ;
        if (r < I_SQ) { conv_item(p.in[I_WLO] + (size_t)l * 1048576, 1024, 1024, Wb + W_LO, 0, scr, r, lane); continue; } r -= I_SQ;
        if (r < I_SQ) { conv_item(p.in[I_WOUT] + (size_t)l * 1048576, 1024, 1024, Wb + W_OUT, 0, scr, r, lane); continue; } r -= I_SQ;
        if (r < I_UP) { conv_item(p.in[I_UP2] + (size_t)l * 1024 * 5632, 1024, 5632, Wb + W_UP2, 1, scr, r, lane); continue; } r -= I_UP;
        conv_item(p.in[I_DN2] + (size_t)l * 2816 * 1024, 2816, 1024, Wb + W_DN2, 0, scr, r, lane);
    }
    for (int idx = blockIdx.x * 512 + tid_opaque(); idx < 2048 * 256; idx += gridDim.x * 512) {
        const int j = idx >> 8, k = idx & 255, pn = j >> 8, i = j & 255, g = pn >> 1, typ = pn & 1;
        const int blk = g * 4 + (i >> 6), dd = i & 63, blk_in = g * 4 + (k >> 6), cc = k & 63;
        float v = 0.f;
        if (blk == blk_in) v = p.in[typ ? I_LWX : I_LWA][(((size_t)l * 16 + blk) * 64 + cc) * 64 + dd];
        Wb[W_LRU + idx] = (bf16_t)f2bf(v);
    }
}

__device__ __forceinline__ float wave_sum(float v) {
#pragma unroll
    for (int o = 1; o < 64; o <<= 1) v += __shfl_xor(v, o);
    return v;
}
template <int NCH>
__device__ __forceinline__ void ph_norm(const Params& p, const float* g, bool init) {
    constexpr int nchunk = NCH;
    const int wave = tid_opaque() >> 6, lane = tid_opaque() & 63;
    const int gw = blockIdx.x * 8 + wave, NGW = gridDim.x * 8;
    float* X = p.out; bf16_t* H = (bf16_t*)(p.ws + OFF_H);
    f32x4 gv[4];
#pragma unroll
    for (int j = 0; j < 4; ++j) gv[j] = ((const f32x4*)g)[lane + 64 * j];
    for (int row = gw; row < MT; row += NGW) {
        const float* src = init ? (row < MP ? p.in[I_XP] + (size_t)row * DM : p.in[I_XS] + (size_t)(row - MP) * DM) : X + (size_t)row * DM;
        f32x4 v[4]; float s = 0.f;
#pragma unroll
        for (int j = 0; j < 4; ++j) v[j] = ((const f32x4*)src)[lane + 64 * j];
        const bool fold = !init && row >= MP && nchunk > 0;
        if (fold) { const float* part = (const float*)(p.ws + OFF_S) + (size_t)(row - MP) * DM;
            f32x4 pv[NCH][4];
#pragma unroll
            for (int c = 0; c < NCH; ++c)
#pragma unroll
                for (int j = 0; j < 4; ++j) pv[c][j] = ((const f32x4*)(part + (size_t)c * MS * DM))[lane + 64 * j];
#pragma unroll
            for (int c = 0; c < NCH; ++c)
#pragma unroll
                for (int j = 0; j < 4; ++j) v[j] += pv[c][j]; }
#pragma unroll
        for (int j = 0; j < 4; ++j) s += (v[j][0] * v[j][0] + v[j][1] * v[j][1]) + (v[j][2] * v[j][2] + v[j][3] * v[j][3]);
        s = wave_sum(s);
        const float rstd = rsqrtf(s * (1.f / DM) + EPS);
#pragma unroll
        for (int j = 0; j < 4; ++j) { u32x2 w; w.x = pk2(v[j][0] * rstd * gv[j][0], v[j][1] * rstd * gv[j][1]); w.y = pk2(v[j][2] * rstd * gv[j][2], v[j][3] * rstd * gv[j][3]);
            *(u32x2*)(H + (size_t)row * DM + (lane + 64 * j) * 4) = w;
            if (init || fold) ((f32x4*)(X + (size_t)row * DM))[lane + 64 * j] = v[j]; }
    }
}

constexpr int KS_LD = 72, VT_LD = 200;
constexpr int KS_OFF = 0, VT_OFF = 192 * KS_LD * 2;
template <bool SAMPLE>
__device__ __forceinline__ void attn_item(const Params& p, int l, LAS unsigned char* lds, int b, int c, int kvh, bool dry) {
    const int tid = tid_opaque(), wave = tid >> 6, lane = tid & 63, l15 = lane & 15, quad = lane >> 4;
    bf16_t* PA = (bf16_t*)(p.ws + OFF_P);
    LAS bf16_t* Ks = (LAS bf16_t*)(lds + KS_OFF); LAS bf16_t* Vt = (LAS bf16_t*)(lds + VT_OFF);
    const float* kg = p.in[I_KN] + l * 64; const float* qg = p.in[I_QN] + l * 64;
    constexpr int NQT = SAMPLE ? 1 : 2, NKT = SAMPLE ? 10 : 12;
    const bool active = SAMPLE ? (wave < 4) : true;
    const int g = SAMPLE ? (wave & 3) : (wave >> 1), tokbase = SAMPLE ? 0 : (wave & 1) * 32;
    const int hq = kvh * 4 + g;
    u32x4 qraw[NQT][2]; long qrow[NQT];
#pragma unroll
    for (int qt = 0; qt < NQT; ++qt) {
        const int tok = tokbase + qt * 16 + l15;
        qrow[qt] = SAMPLE ? ((long)MP + b * DSQ + tok) : ((long)b * SEQ + c * 64 + tok);
        const bf16_t* qp = PA + qrow[qt] * LDA_ + hq * 64;
        qraw[qt][0] = *(const u32x4*)(qp + quad * 8); qraw[qt][1] = *(const u32x4*)(qp + 32 + quad * 8);
    }
    {
        const int d8 = (tid & 7) * 8;
        float kgv[8];
#pragma unroll
        for (int i = 0; i < 8; ++i) kgv[i] = kg[d8 + i];
#pragma unroll
        for (int pass = 0; pass < 3; ++pass) {
            const int j = pass * 64 + (tid >> 3);
            float kf[8], vf[8]; bool valid, need_norm; long row = 0;
            if (!SAMPLE) { const int tk = (c - 2) * 64 + j; valid = tk >= 0; need_norm = true; row = (long)b * SEQ + tk; }
            else { valid = j < 144; need_norm = j >= 128; row = (long)MP + b * DSQ + (j - 128); }
            if (valid && need_norm) {
                const u32x4 kr = *(const u32x4*)(PA + row * LDA_ + 1024 + kvh * 64 + d8); const u32x4 vr = *(const u32x4*)(PA + row * LDA_ + 1280 + kvh * 64 + d8);
                unpack8(kr, kf); unpack8(vr, vf);
            } else if (valid) {
                const float* ck = p.in[I_CK] + ((((size_t)l * DB + b) * 128 + j) * 4 + kvh) * 64 + d8; const float* cv = p.in[I_CV] + ((((size_t)l * DB + b) * 128 + j) * 4 + kvh) * 64 + d8;
                const f32x4 a0 = *(const f32x4*)ck, a1 = *(const f32x4*)(ck + 4), b0 = *(const f32x4*)cv, b1 = *(const f32x4*)(cv + 4);
#pragma unroll
                for (int i = 0; i < 4; ++i) { kf[i] = a0[i]; kf[4 + i] = a1[i]; vf[i] = b0[i]; vf[4 + i] = b1[i]; }
            } else {
#pragma unroll
                for (int i = 0; i < 8; ++i) { kf[i] = 0.f; vf[i] = 0.f; }
            }
            float ss = 0.f;
#pragma unroll
            for (int i = 0; i < 8; ++i) ss += kf[i] * kf[i];
            ss += __shfl_xor(ss, 1); ss += __shfl_xor(ss, 2); ss += __shfl_xor(ss, 4);
            if (need_norm) { const float rstd = rsqrtf(ss * (1.f / 64.f) + EPS);
#pragma unroll
                for (int i = 0; i < 8; ++i) kf[i] = kf[i] * rstd * kgv[i]; }
            *(LAS u32x4*)(Ks + j * KS_LD + d8) = pack8(kf);
#pragma unroll
            for (int i = 0; i < 8; ++i) Vt[(d8 + i) * VT_LD + j] = (bf16_t)f2bf(vf[i]);
            if (!SAMPLE) { const int tk = (c - 2) * 64 + j;
                if (j >= 128 && tk >= SEQ - 128) { const size_t o = ((((size_t)l * NB + b) * 128 + (tk - (SEQ - 128))) * 4 + kvh) * 64 + d8;
#pragma unroll
                    for (int i = 0; i < 8; ++i) { p.out[O_NKP + o + i] = kf[i]; p.out[O_NVP + o + i] = vf[i]; } } }
            else if (j >= 128 && j < 144) { const size_t o = ((((size_t)l * DB + b) * DSQ + (j - 128)) * 4 + kvh) * 64 + d8;
#pragma unroll
                for (int i = 0; i < 8; ++i) { p.out[O_NKS + o + i] = kf[i]; p.out[O_NVS + o + i] = vf[i]; } }
        }
    }
    __syncthreads();
    if (active) {
        const float sink = p.in[I_SINK][l * 16 + hq];
        const int kmin = SAMPLE ? 0 : (c >= 2 ? 0 : (2 - c) * 64), kmax = SAMPLE ? 144 : 192;
        bf16x8 qf[NQT][2];
#pragma unroll
        for (int qt = 0; qt < NQT; ++qt) {
            float q0[8], q1[8]; unpack8(qraw[qt][0], q0); unpack8(qraw[qt][1], q1);
            float ss = 0.f;
#pragma unroll
            for (int i = 0; i < 8; ++i) ss += q0[i] * q0[i] + q1[i] * q1[i];
            ss += __shfl_xor(ss, 16); ss += __shfl_xor(ss, 32);
            const float sc = rsqrtf(ss * (1.f / 64.f) + EPS) * 0.125f;
#pragma unroll
            for (int i = 0; i < 8; ++i) { q0[i] = q0[i] * sc * qg[quad * 8 + i]; q1[i] = q1[i] * sc * qg[32 + quad * 8 + i]; }
            const u32x4 w0 = pack8(q0), w1 = pack8(q1);
            qf[qt][0] = __builtin_bit_cast(bf16x8, w0); qf[qt][1] = __builtin_bit_cast(bf16x8, w1);
        }
        f32x4 st[NKT][NQT];
#pragma unroll
        for (int kt = 0; kt < NKT; ++kt) {
#pragma unroll
            for (int qt = 0; qt < NQT; ++qt) st[kt][qt] = (f32x4){0.f, 0.f, 0.f, 0.f};
#pragma unroll
            for (int ds = 0; ds < 2; ++ds) {
                const bf16x8 kfr = *(const LAS bf16x8*)(Ks + (kt * 16 + l15) * KS_LD + ds * 32 + quad * 8);
#pragma unroll
                for (int qt = 0; qt < NQT; ++qt) st[kt][qt] = __builtin_amdgcn_mfma_f32_16x16x32_bf16(kfr, qf[qt][ds], st[kt][qt], 0, 0, 0);
            }
        }
        float inv[NQT];
#pragma unroll
        for (int qt = 0; qt < NQT; ++qt) {
            float m = -1e30f;
#pragma unroll
            for (int kt = 0; kt < NKT; ++kt)
#pragma unroll
                for (int j = 0; j < 4; ++j) { const int key = kt * 16 + quad * 4 + j; const bool ok = key >= kmin && key < kmax; if (ok) m = fmaxf(m, st[kt][qt][j]); }
            m = fmaxf(m, __shfl_xor(m, 16)); m = fmaxf(m, __shfl_xor(m, 32));
            m = fmaxf(m, sink);
            float sum = 0.f;
#pragma unroll
            for (int kt = 0; kt < NKT; ++kt)
#pragma unroll
                for (int j = 0; j < 4; ++j) { const int key = kt * 16 + quad * 4 + j; const bool ok = key >= kmin && key < kmax; const float e = ok ? __expf(st[kt][qt][j] - m) : 0.f; st[kt][qt][j] = e; sum += e; }
            sum += __shfl_xor(sum, 16); sum += __shfl_xor(sum, 32);
            inv[qt] = 1.f / (sum + __expf(sink - m));
        }
        f32x4 ot[4][NQT];
#pragma unroll
        for (int dt = 0; dt < 4; ++dt)
#pragma unroll
            for (int qt = 0; qt < NQT; ++qt) ot[dt][qt] = (f32x4){0.f, 0.f, 0.f, 0.f};
#pragma unroll
        for (int s = 0; s < NKT / 2; ++s) {
            bf16x8 pf[NQT];
#pragma unroll
            for (int qt = 0; qt < NQT; ++qt) { u32x4 w; w.x = pk2(st[2 * s][qt][0], st[2 * s][qt][1]); w.y = pk2(st[2 * s][qt][2], st[2 * s][qt][3]);
                w.z = pk2(st[2 * s + 1][qt][0], st[2 * s + 1][qt][1]); w.w = pk2(st[2 * s + 1][qt][2], st[2 * s + 1][qt][3]); pf[qt] = __builtin_bit_cast(bf16x8, w); }
#pragma unroll
            for (int dt = 0; dt < 4; ++dt) {
                const LAS bf16_t* vp = Vt + (dt * 16 + l15) * VT_LD + 32 * s + quad * 4;
                const u32x2 lo = *(const LAS u32x2*)vp, hi = *(const LAS u32x2*)(vp + 16);
                u32x4 w; w.x = lo.x; w.y = lo.y; w.z = hi.x; w.w = hi.y;
                const bf16x8 vfr = __builtin_bit_cast(bf16x8, w);
#pragma unroll
                for (int qt = 0; qt < NQT; ++qt) ot[dt][qt] = __builtin_amdgcn_mfma_f32_16x16x32_bf16(vfr, pf[qt], ot[dt][qt], 0, 0, 0);
            }
        }
#pragma unroll
        for (int qt = 0; qt < NQT; ++qt) {
            bf16_t* op = PA + qrow[qt] * LDA_ + hq * 64 + quad * 4;
#pragma unroll
            for (int dt = 0; dt < 4; ++dt) { u32x2 w; w.x = pk2(ot[dt][qt][0] * inv[qt], ot[dt][qt][1] * inv[qt]); w.y = pk2(ot[dt][qt][2] * inv[qt], ot[dt][qt][3] * inv[qt]); if (!dry) *(u32x2*)(op + dt * 16) = w; }
        }
    }
    __syncthreads();
}
__device__ __forceinline__ void ph_attn(const Params& p, int l, LAS unsigned char* lds, bool dry) {
    constexpr int NPI = NB * 64 * 4, NSI = DB * 4;
    for (int it = blockIdx.x; it < NPI + NSI; it += gridDim.x) {
        if (it < NPI) { const int kvh = it & 3, c = (it >> 2) & 63, b = it >> 8; attn_item<false>(p, l, lds, b, c, kvh, dry); }
        else { const int r = it - NPI; attn_item<true>(p, l, lds, r >> 2, 0, r & 3, dry); }
    }
}

__device__ __forceinline__ float hgrn_lb(const Params& p, int l, int idx) {
    if (l == 0) return 0.f;
    const float a = p.in[I_LBL][idx], b = p.in[I_LBL][1024 + idx]; const float m = fmaxf(a, b); const float ea = __expf(a - m), eb = __expf(b - m);
    const float p0 = ea / (ea + eb), p1 = eb / (ea + eb); return (p0 + p1) - p0;
}
template <int MODE>
__device__ __forceinline__ void hgrn_item(const Params& p, int l, LAS unsigned char* lds, long rowbase, int ntok, int h, const float* Sin, float* Sout, float* Dout, bool dry) {
    const int tid = tid_opaque(), wave = tid >> 6, lane = tid & 63, kgi = lane & 15, vs = lane >> 4, vcol = wave * 16 + vs * 4;
    bf16_t* PB = (bf16_t*)(p.ws + OFF_P);
    LAS float* Fs = (LAS float*)lds; LAS float* Kk = Fs + 4096; LAS float* Qs = Kk + 4096; LAS float* Vs = Qs + 4096; LAS float* Os = Vs + 4096;
    f32x2 Sa[8], Sb[8];
#pragma unroll
    for (int i = 0; i < 8; ++i) { f32x4 v = (f32x4){0.f, 0.f, 0.f, 0.f}; if (Sin) v = *(const f32x4*)(Sin + (size_t)(kgi * 8 + i) * 128 + vcol);
        Sa[i] = (f32x2){v[0], v[1]}; Sb[i] = (f32x2){v[2], v[3]}; }
    float Dp[8];
#pragma unroll
    for (int i = 0; i < 8; ++i) Dp[i] = 1.f;
    const int st = tid >> 4, k8 = (tid & 15) * 8;
    float lbv[8], gnv[8];
#pragma unroll
    for (int i = 0; i < 8; ++i) { lbv[i] = hgrn_lb(p, l, h * 128 + k8 + i); gnv[i] = p.in[I_HON][l * 128 + k8 + i]; }
    u32x4 r_hq = (u32x4){0u, 0u, 0u, 0u}, r_hf = r_hq, r_hi = r_hq, r_hg = r_hq;
    { const int nb0 = ntok < 32 ? ntok : 32;
      if (st < nb0) { const bf16_t* rp = PB + (rowbase + st) * LDB_ + h * 128 + k8; r_hf = *(const u32x4*)(rp + 1024); r_hi = *(const u32x4*)(rp + 2048); if (MODE == 1) r_hq = *(const u32x4*)rp; } }
    for (int t0 = 0; t0 < ntok; t0 += 32) {
        const int nb = (ntok - t0) < 32 ? (ntok - t0) : 32;
        if (st < nb) {
            float hf[8], hi[8]; unpack8(r_hf, hf); unpack8(r_hi, hi);
            float fv[8];
#pragma unroll
            for (int i = 0; i < 8; ++i) { const float sg = sigm(hf[i]); const float f = lbv[i] + (1.f - lbv[i]) * sg; fv[i] = fmaxf(f, 1e-26f); }
            *(LAS f32x4*)(Fs + st * 128 + k8) = (f32x4){fv[0], fv[1], fv[2], fv[3]}; *(LAS f32x4*)(Fs + st * 128 + k8 + 4) = (f32x4){fv[4], fv[5], fv[6], fv[7]};
            *(LAS f32x4*)(Vs + st * 128 + k8) = (f32x4){hi[0], hi[1], hi[2], hi[3]}; *(LAS f32x4*)(Vs + st * 128 + k8 + 4) = (f32x4){hi[4], hi[5], hi[6], hi[7]};
            if (MODE == 1) { float hq[8]; unpack8(r_hq, hq);
                *(LAS f32x4*)(Qs + st * 128 + k8) = (f32x4){siluf(hq[0]), siluf(hq[1]), siluf(hq[2]), siluf(hq[3])}; *(LAS f32x4*)(Qs + st * 128 + k8 + 4) = (f32x4){siluf(hq[4]), siluf(hq[5]), siluf(hq[6]), siluf(hq[7])}; }
        }
        __syncthreads();
        { const int t1 = t0 + 32; const int nb1 = (ntok - t1) < 32 ? (ntok - t1) : 32;
          if (t1 < ntok && st < nb1) { const bf16_t* rp = PB + (rowbase + t1 + st) * LDB_ + h * 128 + k8; r_hf = *(const u32x4*)(rp + 1024); r_hi = *(const u32x4*)(rp + 2048); if (MODE == 1) r_hq = *(const u32x4*)rp; }
          if (MODE == 1 && st < nb) r_hg = *(const u32x4*)(PB + (rowbase + t0 + st) * LDB_ + 3072 + h * 128 + k8); }
#pragma unroll 4
        for (int t = 0; t < nb; ++t) {
            const f32x4 f0 = *(const LAS f32x4*)(Fs + t * 128 + kgi * 8), f1 = *(const LAS f32x4*)(Fs + t * 128 + kgi * 8 + 4);
            const f32x4 v4 = *(const LAS f32x4*)(Vs + t * 128 + vcol);
            f32x4 q0 = (f32x4){0.f, 0.f, 0.f, 0.f}, q1 = q0;
            if (MODE == 1) { q0 = *(const LAS f32x4*)(Qs + t * 128 + kgi * 8); q1 = *(const LAS f32x4*)(Qs + t * 128 + kgi * 8 + 4); }
            f32x2 oa = (f32x2){0.f, 0.f}, ob = oa; const f32x2 va = (f32x2){v4[0], v4[1]}, vb = (f32x2){v4[2], v4[3]};
#pragma unroll
            for (int i = 0; i < 8; ++i) { const float fi = i < 4 ? f0[i & 3] : f1[i & 3], qi = i < 4 ? q0[i & 3] : q1[i & 3];
                if (MODE == 0) Dp[i] *= fi;
                const f32x2 f2 = (f32x2){fi, fi}, q2 = (f32x2){qi, qi};
                Sa[i] = va + f2 * (Sa[i] - va); Sb[i] = vb + f2 * (Sb[i] - vb);
                if (MODE == 1) { oa += Sa[i] * q2; ob += Sb[i] * q2; } }
            if (MODE == 1) {
                float o[4] = {oa[0], oa[1], ob[0], ob[1]};
#pragma unroll
                for (int j = 0; j < 4; ++j) { o[j] += row_ror<1>(o[j]); o[j] += row_ror<2>(o[j]); o[j] += row_ror<4>(o[j]); o[j] += row_ror<8>(o[j]); }
                if (kgi == 0) *(LAS f32x4*)(Os + t * 128 + vcol) = (f32x4){o[0], o[1], o[2], o[3]};
            }
        }
        __syncthreads();
        if (MODE == 1 && st < nb) {
            const f32x4 o0 = *(const LAS f32x4*)(Os + st * 128 + k8), o1 = *(const LAS f32x4*)(Os + st * 128 + k8 + 4);
            float ov[8] = {o0[0], o0[1], o0[2], o0[3], o1[0], o1[1], o1[2], o1[3]};
            float ss = 0.f;
#pragma unroll
            for (int i = 0; i < 8; ++i) ss += ov[i] * ov[i];
            ss += __shfl_xor(ss, 1); ss += __shfl_xor(ss, 2); ss += __shfl_xor(ss, 4); ss += __shfl_xor(ss, 8);
            const float rstd = rsqrtf(ss * (1.f / 128.f) + EPS);
            bf16_t* gp = PB + (rowbase + t0 + st) * LDB_ + 3072 + h * 128 + k8;
            float hg[8]; unpack8(r_hg, hg);
#pragma unroll
            for (int i = 0; i < 8; ++i) ov[i] = ov[i] * rstd * gnv[i] * siluf(hg[i]);
            if (!dry) *(u32x4*)gp = pack8(ov);
        }
    }
    if (Sout) {
#pragma unroll
        for (int i = 0; i < 8; ++i) *(f32x4*)(Sout + (size_t)(kgi * 8 + i) * 128 + vcol) = (f32x4){Sa[i][0], Sa[i][1], Sb[i][0], Sb[i][1]};
    }
    if (MODE == 0 && wave == 0 && vs == 0) {
#pragma unroll
        for (int i = 0; i < 8; ++i) Dout[kgi * 8 + i] = Dp[i];
    }
    __syncthreads();
}
__device__ __forceinline__ void hgrn1_item_mfma(const Params& p, int l, LAS unsigned char* lds, long rowbase, int h, float* Sout, float* Dout) {
    const int tid = tid_opaque(), wave = tid >> 6, lane = tid & 63, l15 = lane & 15, quad = lane >> 4;
    const bf16_t* PB = (const bf16_t*)(p.ws + OFF_P);
    LAS float* G = (LAS float*)lds; LAS float* KKs = G + 64 * 128;
    LAS bf16_t* KdT = (LAS bf16_t*)(lds + 65536); LAS bf16_t* Vt = (LAS bf16_t*)(lds + 65536 + 18432);
    LAS float* QS = (LAS float*)(lds + 65536 + 36864); LAS float* CAR = QS + 512; LAS bf16_t* Vs1 = (LAS bf16_t*)(lds + 106496);
    const int st = tid >> 3, kb = (tid & 7) * 16;
    const int sk = tid & 127, qr = tid >> 7;
    float lbv[16];
#pragma unroll
    for (int i = 0; i < 16; ++i) lbv[i] = hgrn_lb(p, l, h * 128 + kb + i);
    if (tid < 128) CAR[tid] = 0.f;
    f32x4 acc[8];
#pragma unroll
    for (int vt = 0; vt < 8; ++vt) acc[vt] = (f32x4){0.f, 0.f, 0.f, 0.f};
    __syncthreads();
    for (int c = SEGT / 64 - 1; c >= 0; --c) {
        {
            const bf16_t* rp = PB + (rowbase + c * 64 + st) * LDB_ + h * 128 + kb;
            float hf[16], hi[16];
            unpack8(*(const u32x4*)(rp + 1024), *(float(*)[8])&hf[0]); unpack8(*(const u32x4*)(rp + 1024 + 8), *(float(*)[8])&hf[8]);
            unpack8(*(const u32x4*)(rp + 2048), *(float(*)[8])&hi[0]); unpack8(*(const u32x4*)(rp + 2048 + 8), *(float(*)[8])&hi[8]);
#pragma unroll
            for (int i = 0; i < 16; ++i) { const float sg = sigm(hf[i]); const float f = fmaxf(lbv[i] + (1.f - lbv[i]) * sg, 1e-26f);
                G[st * 128 + kb + i] = __logf(f); KKs[st * 128 + kb + i] = 1.f - f; }
            *(LAS u32x4*)(Vs1 + st * 128 + kb) = pack8(*(float(*)[8])&hi[0]); *(LAS u32x4*)(Vs1 + st * 128 + kb + 8) = pack8(*(float(*)[8])&hi[8]);
        }
        __syncthreads();
        {
            float run = 0.f;
#pragma unroll
            for (int i = 15; i >= 0; --i) { const int t = qr * 16 + i; const float g = G[t * 128 + sk]; G[t * 128 + sk] = run; run += g; }
            QS[qr * 128 + sk] = run;
        }
        __syncthreads();
        {
            float add = CAR[sk];
#pragma unroll
            for (int q2 = 1; q2 < 4; ++q2) if (q2 > qr) add += QS[q2 * 128 + sk];
            float kd[16], vv[16];
#pragma unroll
            for (int i = 0; i < 16; ++i) { const int t = qr * 16 + i; const float e = G[t * 128 + sk] + add; kd[i] = KKs[t * 128 + sk] * __expf(e); vv[i] = bf2f(Vs1[t * 128 + sk]); }
            *(LAS u32x4*)(KdT + sk * 72 + qr * 16) = pack8(*(float(*)[8])&kd[0]); *(LAS u32x4*)(KdT + sk * 72 + qr * 16 + 8) = pack8(*(float(*)[8])&kd[8]);
            *(LAS u32x4*)(Vt + sk * 72 + qr * 16) = pack8(*(float(*)[8])&vv[0]); *(LAS u32x4*)(Vt + sk * 72 + qr * 16 + 8) = pack8(*(float(*)[8])&vv[8]);
        }
        __syncthreads();
        if (qr == 0) CAR[sk] += (QS[sk] + QS[128 + sk]) + (QS[256 + sk] + QS[384 + sk]);
#pragma unroll
        for (int s2 = 0; s2 < 2; ++s2) {
            const bf16x8 a = *(const LAS bf16x8*)(KdT + (wave * 16 + l15) * 72 + s2 * 32 + quad * 8);
#pragma unroll
            for (int vt = 0; vt < 8; ++vt) { const bf16x8 bfr = *(const LAS bf16x8*)(Vt + (vt * 16 + l15) * 72 + s2 * 32 + quad * 8);
                acc[vt] = __builtin_amdgcn_mfma_f32_16x16x32_bf16(a, bfr, acc[vt], 0, 0, 0); }
        }
        __syncthreads();
    }
#pragma unroll
    for (int vt = 0; vt < 8; ++vt)
#pragma unroll
        for (int r = 0; r < 4; ++r) Sout[(size_t)(wave * 16 + quad * 4 + r) * 128 + vt * 16 + l15] = acc[vt][r];
    if (tid < 128) Dout[tid] = __expf(CAR[tid]);
    __syncthreads();
}
__device__ __forceinline__ void ph_hgrn1(const Params& p, int l, LAS unsigned char* lds) {
    float* Sb = (float*)(p.ws + OFF_S); float* Db = (float*)(p.ws + OFF_D);
    constexpr int NI = NB * 8 * (NSEG - 1);
    for (int it = blockIdx.x; it < NI; it += gridDim.x) {
        const int seg = it % (NSEG - 1), bh = it / (NSEG - 1), b = bh >> 3, h = bh & 7;
        hgrn1_item_mfma(p, l, lds, (long)b * SEQ + seg * SEGT, h, Sb + ((size_t)bh * NSEG + seg + 1) * 16384, Db + ((size_t)bh * NSEG + seg) * 128);
    }
}
__device__ __forceinline__ void ph_hgrn2(const Params& p) {
    float* Sb = (float*)(p.ws + OFF_S); const float* Db = (const float*)(p.ws + OFF_D);
    const int nth = gridDim.x * 512;
    for (int e = blockIdx.x * 512 + tid_opaque(); e < NB * 8 * 16384; e += nth) {
        const int bh = e >> 14, kv = e & 16383, k = kv >> 7;
        float* base = Sb + (size_t)bh * NSEG * 16384 + kv; float carry = 0.f; base[0] = 0.f;
        for (int s = 1; s < NSEG; ++s) { const float d = Db[((size_t)bh * NSEG + (s - 1)) * 128 + k]; carry = d * carry + base[(size_t)s * 16384]; base[(size_t)s * 16384] = carry; }
    }
}
constexpr int H3_G = 0, H3_Q = 16384, H3_K = 32768, H3_QC = 49152, H3_KD = 57856, H3_VT = 78336, H3_S0 = 92672, H3_AT = 127488, H3_OS = 130048, H3_DS = 138240, H3_VS = 139264, H3_KC = 147456, H3_FL = 156160, H3_END = 156416;
template <bool SAMPLE>
__device__ __forceinline__ void hgrn3_item_mfma(const Params& p, int l, LAS unsigned char* lds, long rowbase, int h, const float* Sin, float* Sout, bool dry) {
    constexpr int NTOK = SAMPLE ? 16 : SEGT, NBLK = SAMPLE ? 1 : 2;
    const int tid = tid_opaque(), wave = tid >> 6, lane = tid & 63, l15 = lane & 15, quad = lane >> 4;
    bf16_t* PB = (bf16_t*)(p.ws + OFF_P);
    LAS float* G = (LAS float*)(lds + H3_G); LAS float* Qs = (LAS float*)(lds + H3_Q); LAS float* KKs = (LAS float*)(lds + H3_K);
    LAS bf16_t* QcS = (LAS bf16_t*)(lds + H3_QC); LAS bf16_t* KdTS = (LAS bf16_t*)(lds + H3_KD); LAS bf16_t* Vt = (LAS bf16_t*)(lds + H3_VT);
    LAS bf16_t* S0T = (LAS bf16_t*)(lds + H3_S0); LAS bf16_t* attS = (LAS bf16_t*)(lds + H3_AT);
    LAS float* Os = (LAS float*)(lds + H3_OS); LAS float* Ds = (LAS float*)(lds + H3_DS); LAS bf16_t* Vs2 = (LAS bf16_t*)(lds + H3_VS);
    LAS bf16_t* KcS = (LAS bf16_t*)(lds + H3_KC); LAS int* FLG = (LAS int*)(lds + H3_FL);
    for (int i = tid; i < (H3_S0 - H3_KD) / 16; i += 512) *(LAS u32x4*)(lds + H3_KD + i * 16) = (u32x4){0u, 0u, 0u, 0u};
    for (int i = tid; i < (H3_OS - H3_AT) / 16; i += 512) *(LAS u32x4*)(lds + H3_AT + i * 16) = (u32x4){0u, 0u, 0u, 0u};
    f32x4 acc[8];
#pragma unroll
    for (int vt = 0; vt < 8; ++vt) {
#pragma unroll
        for (int r = 0; r < 4; ++r) acc[vt][r] = Sin ? Sin[(size_t)(wave * 16 + quad * 4 + r) * 128 + vt * 16 + l15] : 0.f; }
    const int kc = tid & 15;
    int pt[5], pm[5];
#pragma unroll
    for (int pp = 0; pp < 5; ++pp) { const int pi = pp * 32 + (tid >> 4); int t = (int)((sqrtf(8.f * pi + 1.f) - 1.f) * 0.5f); if ((t + 1) * (t + 2) / 2 <= pi) ++t; if (t * (t + 1) / 2 > pi) --t;
        pt[pp] = pi < 136 ? t : -1; pm[pp] = pi - t * (t + 1) / 2; }
    const int st = tid >> 4, k8 = (tid & 15) * 8;
    float lbv[8];
#pragma unroll
    for (int i = 0; i < 8; ++i) lbv[i] = hgrn_lb(p, l, h * 128 + k8 + i);
    const int ptk = tid >> 5, pv4 = (tid & 31) * 4;
    const f32x4 gn4 = *(const f32x4*)(p.in[I_HON] + l * 128 + pv4);
    u32x4 r_hq = (u32x4){0u, 0u, 0u, 0u}, r_hf = r_hq, r_hi = r_hq; u32x2 r_hg[NBLK];
    if (st < NBLK * 16) { const bf16_t* rp = PB + (rowbase + st) * LDB_ + h * 128 + k8; r_hq = *(const u32x4*)rp; r_hf = *(const u32x4*)(rp + 1024); r_hi = *(const u32x4*)(rp + 2048); }
    __syncthreads();
    for (int c0 = 0; c0 < NTOK; c0 += 32) {
#pragma unroll
        for (int bq = 0; bq < NBLK; ++bq) r_hg[bq] = *(const u32x2*)(PB + (rowbase + c0 + bq * 16 + ptk) * LDB_ + 3072 + h * 128 + pv4);
        if (st < NBLK * 16) {
            float hq[8], hf[8], hi[8]; unpack8(r_hq, hq); unpack8(r_hf, hf); unpack8(r_hi, hi);
#pragma unroll
            for (int i = 0; i < 8; ++i) { const float sg = sigm(hf[i]); const float f = fmaxf(lbv[i] + (1.f - lbv[i]) * sg, 1e-26f);
                G[st * 128 + k8 + i] = __logf(f); KKs[st * 128 + k8 + i] = 1.f - f; Qs[st * 128 + k8 + i] = siluf(hq[i]); }
            *(LAS u32x4*)(Vs2 + st * 128 + k8) = r_hi;
        }
        if (tid < 2) FLG[tid] = 0;
        __syncthreads();
        if (c0 + 32 < NTOK && st < NBLK * 16) { const bf16_t* rp = PB + (rowbase + c0 + 32 + st) * LDB_ + h * 128 + k8; r_hq = *(const u32x4*)rp; r_hf = *(const u32x4*)(rp + 1024); r_hi = *(const u32x4*)(rp + 2048); }
        if (tid < 128 * NBLK) {
            const int k = tid & 127, blk = tid >> 7; float run = 0.f;
#pragma unroll
            for (int t = 0; t < 16; ++t) { const int o = (blk * 16 + t) * 128 + k; run += G[o]; G[o] = run; QcS[(blk * 16 + t) * 136 + k] = (bf16_t)f2bf(Qs[o] * __expf(run)); }
            Ds[blk * 128 + k] = __expf(run);
            if (run < -80.f) FLG[blk] = 1;
#pragma unroll
            for (int t = 0; t < 16; ++t) { const int o = (blk * 16 + t) * 128 + k; KcS[(blk * 16 + t) * 136 + k] = (bf16_t)f2bf(KKs[o] * __expf(fminf(-G[o], 85.f))); }
            float kd[16]; unsigned vw[8];
#pragma unroll
            for (int t = 0; t < 16; ++t) { const int o = (blk * 16 + t) * 128 + k; kd[t] = KKs[o] * __expf(run - G[o]); }
#pragma unroll
            for (int t = 0; t < 8; ++t) vw[t] = (unsigned)Vs2[(blk * 16 + 2 * t) * 128 + k] | ((unsigned)Vs2[(blk * 16 + 2 * t + 1) * 128 + k] << 16);
            *(LAS u32x4*)(KdTS + (blk * 128 + k) * 40) = pack8(*(float(*)[8])&kd[0]); *(LAS u32x4*)(KdTS + (blk * 128 + k) * 40 + 8) = pack8(*(float(*)[8])&kd[8]);
            *(LAS u32x4*)(Vt + k * 56 + blk * 16) = (u32x4){vw[0], vw[1], vw[2], vw[3]}; *(LAS u32x4*)(Vt + k * 56 + blk * 16 + 8) = (u32x4){vw[4], vw[5], vw[6], vw[7]};
        }
        __syncthreads();
#pragma unroll 1
        for (int blk = 0; blk < NBLK; ++blk) {
            const bool exact = FLG[blk] != 0;
            if (!exact) { if (wave == 0) { f32x4 C = (f32x4){0.f, 0.f, 0.f, 0.f};
#pragma unroll
                    for (int sl = 0; sl < 4; ++sl) { const bf16x8 a = *(const LAS bf16x8*)(QcS + (blk * 16 + l15) * 136 + sl * 32 + quad * 8); const bf16x8 bk = *(const LAS bf16x8*)(KcS + (blk * 16 + l15) * 136 + sl * 32 + quad * 8);
                        C = __builtin_amdgcn_mfma_f32_16x16x32_bf16(a, bk, C, 0, 0, 0); }
#pragma unroll
                    for (int r = 0; r < 4; ++r) { const int t = quad * 4 + r; attS[(blk * 16 + t) * 40 + l15] = (bf16_t)f2bf(l15 <= t ? C[r] : 0.f); } } }
            else
#pragma unroll
            for (int pp = 0; pp < 5; ++pp) if (pt[pp] >= 0) {
                const int ot = ((blk * 16 + pt[pp]) * 128 + kc * 8), om = ((blk * 16 + pm[pp]) * 128 + kc * 8);
                const f32x4 q0 = *(const LAS f32x4*)(Qs + ot), q1 = *(const LAS f32x4*)(Qs + ot + 4), k0 = *(const LAS f32x4*)(KKs + om), k1 = *(const LAS f32x4*)(KKs + om + 4);
                const f32x4 b0 = *(const LAS f32x4*)(G + ot), b1 = *(const LAS f32x4*)(G + ot + 4), c0v = *(const LAS f32x4*)(G + om), c1v = *(const LAS f32x4*)(G + om + 4);
                float sum = 0.f;
#pragma unroll
                for (int i = 0; i < 4; ++i) { sum += q0[i] * k0[i] * __expf(b0[i] - c0v[i]); sum += q1[i] * k1[i] * __expf(b1[i] - c1v[i]); }
                sum += row_ror<1>(sum); sum += row_ror<2>(sum); sum += row_ror<4>(sum); sum += row_ror<8>(sum);
                if (kc == 0) attS[(blk * 16 + pt[pp]) * 40 + pm[pp]] = (bf16_t)f2bf(sum);
            }
#pragma unroll
            for (int vt = 0; vt < 8; ++vt) { u32x2 w; w.x = pk2(acc[vt][0], acc[vt][1]); w.y = pk2(acc[vt][2], acc[vt][3]); *(LAS u32x2*)(S0T + (vt * 16 + l15) * 136 + wave * 16 + quad * 4) = w; }
            __syncthreads();
            {
                f32x4 C = (f32x4){0.f, 0.f, 0.f, 0.f};
#pragma unroll
                for (int sl = 0; sl < 4; ++sl) { const bf16x8 a = *(const LAS bf16x8*)(QcS + (blk * 16 + l15) * 136 + sl * 32 + quad * 8); const bf16x8 bq = *(const LAS bf16x8*)(S0T + (wave * 16 + l15) * 136 + sl * 32 + quad * 8);
                    C = __builtin_amdgcn_mfma_f32_16x16x32_bf16(a, bq, C, 0, 0, 0); }
                const bf16x8 a2 = *(const LAS bf16x8*)(attS + (blk * 16 + l15) * 40 + quad * 8); const bf16x8 b2 = *(const LAS bf16x8*)(Vt + (wave * 16 + l15) * 56 + blk * 16 + quad * 8);
                C = __builtin_amdgcn_mfma_f32_16x16x32_bf16(a2, b2, C, 0, 0, 0);
#pragma unroll
                for (int r = 0; r < 4; ++r) Os[(quad * 4 + r) * 128 + wave * 16 + l15] = C[r];
            }
            {
                const f32x4 d4 = *(const LAS f32x4*)(Ds + blk * 128 + wave * 16 + quad * 4);
                const bf16x8 a3 = *(const LAS bf16x8*)(KdTS + (blk * 128 + wave * 16 + l15) * 40 + quad * 8);
#pragma unroll
                for (int vt = 0; vt < 8; ++vt) { acc[vt] = acc[vt] * d4; const bf16x8 b3 = *(const LAS bf16x8*)(Vt + (vt * 16 + l15) * 56 + blk * 16 + quad * 8);
                    acc[vt] = __builtin_amdgcn_mfma_f32_16x16x32_bf16(a3, b3, acc[vt], 0, 0, 0); }
            }
            __syncthreads();
            {
                const f32x4 o4 = *(const LAS f32x4*)(Os + ptk * 128 + pv4);
                float ss = (o4[0] * o4[0] + o4[1] * o4[1]) + (o4[2] * o4[2] + o4[3] * o4[3]);
                ss += __shfl_xor(ss, 1); ss += __shfl_xor(ss, 2); ss += __shfl_xor(ss, 4); ss += __shfl_xor(ss, 8); ss += __shfl_xor(ss, 16);
                const float rstd = rsqrtf(ss * (1.f / 128.f) + EPS);
                bf16_t* gp = PB + (rowbase + c0 + blk * 16 + ptk) * LDB_ + 3072 + h * 128 + pv4;
                const u32x2 gw = NBLK == 1 ? r_hg[0] : (blk == 0 ? r_hg[0] : r_hg[NBLK - 1]);
                const float y0 = o4[0] * rstd * gn4[0] * siluf(bf2f(gw.x & 0xffffu)), y1 = o4[1] * rstd * gn4[1] * siluf(bf2f(gw.x >> 16)), y2 = o4[2] * rstd * gn4[2] * siluf(bf2f(gw.y & 0xffffu)), y3 = o4[3] * rstd * gn4[3] * siluf(bf2f(gw.y >> 16));
                u32x2 w; w.x = pk2(y0, y1); w.y = pk2(y2, y3);
                if (!dry) *(u32x2*)gp = w;
            }
        }
    }
    if (Sout) {
#pragma unroll
        for (int vt = 0; vt < 8; ++vt)
#pragma unroll
            for (int r = 0; r < 4; ++r) Sout[(size_t)(wave * 16 + quad * 4 + r) * 128 + vt * 16 + l15] = acc[vt][r];
    }
    __syncthreads();
}
__device__ __forceinline__ void ph_hgrn3(const Params& p, int l, LAS unsigned char* lds, bool dry) {
    float* Sb = (float*)(p.ws + OFF_S);
    constexpr int NPI = NB * 8 * NSEG, NSI = DB * 8;
    for (int it = blockIdx.x; it < NPI + NSI; it += gridDim.x) {
        if (it < NPI) { const int seg = it & (NSEG - 1), bh = it >> 4, b = bh >> 3, h = bh & 7;
            float* so = seg == NSEG - 1 ? p.out + O_NHP + (((size_t)l * NB + b) * 8 + h) * 16384 : nullptr;
            hgrn3_item_mfma<false>(p, l, lds, (long)b * SEQ + seg * SEGT, h, Sb + ((size_t)bh * NSEG + seg) * 16384, so, dry); }
        else { const int r = it - NPI, b = r >> 3, h = r & 7;
            hgrn3_item_mfma<true>(p, l, lds, (long)MP + b * DSQ, h, p.in[I_SH] + (((size_t)l * DB + b) * 8 + h) * 16384, p.out + O_NHS + (((size_t)l * DB + b) * 8 + h) * 16384, dry); }
    }
}

__device__ __forceinline__ void ph_conv(const Params& p, int l) {
    bf16_t* PC = (bf16_t*)(p.ws + OFF_P); bf16_t* XC = (bf16_t*)(p.ws + OFF_MG);
    const float* cw = p.in[I_CW] + (size_t)l * 4 * 1024; const float* cb = p.in[I_CB] + (size_t)l * 1024;
    const int nth = (gridDim.x * 512) & ~127;
    const int tid0 = blockIdx.x * 512 + tid_opaque(), c8 = (tid0 & 127) * 8;
    float wv[4][8], bv[8];
#pragma unroll
    for (int jj = 0; jj < 4; ++jj) { const f32x4 w0 = *(const f32x4*)(cw + jj * 1024 + c8), w1 = *(const f32x4*)(cw + jj * 1024 + c8 + 4);
#pragma unroll
        for (int i = 0; i < 4; ++i) { wv[jj][i] = w0[i]; wv[jj][4 + i] = w1[i]; } }
    { const f32x4 b0 = *(const f32x4*)(cb + c8), b1 = *(const f32x4*)(cb + c8 + 4);
#pragma unroll
      for (int i = 0; i < 4; ++i) { bv[i] = b0[i]; bv[4 + i] = b1[i]; } }
    if (tid0 < nth)
    for (int idx = tid0; idx < MT * 128; idx += nth) {
        const int row = idx >> 7;
        int t, bb;
        if (row < MP) { bb = row >> 12; t = row & 4095; } else { const int r = row - MP; bb = r >> 4; t = r & 15; }
        float acc[8];
#pragma unroll
        for (int i = 0; i < 8; ++i) acc[i] = bv[i];
        float xv[8];
#pragma unroll
        for (int jj = 0; jj < 4; ++jj) {
            const int ti = t - 3 + jj; bool have = true;
            if (ti >= 0) unpack8(*(const u32x4*)(PC + (size_t)(row - 3 + jj) * LDC_ + c8), xv);
            else if (row >= MP) { const float* sc = p.in[I_SC] + (((size_t)l * DB + bb) * 3 + (3 + ti)) * 1024 + c8; const f32x4 a0 = *(const f32x4*)sc, a1 = *(const f32x4*)(sc + 4);
#pragma unroll
                for (int i = 0; i < 4; ++i) { xv[i] = a0[i]; xv[4 + i] = a1[i]; } }
            else have = false;
            if (have) {
#pragma unroll
                for (int i = 0; i < 8; ++i) acc[i] += xv[i] * wv[jj][i]; }
        }
        *(u32x4*)(XC + (size_t)row * DM + c8) = pack8(acc);
        if (row < MP) { if (t >= SEQ - 3) { float* o = p.out + O_NCP + (((size_t)l * NB + bb) * 3 + (t - (SEQ - 3))) * 1024 + c8;
#pragma unroll
                for (int i = 0; i < 8; ++i) o[i] = xv[i]; } }
        else if (t >= DSQ - 3) { float* o = p.out + O_NCS + (((size_t)l * DB + bb) * 3 + (t - (DSQ - 3))) * 1024 + c8;
#pragma unroll
            for (int i = 0; i < 8; ++i) o[i] = xv[i]; }
    }
}
struct LruConst { float ba[4], bx[4], sp[4], w0[4], w1[4], w2[4], w3[4], cbv[4]; };
__device__ __forceinline__ void unpack4(u32x2 r, float (&o)[4]) { o[0] = bf2f(r.x & 0xffffu); o[1] = bf2f(r.x >> 16); o[2] = bf2f(r.y & 0xffffu); o[3] = bf2f(r.y >> 16); }
template <int SWEEP>
__device__ __forceinline__ void lru_scan_item(const Params& p, int l, LAS unsigned char* lds, int it, bool dry, const LruConst& K, int tid) {
    const int chl = tid & 63, sub = tid >> 6;
    bf16_t* PC = (bf16_t*)(p.ws + OFF_P);
    float* SUB = (float*)(p.ws + OFF_S); float* SEGB = SUB + (size_t)NB * 256 * 1024 * 2;
    const bool samp = it >= 512;
    int cg, seg = 0, b = 0, bb = 0; size_t row0;
    if (!samp) { cg = it & 3; seg = (it >> 2) & 31; b = it >> 7; row0 = (size_t)b * SEQ + seg * 128 + sub * 16; }
    else { const int r = it - 512; cg = r & 3; bb = (r >> 2) * 8 + sub; row0 = (size_t)MP + bb * DSQ; }
    const int ch = cg * 256 + chl * 4;
    float x1[4], x2[4], x3[4];
    if (SWEEP == 1) {
        if (!samp) { const int t0 = seg * 128 + sub * 16; const bf16_t* q = PC + row0 * LDC_ + ch;
            const u32x2 z = (u32x2){0u, 0u};
            unpack4(t0 >= 1 ? *(const u32x2*)(q - (size_t)LDC_) : z, x1); unpack4(t0 >= 2 ? *(const u32x2*)(q - (size_t)2 * LDC_) : z, x2); unpack4(t0 >= 3 ? *(const u32x2*)(q - (size_t)3 * LDC_) : z, x3); }
        else { const float* sc = p.in[I_SC] + ((size_t)l * DB + bb) * 3 * 1024 + ch; const f32x4 a1 = *(const f32x4*)(sc + 2048), a2 = *(const f32x4*)(sc + 1024), a3 = *(const f32x4*)sc;
#pragma unroll
            for (int i = 0; i < 4; ++i) { x1[i] = a1[i]; x2[i] = a2[i]; x3[i] = a3[i]; } }
    }
    float h[4] = {0.f, 0.f, 0.f, 0.f}, A[4] = {1.f, 1.f, 1.f, 1.f}, B[4] = {0.f, 0.f, 0.f, 0.f};
    if (SWEEP == 2) {
        if (!samp) {
            f32x4 su[8][2];
#pragma unroll
            for (int u = 0; u < 8; ++u) { su[u][0] = (f32x4){1.f, 0.f, 1.f, 0.f}; su[u][1] = su[u][0];
                if (u < sub) { const f32x4* q = (const f32x4*)(SUB + (((size_t)b * 256 + seg * 8 + u) * 1024 + ch) * 2); su[u][0] = q[0]; su[u][1] = q[1]; } }
#pragma unroll 1
            for (int hf = 0; hf * 4 < seg; ++hf) { f32x4 sg[4][2];
#pragma unroll
                for (int i = 0; i < 4; ++i) { const int sgi = hf * 4 + i; sg[i][0] = (f32x4){1.f, 0.f, 1.f, 0.f}; sg[i][1] = sg[i][0];
                    if (sgi < seg) { const f32x4* q = (const f32x4*)(SEGB + (((size_t)b * 32 + sgi) * 1024 + ch) * 2); sg[i][0] = q[0]; sg[i][1] = q[1]; } }
#pragma unroll
                for (int i = 0; i < 4; ++i) { h[0] = sg[i][0][0] * h[0] + sg[i][0][1]; h[1] = sg[i][0][2] * h[1] + sg[i][0][3]; h[2] = sg[i][1][0] * h[2] + sg[i][1][1]; h[3] = sg[i][1][2] * h[3] + sg[i][1][3]; } }
#pragma unroll
            for (int u = 0; u < 8; ++u) { h[0] = su[u][0][0] * h[0] + su[u][0][1]; h[1] = su[u][0][2] * h[1] + su[u][0][3]; h[2] = su[u][1][0] * h[2] + su[u][1][1]; h[3] = su[u][1][2] * h[3] + su[u][1][3]; }
        } else { const f32x4 h0 = *(const f32x4*)(p.in[I_SL] + ((size_t)l * DB + bb) * 1024 + ch);
#pragma unroll
            for (int i = 0; i < 4; ++i) h[i] = h0[i]; }
    }
    if (SWEEP == 1) {
#pragma unroll 8
        for (int t = 0; t < 16; ++t) {
            bf16_t* q = PC + (row0 + t) * LDC_ + ch;
            float x0[4], rp[4], ip[4]; unpack4(*(const u32x2*)q, x0); unpack4(*(const u32x2*)(q + 3072), rp); unpack4(*(const u32x2*)(q + 4096), ip);
            unsigned oa[4], ob[4];
#pragma unroll
            for (int i = 0; i < 4; ++i) {
                const float xc = K.cbv[i] + K.w3[i] * x0[i] + K.w2[i] * x1[i] + K.w1[i] * x2[i] + K.w0[i] * x3[i];
                x3[i] = x2[i]; x2[i] = x1[i]; x1[i] = x0[i];
                const float r = sigm(rp[i] + K.ba[i]), ig = sigm(ip[i] + K.bx[i]);
                const float la = -8.f * r * K.sp[i], a = __expf(la), x = 2.f * la;
                const float ser = -x * (1.f + x * (0.5f + x * (0.16666667f + x * (0.041666668f + x * 0.008333334f))));
                const float om = x > -0.3f ? ser : 1.f - a * a;
                const float bc = sqrtf(om) * (ig * xc);
                const float lser = -la * (1.f + la * (0.5f + la * (0.16666667f + la * (0.041666668f + la * 0.008333334f))));
                oa[i] = f2bf(la > -0.3f ? lser : 1.f - a); ob[i] = f2bf(bc);
                const float ar = 1.f - bf2f(oa[i]), br = bf2f(ob[i]);
                A[i] *= ar; B[i] = ar * B[i] + br;
            }
            u32x2 wa; wa.x = oa[0] | (oa[1] << 16); wa.y = oa[2] | (oa[3] << 16); u32x2 wb; wb.x = ob[0] | (ob[1] << 16); wb.y = ob[2] | (ob[3] << 16);
            *(u32x2*)(q + 3072) = wa; *(u32x2*)(q + 4096) = wb;
        }
    } else {
#pragma unroll 8
        for (int t = 0; t < 16; ++t) {
            bf16_t* q = PC + (row0 + t) * LDC_ + ch;
            float oa[4], ob[4], lg[4]; unpack4(*(const u32x2*)(q + 3072), oa); unpack4(*(const u32x2*)(q + 4096), ob); unpack4(*(const u32x2*)(q + 1024), lg);
            float yv[4];
#pragma unroll
            for (int i = 0; i < 4; ++i) { h[i] = (1.f - oa[i]) * h[i] + ob[i]; yv[i] = h[i] * gelu_tanh(lg[i]); }
            u32x2 w; w.x = pk2(yv[0], yv[1]); w.y = pk2(yv[2], yv[3]);
            if (!dry) *(u32x2*)(q + 1024) = w;
        }
    }
    if (SWEEP == 1 && !samp) {
        f32x4* qs = (f32x4*)(SUB + (((size_t)b * 256 + seg * 8 + sub) * 1024 + ch) * 2);
        qs[0] = (f32x4){A[0], B[0], A[1], B[1]}; qs[1] = (f32x4){A[2], B[2], A[3], B[3]};
        LAS f32x4* ex = (LAS f32x4*)lds;
        ex[(sub * 64 + chl) * 2] = (f32x4){A[0], B[0], A[1], B[1]}; ex[(sub * 64 + chl) * 2 + 1] = (f32x4){A[2], B[2], A[3], B[3]};
        __syncthreads();
        if (sub == 0) { float a[4] = {1.f, 1.f, 1.f, 1.f}, bs[4] = {0.f, 0.f, 0.f, 0.f};
#pragma unroll
            for (int u = 0; u < 8; ++u) { const f32x4 e0 = ex[(u * 64 + chl) * 2], e1 = ex[(u * 64 + chl) * 2 + 1];
                a[0] *= e0[0]; bs[0] = e0[0] * bs[0] + e0[1]; a[1] *= e0[2]; bs[1] = e0[2] * bs[1] + e0[3]; a[2] *= e1[0]; bs[2] = e1[0] * bs[2] + e1[1]; a[3] *= e1[2]; bs[3] = e1[2] * bs[3] + e1[3]; }
            f32x4* qg = (f32x4*)(SEGB + (((size_t)b * 32 + seg) * 1024 + ch) * 2);
            qg[0] = (f32x4){a[0], bs[0], a[1], bs[1]}; qg[1] = (f32x4){a[2], bs[2], a[3], bs[3]}; }
        __syncthreads();
    } else if (SWEEP == 2) {
        if (!samp) { if (seg == 31 && sub == 7) *(f32x4*)(p.out + O_NLP + ((size_t)l * NB + b) * 1024 + ch) = (f32x4){h[0], h[1], h[2], h[3]}; }
        else *(f32x4*)(p.out + O_NLS + ((size_t)l * DB + bb) * 1024 + ch) = (f32x4){h[0], h[1], h[2], h[3]};
    }
}
template <int SWEEP>
__device__ __forceinline__ void ph_lru_scan(const Params& p, int l, LAS unsigned char* lds, bool dry) {
    constexpr int NI = 512 + 16;
    const int tid = tid_opaque(), ch = (blockIdx.x & 3) * 256 + (tid & 63) * 4;
    LruConst K;
#pragma unroll
    for (int i = 0; i < 4; ++i) { K.ba[i] = p.in[I_LBA][l * 1024 + ch + i]; K.bx[i] = p.in[I_LBX][l * 1024 + ch + i]; K.sp[i] = log1pf(expf(-p.in[I_LAM][l * 1024 + ch + i]));
        const float* cw = p.in[I_CW] + (size_t)l * 4 * 1024 + ch + i; K.w0[i] = cw[0]; K.w1[i] = cw[1024]; K.w2[i] = cw[2048]; K.w3[i] = cw[3072]; K.cbv[i] = p.in[I_CB][l * 1024 + ch + i]; }
    const int G4 = (int)gridDim.x & ~3;
    if ((int)blockIdx.x < G4) for (int it = blockIdx.x; it < NI; it += G4) lru_scan_item<SWEEP>(p, l, lds, it, dry, K, tid);
}

#define XB_TMO      128
#define XB_XCNT(j)  (256  + 64 * (j))
#define XB_XSUB(j)  (1280 + 64 * (j))
#define XB_XGEN(j)  (2304 + 64 * (j))
#define XB_TOP      3328
#define XB_TOPGEN   3392
#define XCD_BAR_WORDS 3456
#define XB_SPIN_CAP (1u << 18)
__device__ __forceinline__ unsigned xb_ld(unsigned* p)              { return __hip_atomic_load(p, __ATOMIC_RELAXED, __HIP_MEMORY_SCOPE_AGENT); }
__device__ __forceinline__ unsigned xb_add(unsigned* p, unsigned v) { return __hip_atomic_fetch_add(p, v, __ATOMIC_RELAXED, __HIP_MEMORY_SCOPE_AGENT); }
__device__ __forceinline__ unsigned xb_xcc_id() { return (unsigned)__builtin_amdgcn_s_getreg((3 << 11) | 20) & 0xFu; }
#define XB_SPIN(cond, bar) do { unsigned _sp = 0; while (cond) { __builtin_amdgcn_s_sleep(1); \
    if ((++_sp & 255u) == 0u) { if (xb_ld(&(bar)[XB_TMO])) break; if (_sp > XB_SPIN_CAP) { atomicAdd(&(bar)[XB_TMO], 1u); break; } } } } while (0)
struct XcdBarrier { unsigned* bar; unsigned x; volatile LAS unsigned* st; };
__device__ __forceinline__ XcdBarrier xcd_barrier_post(unsigned* bar, volatile LAS unsigned* st) {
    XcdBarrier b; b.bar = bar; b.x = xb_xcc_id(); b.st = st;
    if (threadIdx.x == 0) (void)xb_add(&bar[XB_XCNT(b.x)], 1u);
    return b;
}
__device__ __forceinline__ void xcd_barrier_complete(unsigned* bar, unsigned x, unsigned& nloc, unsigned& nx) {
    const unsigned G = gridDim.x * gridDim.y * gridDim.z;
    unsigned sum, cnt, mine, sp = 0u;
    for (;;) {
        sum = 0u; cnt = 0u; mine = 0u;
#pragma unroll
        for (unsigned j = 0; j < 16; ++j) { const unsigned c = xb_ld(&bar[XB_XCNT(j)]); sum += c; cnt += (c > 0u) ? 1u : 0u; mine = (j == x) ? c : mine; }
        if (sum == G) break;
        __builtin_amdgcn_s_sleep(1);
        if ((++sp & 255u) == 0u) { if (xb_ld(&bar[XB_TMO])) break; if (sp > XB_SPIN_CAP) { atomicAdd(&bar[XB_TMO], 1u); break; } }
    }
    nloc = mine > 0u ? mine : 1u; nx = cnt > 0u ? cnt : 1u;
}
__device__ __forceinline__ void xcd_barrier(const XcdBarrier& b) {
    asm volatile("s_waitcnt vmcnt(0)" ::: "memory");
    __syncthreads();
    if (threadIdx.x == 0) {
        unsigned* bar = b.bar;
        __builtin_amdgcn_s_waitcnt(0);
        unsigned nloc = b.st[0], nx = b.st[1];
        if (nloc == 0u) { xcd_barrier_complete(bar, b.x, nloc, nx); b.st[0] = nloc; b.st[1] = nx; }
        const unsigned old = xb_add(&bar[XB_XSUB(b.x)], 1u);
        const unsigned gen = old / nloc;
        if (old + 1u == (gen + 1u) * nloc) {
            __builtin_amdgcn_fence(__ATOMIC_RELEASE, "agent");
            asm volatile("s_waitcnt vmcnt(0)" ::: "memory");
            const unsigned og = xb_add(&bar[XB_TOP], 1u);
            const unsigned tg = og / nx;
            if (og + 1u == (tg + 1u) * nx) xb_add(&bar[XB_TOPGEN], 1u);
            else XB_SPIN(xb_ld(&bar[XB_TOPGEN]) == tg, bar);
            __builtin_amdgcn_fence(__ATOMIC_ACQUIRE, "agent");
            xb_add(&bar[XB_XGEN(b.x)], 1u);
            asm volatile("s_waitcnt vmcnt(0)" ::: "memory");
        } else {
            XB_SPIN(xb_ld(&bar[XB_XGEN(b.x)]) == gen, bar);
            __builtin_amdgcn_fence(__ATOMIC_ACQUIRE, "agent");
            asm volatile("s_waitcnt vmcnt(0)" ::: "memory");
        }
    }
    __syncthreads();
}

constexpr int NPL = 22, NPH = DEPTH * NPL + 1;
template <int K>
__device__ __forceinline__ void run_phase(const Params& p, int l, LAS unsigned char* lds, bool dry) {
    bf16_t* Wb = (bf16_t*)(p.ws + OFF_W); bf16_t* H = (bf16_t*)(p.ws + OFF_H); bf16_t* MG = (bf16_t*)(p.ws + OFF_MG); bf16_t* P = (bf16_t*)(p.ws + OFF_P);
    float* X = p.out;
    if constexpr (K == 0) { ph_convert(p, l, lds); ph_norm<11>(p, p.in[I_NF1] + l * DM, l == 0); }
    else if constexpr (K == 1) { EpiSwiGLU e; e.G = P; run_gemm(lds, H, DM, Wb + W_UP1, 2 * DFF, DM, e); }
    else if constexpr (K == 2) run_gemm_resid(lds, P, DFF, Wb + W_DN1, DFF, X, 0.5f, (float*)(p.ws + OFF_S));
    else if constexpr (K == 3) ph_norm<11>(p, p.in[I_NMIX] + l * DM, false);
    else if constexpr (K == 4) { EpiStore e; e.O = P; e.ldc = LDC_; run_gemm(lds, H, DM, Wb + W_IN + (size_t)2560 * 1024, 3072, DM, e); }
    else if constexpr (K == 5) ph_conv(p, l);
    else if constexpr (K == 6) { EpiStoreLru e; e.O = P; e.ldc = LDC_; run_gemm_lru(lds, MG, Wb + W_LRU, e); }
    else if constexpr (K == 7) ph_lru_scan<1>(p, l, lds, false);
    else if constexpr (K == 8) ph_lru_scan<2>(p, l, lds, dry);
    else if constexpr (K == 9) { EpiGate e; e.MG = MG; e.gate = P + 2048; e.ldg = LDC_; e.accum = 0; run_gemm(lds, P + 1024, LDC_, Wb + W_LO, DM, DM, e); }
    else if constexpr (K == 10) { EpiStore e; e.O = P; e.ldc = LDA_; run_gemm(lds, H, DM, Wb + W_IN, 2560, DM, e); }
    else if constexpr (K == 11) ph_attn(p, l, lds, dry);
    else if constexpr (K == 12) { EpiGate e; e.MG = MG; e.gate = P + 1536; e.ldg = LDA_; e.accum = 1; run_gemm(lds, P, LDA_, Wb + W_AO, DM, DM, e); }
    else if constexpr (K == 13) { EpiStore e; e.O = P; e.ldc = LDB_; run_gemm(lds, H, DM, Wb + W_IN + (size_t)5632 * 1024, 5120, DM, e, MP); }
    else if constexpr (K == 14) {
        if ((int)gridDim.x >= 64) { pg8::TailOrder S; S.c = (int)blockIdx.x - ((int)gridDim.x - 40);
            if (S.c >= 0) { EpiStore e; e.O = P; e.ldc = LDB_; pg8::Gemm g; g.A = H; g.Bt = Wb + W_IN + (size_t)5632 * 1024; g.M = MT; g.N = 5120; g.K = DM; g.lda = DM; g.ldb = DM;
                pg8::gemm_phase<EpiStore, pg8::TailOrder>(lds, g, S, e); } }
        else { EpiStore e; e.O = P; e.ldc = LDB_; pg8::Gemm g; g.A = H + (size_t)MP * DM; g.Bt = Wb + W_IN + (size_t)5632 * 1024; g.M = MS; g.N = 5120; g.K = DM; g.lda = DM; g.ldb = DM;
            EpiStore e2 = e; e2.O = P + (size_t)MP * LDB_; pg8::StaticOrder S; S.init(MS, 5120, (int)gridDim.x, (int)blockIdx.x); pg8::gemm_phase<EpiStore, pg8::StaticOrder>(lds, g, S, e2); }
        ph_hgrn1(p, l, lds); }
    else if constexpr (K == 15) ph_hgrn2(p);
    else if constexpr (K == 16) ph_hgrn3(p, l, lds, dry);
    else if constexpr (K == 17) { EpiGate e; e.MG = MG; e.gate = P + 4096; e.ldg = LDB_; e.accum = 1; run_gemm(lds, P + 3072, LDB_, Wb + W_HO, DM, DM, e); }
    else if constexpr (K == 18) run_gemm_resid(lds, MG, DM, Wb + W_OUT, DM, X, 1.f, (float*)(p.ws + OFF_S));
    else if constexpr (K == 19) ph_norm<4>(p, p.in[I_NF2] + l * DM, false);
    else if constexpr (K == 20) { EpiSwiGLU e; e.G = P; run_gemm(lds, H, DM, Wb + W_UP2, 2 * DFF, DM, e); }
    else if constexpr (K == 21) run_gemm_resid(lds, P, DFF, Wb + W_DN2, DFF, X, 0.5f, (float*)(p.ws + OFF_S));
    else {
        const float* part = (const float*)(p.ws + OFF_S);
        for (int i = blockIdx.x * 512 + tid_opaque(); i < MS * DM / 4; i += gridDim.x * 512) { f32x4 v = ((f32x4*)(X + (size_t)MP * DM))[i];
#pragma unroll
            for (int c = 0; c < 11; ++c) v += ((const f32x4*)(part + (size_t)c * MS * DM))[i];
            ((f32x4*)(X + (size_t)MP * DM))[i] = v; }
    }
}

__global__ void __launch_bounds__(512, 2) mega(Params p, int ph_lo, int ph_hi) {
    extern __shared__ __attribute__((aligned(16))) unsigned char shm[];
    LAS unsigned char* lds = (LAS unsigned char*)shm;
    cg::grid_group grid = cg::this_grid();
    volatile LAS unsigned* st = (volatile LAS unsigned*)(lds + LDS_MAIN);
    if (threadIdx.x < 4) st[threadIdx.x] = 0u;
    __syncthreads();
    const XcdBarrier xb = xcd_barrier_post(p.bar, st);
    if (ph_hi < 0) grid.sync();
#define SEAM(ph) { xcd_barrier(xb); }
#define PHASE(L, K) { constexpr int ph = (L) * NPL + (K); if (ph >= ph_lo && ph < ph_hi) { if constexpr ((DUP_MASK >> (K)) & 1) { run_phase<K>(p, L, lds, p.one != 0); SEAM(1) } run_phase<K>(p, L, lds, false); if (ph + 1 < ph_hi) SEAM(ph) } }
#define LAYER(L) PHASE(L, 0) PHASE(L, 1) PHASE(L, 2) PHASE(L, 3) PHASE(L, 4) PHASE(L, 5) PHASE(L, 6) PHASE(L, 7) PHASE(L, 8) PHASE(L, 9) \
    PHASE(L, 10) PHASE(L, 11) PHASE(L, 12) PHASE(L, 13) PHASE(L, 14) PHASE(L, 15) PHASE(L, 16) PHASE(L, 17) PHASE(L, 18) PHASE(L, 19) PHASE(L, 20) PHASE(L, 21)
    LAYER(0)
    LAYER(1)
    PHASE(1, 22)
#undef LAYER
#undef PHASE
}

extern "C" void kernel_launch(void* const* d_in, const int* in_sizes, int n_in, void* d_out, int out_size, void* d_ws, size_t ws_size, hipStream_t stream) {
    static int grid = 0;
    if (grid == 0) {
        if (n_in != 31 || ws_size < WS_NEED) { fprintf(stderr, "kernel_launch: unexpected n_in %d or ws %zu < %zu\n", n_in, ws_size, (size_t)WS_END); grid = -1; return; }
        int dev = 0, cus = 0, per_cu = 0;
        (void)hipGetDevice(&dev); (void)hipDeviceGetAttribute(&cus, hipDeviceAttributeMultiprocessorCount, dev);
        if (hipFuncSetAttribute((const void*)mega, hipFuncAttributeMaxDynamicSharedMemorySize, LDS_BYTES) != hipSuccess) { fprintf(stderr, "hipFuncSetAttribute failed\n"); grid = -1; return; }
        if (hipOccupancyMaxActiveBlocksPerMultiprocessor(&per_cu, (const void*)mega, 512, LDS_BYTES) != hipSuccess || per_cu < 1) { fprintf(stderr, "occupancy query: %d\n", per_cu); per_cu = 1; }
        (void)hipGetLastError();
        grid = cus * 1;
    }
    if (grid < 0) return;
    Params p{};
    for (int i = 0; i < 31; ++i) p.in[i] = (const float*)d_in[i];
    p.out = (float*)d_out; p.ws = (unsigned char*)d_ws; p.one = 1; p.bar = (unsigned*)((unsigned char*)d_ws + OFF_BAR);
    (void)hipMemsetAsync((unsigned char*)d_ws + OFF_BAR, 0, 3456 * 4, stream);
#if ONE_LAUNCH
    int lo = 0, hi = NPH;
    void* args[] = {&p, &lo, &hi};
    hipError_t e = hipLaunchCooperativeKernel((const void*)mega, dim3(grid), dim3(512), args, LDS_BYTES, stream);
    if (e != hipSuccess) fprintf(stderr, "cooperative launch failed: %s (grid %d)\n", hipGetErrorString(e), grid);
#else
    for (int ph = 0; ph < NPH; ++ph) mega<<<dim3(grid), dim3(512), LDS_BYTES, stream>>>(p, ph, ph + 1);
#endif
}
```
